# Optimizing an MI355X kernel written in HIP

```python
import math
import jax, jax.numpy as jnp
from jax import lax
import numpy as np

D_MODEL = 2048
BATCH = 1
SEQ = 16384
DEPTH = 4
DEC_BATCH = 16
DEC_SEQ = 2048
PAST_LEN = 128

GRID_W = 64
EPS = 1e-6
NA_HEADS = 4
NA_HEAD_DIM = 128
NA_WIDTH = NA_HEADS * NA_HEAD_DIM
NA_WIN_H = 8
NA_WIN_W = 16
SSD_HEADS = 16
SSD_HEAD_DIM = 64
SSD_WIDTH = SSD_HEADS * SSD_HEAD_DIM
SSD_STATE = 128
SSD_GROUPS = 2
SSD_CONV = 5
SSD_CHUNK = 128
SSD_XBC = SSD_WIDTH + 2 * SSD_GROUPS * SSD_STATE
GQA_HEADS = 4
GQA_KV_HEADS = 2
GQA_HEAD_DIM = 128
GQA_WIDTH = GQA_HEADS * GQA_HEAD_DIM
GQA_KV_WIDTH = GQA_KV_HEADS * GQA_HEAD_DIM
ATTN_BLOCK = 128
ROPE_THETA = 10000.0
D_FF = 5632
FFN_CONV = 3
N_BRANCH = 3
MIX_WIDTH = NA_WIDTH + SSD_WIDTH + GQA_WIDTH
IN_SIZES = (3 * NA_WIDTH, GQA_WIDTH, GQA_KV_WIDTH, GQA_KV_WIDTH, SSD_WIDTH, SSD_XBC, 2 * SSD_HEADS, N_BRANCH * D_MODEL)
IN_COLS = 3 * NA_WIDTH + GQA_WIDTH + 2 * GQA_KV_WIDTH + SSD_WIDTH + SSD_XBC + 2 * SSD_HEADS + N_BRANCH * D_MODEL

kernel_name = "hybrid_na_ssd_gqa_encoder"


def _split(t, sizes):
    idx, acc = [], 0
    for s in sizes[:-1]:
        acc += s
        idx.append(acc)
    return jnp.split(t, idx, axis=-1)


def rmsnorm(x, w):
    xf = x.astype(jnp.float32)
    y = xf * lax.rsqrt(jnp.mean(xf * xf, axis=-1, keepdims=True) + EPS)
    return (y * w.astype(jnp.float32)).astype(x.dtype)


def dwconv_centred(x, w, b):
    K = w.shape[0]
    L = x.shape[1]
    pad = K // 2
    xp = jnp.pad(x, ((0, 0), (pad, pad), (0, 0)))
    out = b
    for i in range(K):
        out = out + xp[:, i:i + L] * w[i]
    return out


def neighbourhood_attention(q, k, v, rpb, q_norm, k_norm):
    B, L = q.shape[:2]
    rows = L // GRID_W
    kh = min(NA_WIN_H, rows)
    q = rmsnorm(q, q_norm)
    k = rmsnorm(k, k_norm)
    grid = lambda t: t.reshape(B, rows, GRID_W, NA_HEADS, NA_HEAD_DIM).transpose(0, 3, 1, 2, 4)
    qg, kg, vg = grid(q), grid(k), grid(v)
    r = jnp.arange(rows)
    row_start = jnp.clip(r - kh // 2, 0, rows - kh)
    key_rows = row_start[:, None] + jnp.arange(kh)[None, :]
    kr = kg[:, :, key_rows]
    vr = vg[:, :, key_rows]
    scale = NA_HEAD_DIM ** -0.5
    s = jnp.einsum('bhrqd,bhrkcd->bhrqkc', qg, kr).astype(jnp.float32) * scale
    c = jnp.arange(GRID_W)
    col_start = jnp.clip(c - NA_WIN_W // 2, 0, GRID_W - NA_WIN_W)
    in_win = (c[None, :] >= col_start[:, None]) & (c[None, :] < col_start[:, None] + NA_WIN_W)
    dr = key_rows - r[:, None]
    dc = jnp.clip(c[None, :] - c[:, None], -(NA_WIN_W - 1), NA_WIN_W - 1)
    bias = rpb[:, (dr + NA_WIN_H - 1)[:, None, :, None], (dc + NA_WIN_W - 1)[None, :, None, :]]
    s = s + bias.astype(jnp.float32)[None]
    s = jnp.where(in_win[None, None, None, :, None, :], s, -jnp.inf)
    p = jax.nn.softmax(s.reshape(B, NA_HEADS, rows, GRID_W, kh * GRID_W), axis=-1)
    p = p.reshape(B, NA_HEADS, rows, GRID_W, kh, GRID_W).astype(v.dtype)
    o = jnp.einsum('bhrqkc,bhrkcd->bhrqd', p, vr)
    return o.transpose(0, 2, 3, 1, 4).reshape(B, L, NA_WIDTH)


def axial_rope(x):
    B, L, H, hd = x.shape
    t = jnp.arange(L)
    pos = jnp.stack([t // GRID_W, t % GRID_W], axis=-1).astype(jnp.float32)
    n_freq = hd // 4
    inv_freq = ROPE_THETA ** (-jnp.arange(n_freq, dtype=jnp.float32) / n_freq)
    ang = pos[:, :, None] * inv_freq
    cos = jnp.cos(ang)[:, None]
    sin = jnp.sin(ang)[:, None]
    xa = x.astype(jnp.float32).reshape(B, L, H, 2, 2, n_freq)
    x1, x2 = xa[..., 0, :], xa[..., 1, :]
    out = jnp.stack([x1 * cos - x2 * sin, x1 * sin + x2 * cos], axis=-2)
    return out.reshape(B, L, H, hd).astype(x.dtype)


def gqa_attention(q, k, v, q_norm, k_norm):
    B, L = q.shape[:2]
    q = axial_rope(rmsnorm(q, q_norm))
    k = axial_rope(rmsnorm(k, k_norm))
    rep = GQA_HEADS // GQA_KV_HEADS
    nb = L // ATTN_BLOCK
    qb = q.reshape(B, nb, ATTN_BLOCK, GQA_KV_HEADS, rep, GQA_HEAD_DIM).transpose(1, 0, 3, 4, 2, 5)
    scale = GQA_HEAD_DIM ** -0.5

    def block(qi):
        s = jnp.einsum('bgrqd,bkgd->bgrqk', qi, k).astype(jnp.float32) * scale
        p = jax.nn.softmax(s, axis=-1).astype(v.dtype)
        return jnp.einsum('bgrqk,bkgd->bgrqd', p, v)

    o = lax.map(block, qb)
    return o.transpose(1, 0, 4, 2, 3, 5).reshape(B, L, GQA_WIDTH)


def ssd_scan(x, dt, a, b, c):
    out_dtype = x.dtype
    Bsz, L = x.shape[:2]
    nc = L // SSD_CHUNK
    R = SSD_HEADS // SSD_GROUPS
    x = x.astype(jnp.float32)
    dt = dt.astype(jnp.float32)
    xd = (x * dt[..., None]).reshape(Bsz, nc, SSD_CHUNK, SSD_GROUPS, R, SSD_HEAD_DIM)
    da = (dt * a).reshape(Bsz, nc, SSD_CHUNK, SSD_GROUPS, R).transpose(0, 3, 4, 1, 2)
    bc = b.astype(jnp.float32).reshape(Bsz, nc, SSD_CHUNK, SSD_GROUPS, SSD_STATE)
    cc = c.astype(jnp.float32).reshape(Bsz, nc, SSD_CHUNK, SSD_GROUPS, SSD_STATE)
    cum = jnp.cumsum(da, axis=-1)
    li = jnp.arange(SSD_CHUNK)
    lower = li[:, None] >= li[None, :]
    seg = cum[..., :, None] - cum[..., None, :]
    lmat = jnp.exp(jnp.where(lower, seg, -jnp.inf))
    cb = jnp.einsum('bclgn,bcsgn->bgcls', cc, bc)
    y_diag = jnp.einsum('bgcls,bgrcls,bcsgrp->bclgrp', cb, lmat, xd)
    decay_states = jnp.exp(cum[..., -1:] - cum)
    states = jnp.einsum('bclgn,bgrcl,bclgrp->bcgrpn', bc, decay_states, xd)
    chunk_decay = jnp.exp(cum[..., -1])

    def step(h, inp):
        s_c, d_c = inp
        return h * d_c[..., None, None] + s_c, h

    h0 = jnp.zeros((Bsz, SSD_GROUPS, R, SSD_HEAD_DIM, SSD_STATE), jnp.float32)
    _, prev = lax.scan(step, h0, (states.transpose(1, 0, 2, 3, 4, 5), chunk_decay.transpose(3, 0, 1, 2)))
    prev = prev.transpose(1, 0, 2, 3, 4, 5)
    y_off = jnp.einsum('bclgn,bcgrpn,bgrcl->bclgrp', cc, prev, jnp.exp(cum))
    return (y_diag + y_off).reshape(Bsz, L, SSD_HEADS, SSD_HEAD_DIM).astype(out_dtype)


def ssd_mixer(z, xbc, dt_raw, conv_w, conv_b, dt_bias, a_log, d_skip, norm_w):
    B, L = z.shape[:2]
    xbc = jax.nn.silu(dwconv_centred(xbc, conv_w, conv_b))
    xs, bm, cm = _split(xbc, (SSD_WIDTH, SSD_GROUPS * SSD_STATE, SSD_GROUPS * SSD_STATE))
    xs = xs.reshape(B, L, SSD_HEADS, SSD_HEAD_DIM)
    bm = bm.reshape(B, L, SSD_GROUPS, SSD_STATE)
    cm = cm.reshape(B, L, SSD_GROUPS, SSD_STATE)
    dt = jax.nn.softplus(dt_raw.astype(jnp.float32).reshape(B, L, 2, SSD_HEADS) + dt_bias.astype(jnp.float32))
    a = -jnp.exp(a_log.astype(jnp.float32))
    flip = lambda t: jnp.flip(t, axis=1)
    y_fwd = ssd_scan(xs, dt[:, :, 0], a[0], bm, cm)
    y_bwd = flip(ssd_scan(flip(xs), flip(dt[:, :, 1]), a[1], flip(bm), flip(cm)))
    y = y_fwd + y_bwd + xs * d_skip[:, None]
    y = y.reshape(B, L, SSD_WIDTH) * jax.nn.silu(z)
    y = rmsnorm(y.reshape(B, L, SSD_GROUPS, SSD_WIDTH // SSD_GROUPS), norm_w.reshape(SSD_GROUPS, SSD_WIDTH // SSD_GROUPS))
    return y.reshape(B, L, SSD_WIDTH)


def layer(x, norm1_w, w_in, na_q_norm, na_k_norm, na_rpb, ssd_conv_w, ssd_conv_b, ssd_dt_bias, ssd_a_log,
          ssd_d, ssd_norm_w, gqa_q_norm, gqa_k_norm, w_branch, w_out, norm2_w, ffn_w_up, ffn_conv_w,
          ffn_conv_b, ffn_w_down):
    B, L, _ = x.shape
    h = rmsnorm(x, norm1_w)
    proj = h @ w_in
    na_qkv, gq, gk, gv, z, xbc, dt_raw, gates = _split(proj, IN_SIZES)
    na_qkv = na_qkv.reshape(B, L, 3, NA_HEADS, NA_HEAD_DIM)
    o_na = neighbourhood_attention(na_qkv[:, :, 0], na_qkv[:, :, 1], na_qkv[:, :, 2], na_rpb, na_q_norm, na_k_norm)
    o_ssd = ssd_mixer(z, xbc, dt_raw, ssd_conv_w, ssd_conv_b, ssd_dt_bias, ssd_a_log, ssd_d, ssd_norm_w)
    o_gqa = gqa_attention(gq.reshape(B, L, GQA_HEADS, GQA_HEAD_DIM), gk.reshape(B, L, GQA_KV_HEADS, GQA_HEAD_DIM),
                          gv.reshape(B, L, GQA_KV_HEADS, GQA_HEAD_DIM), gqa_q_norm, gqa_k_norm)
    g = jax.nn.sigmoid(gates.astype(jnp.float32)).astype(x.dtype).reshape(B, L, N_BRANCH, D_MODEL)
    p_na = o_na @ w_branch[:NA_WIDTH]
    p_ssd = o_ssd @ w_branch[NA_WIDTH:NA_WIDTH + SSD_WIDTH]
    p_gqa = o_gqa @ w_branch[NA_WIDTH + SSD_WIDTH:]
    merged = g[:, :, 0] * p_na + g[:, :, 1] * p_ssd + g[:, :, 2] * p_gqa
    x = x + merged @ w_out
    h2 = rmsnorm(x, norm2_w)
    u_gate, u_val = _split(h2 @ ffn_w_up, (D_FF, D_FF))
    u_gate = dwconv_centred(u_gate, ffn_conv_w, ffn_conv_b)
    return x + (jax.nn.silu(u_gate) * u_val) @ ffn_w_down


def trunk(x, params):
    for i in range(DEPTH):
        x = layer(x, *[p[i] for p in params])
    return x


def setup_inputs(seed: int = 0) -> dict:
    key = jax.random.key(seed)
    ks = jax.random.split(key, 24)
    nrm = lambda k, shape, s: jax.random.normal(k, shape, jnp.float32) * s
    u_dt = jax.random.uniform(ks[9], (DEPTH, 2, SSD_HEADS), jnp.float32)
    dt0 = jnp.exp(u_dt * (math.log(0.1) - math.log(0.001)) + math.log(0.001))
    return {
        "x_prompt": nrm(ks[0], (BATCH, SEQ, D_MODEL), 1.0),
        "x_sample": nrm(ks[1], (DEC_BATCH, DEC_SEQ, D_MODEL), 1.0),
        "norm1_w": 1.0 + nrm(ks[2], (DEPTH, D_MODEL), 0.02),
        "w_in": nrm(ks[3], (DEPTH, D_MODEL, IN_COLS), D_MODEL ** -0.5),
        "na_q_norm": 1.0 + nrm(ks[4], (DEPTH, NA_HEAD_DIM), 0.02),
        "na_k_norm": 1.0 + nrm(ks[5], (DEPTH, NA_HEAD_DIM), 0.02),
        "na_rpb": nrm(ks[6], (DEPTH, NA_HEADS, 2 * NA_WIN_H - 1, 2 * NA_WIN_W - 1), 0.1),
        "ssd_conv_w": nrm(ks[7], (DEPTH, SSD_CONV, SSD_XBC), SSD_CONV ** -0.5),
        "ssd_conv_b": nrm(ks[8], (DEPTH, SSD_XBC), 0.02),
        "ssd_dt_bias": dt0 + jnp.log(-jnp.expm1(-dt0)),
        "ssd_a_log": jnp.log(jax.random.uniform(ks[10], (DEPTH, 2, SSD_HEADS), jnp.float32, 1.0, 16.0)),
        "ssd_d": 1.0 + nrm(ks[11], (DEPTH, SSD_HEADS), 0.1),
        "ssd_norm_w": 1.0 + nrm(ks[12], (DEPTH, SSD_WIDTH), 0.02),
        "gqa_q_norm": 1.0 + nrm(ks[13], (DEPTH, GQA_HEAD_DIM), 0.02),
        "gqa_k_norm": 1.0 + nrm(ks[14], (DEPTH, GQA_HEAD_DIM), 0.02),
        "w_branch": nrm(ks[15], (DEPTH, MIX_WIDTH, D_MODEL), NA_WIDTH ** -0.5),
        "w_out": nrm(ks[16], (DEPTH, D_MODEL, D_MODEL), D_MODEL ** -0.5),
        "norm2_w": 1.0 + nrm(ks[17], (DEPTH, D_MODEL), 0.02),
        "ffn_w_up": nrm(ks[18], (DEPTH, D_MODEL, 2 * D_FF), D_MODEL ** -0.5),
        "ffn_conv_w": nrm(ks[19], (DEPTH, FFN_CONV, D_FF), FFN_CONV ** -0.5),
        "ffn_conv_b": nrm(ks[20], (DEPTH, D_FF), 0.02),
        "ffn_w_down": nrm(ks[21], (DEPTH, D_FF, D_MODEL), D_FF ** -0.5),
    }


def reference(x_prompt, x_sample, norm1_w, w_in, na_q_norm, na_k_norm, na_rpb, ssd_conv_w, ssd_conv_b,
              ssd_dt_bias, ssd_a_log, ssd_d, ssd_norm_w, gqa_q_norm, gqa_k_norm, w_branch, w_out, norm2_w,
              ffn_w_up, ffn_conv_w, ffn_conv_b, ffn_w_down):
    params = (norm1_w, w_in, na_q_norm, na_k_norm, na_rpb, ssd_conv_w, ssd_conv_b, ssd_dt_bias, ssd_a_log,
              ssd_d, ssd_norm_w, gqa_q_norm, gqa_k_norm, w_branch, w_out, norm2_w, ffn_w_up, ffn_conv_w,
              ffn_conv_b, ffn_w_down)
    y_prompt = trunk(x_prompt, params)
    y_sample = trunk(x_sample, params)
    return (y_prompt, y_sample)
```

```cpp
#define DBG_STOP 0
#include <hip/hip_runtime.h>
#include <cstdio>
#include <cstdint>
#include <cmath>

#define GAS __attribute__((address_space(1)))
#define LAS __attribute__((address_space(3)))
typedef unsigned short bf16;
typedef unsigned v4u __attribute__((ext_vector_type(4)));
typedef unsigned v2u __attribute__((ext_vector_type(2)));
typedef float f32x4 __attribute__((ext_vector_type(4)));
typedef float f32x2 __attribute__((ext_vector_type(2)));
typedef float f32x16 __attribute__((ext_vector_type(16)));
typedef short bf16x8 __attribute__((ext_vector_type(8)));
typedef short s16x4 __attribute__((ext_vector_type(4)));
typedef __bf16 bf16x2_t __attribute__((ext_vector_type(2)));
#define DI __device__ __forceinline__

DI unsigned pk2(float lo, float hi) { f32x2 v = {lo, hi}; bf16x2_t b = __builtin_convertvector(v, bf16x2_t); return __builtin_bit_cast(unsigned, b); }
DI unsigned short f2bf(float f) { return (unsigned short)(pk2(f, 0.f) & 0xffffu); }
DI float bflo(unsigned u) { return __uint_as_float(u << 16); }
DI float bfhi(unsigned u) { return __uint_as_float(u & 0xffff0000u); }
DI float bf2f(unsigned short h) { return __uint_as_float((unsigned)h << 16); }
DI void unpack8(v4u v, float (&x)[8]) { x[0] = bflo(v.x); x[1] = bfhi(v.x); x[2] = bflo(v.y); x[3] = bfhi(v.y); x[4] = bflo(v.z); x[5] = bfhi(v.z); x[6] = bflo(v.w); x[7] = bfhi(v.w); }
DI v4u pack8(const float (&x)[8]) { v4u v; v.x = pk2(x[0], x[1]); v.y = pk2(x[2], x[3]); v.z = pk2(x[4], x[5]); v.w = pk2(x[6], x[7]); return v; }
DI float sigmoidf_(float x) { return __builtin_amdgcn_rcpf(1.f + __expf(-x)); }
DI float siluf_(float x) { return x * sigmoidf_(x); }

template <int K> DI float xor_lane(float v) {
    if constexpr (K == 32) { auto rr = __builtin_amdgcn_permlane32_swap(__float_as_uint(v), __float_as_uint(v), false, false); return __uint_as_float((__builtin_amdgcn_mbcnt_hi(~0u, __builtin_amdgcn_mbcnt_lo(~0u, 0u)) & 32u) ? rr[0] : rr[1]); }
    else return __int_as_float(__builtin_amdgcn_ds_swizzle(__float_as_int(v), (K << 10) | 0x1f));
}
DI float wave_sum(float v) {
    v += xor_lane<1>(v); v += xor_lane<2>(v); v += xor_lane<4>(v); v += xor_lane<8>(v); v += xor_lane<16>(v);
    { auto rr = __builtin_amdgcn_permlane32_swap(__float_as_uint(v), __float_as_uint(v), false, false); v = __uint_as_float(rr[0]) + __uint_as_float(rr[1]); }
    return v;
}
template <int CTRL, int RMASK> DI float dpp0(float v) { return __int_as_float(__builtin_amdgcn_update_dpp(0, __float_as_int(v), CTRL, RMASK, 0xf, false)); }
DI float wave_scan_incl(float v) {
    v += dpp0<0x111, 0xf>(v); v += dpp0<0x112, 0xf>(v); v += dpp0<0x114, 0xf>(v); v += dpp0<0x118, 0xf>(v);
    v += dpp0<0x142, 0xa>(v); v += dpp0<0x143, 0xc>(v);
    return v;
}
DI int lane_id() { return (int)__builtin_amdgcn_mbcnt_hi(~0u, __builtin_amdgcn_mbcnt_lo(~0u, 0u)); }
DI int tid_of(int wave) { int t = wave * 64 + lane_id(); asm volatile("" : "+v"(t)); return t; }
#define LDS_WAIT() asm volatile("s_waitcnt lgkmcnt(0)" ::: "memory")
#define VM_WAIT() asm volatile("s_waitcnt vmcnt(0)" ::: "memory")

constexpr int DM = 2048, DEPTH = 4, MTOT = 49152, MG = 16384, NGRP = 3;
constexpr int NIN = 11296, NINP = 11520, DFF = 5632, NUP = 11264, GATE_SRC0 = 5152, GATE_DST0 = 5376;
constexpr float EPSN = 1e-6f;
namespace pg8 {
#define PG8_LAS __attribute__((address_space(3)))
typedef unsigned short bf16_t;
typedef short bf16x8 __attribute__((ext_vector_type(8)));
typedef float f32x4 __attribute__((ext_vector_type(4)));
typedef unsigned u32x4 __attribute__((ext_vector_type(4)));
constexpr int BM = 256, BK = 64, HALF = 128, HTB = HALF * BK * 2  , STAGE_BYTES = 8 * HTB, NXCD = 8, WGM = 8;

__host__ __device__ __forceinline__ int lds_byte(int r, int c) { const int st = (r >> 4) * 2 + (c >> 5), rr = r & 15, cc = c & 31, ob = rr * 64 + cc * 2; return st * 1024 + (ob ^ (((ob >> 9) & 1) << 5)); }
__host__ __device__ __forceinline__ void stage_rc(int b, int& R, int& C) { const int st = b / 1024, sb = b % 1024, swz = sb ^ (((sb >> 9) & 1) << 5); R = (st >> 1) * 16 + swz / 64; C = (st & 1) * 32 + (swz % 64) / 2; }
__host__ __device__ __forceinline__ int perm32(int rho) { const int n = rho >> 4, i = rho & 15; return 8 * (i >> 2) + 4 * n + (i & 3); }

struct Unit { int pm, pn; };
struct Gemm { const bf16_t* A; const bf16_t* Bt; int M, N, K, lda, ldb; };

struct StaticOrder {
    int nM, nN, nwg, G, c;
    __host__ __device__ void init(int M, int N, int G_, int c_) { nM = M / BM; nN = N / BM; nwg = nM * nN; G = G_; c = c_; }
    __host__ __device__ bool next(int i, Unit& u) const {
        const long L = (long)i * G + c; if (L >= nwg) return false;
        int wgid = (int)L; { const int q = nwg / NXCD, r = nwg % NXCD, xcd = wgid % NXCD, off = wgid / NXCD; wgid = (xcd < r ? xcd * (q + 1) : r * (q + 1) + (xcd - r) * q) + off; }
        const int nig = WGM * nN, gid = wgid / nig, fm = gid * WGM, gsz = (nM - fm) < WGM ? (nM - fm) : WGM;
        u.pm = fm + ((wgid % nig) % gsz); u.pn = (wgid % nig) / gsz; return true;
    }
    __device__ __forceinline__ void a_ready(const Unit&) const {}
    __device__ __forceinline__ void done(const Unit&) const {}
};

struct EpiInProj {
    static constexpr bool PERM = true, AFTER_DRAIN = false;
    unsigned char* r1;
    size_t oQNA, oKNA, oVNA, oGQ, oGK, oGV, oZ, oXBC, oDT, oGATE;
    __device__ __forceinline__ void operator()(const f32x4 (&acc)[2][2][4][2], const Unit& u, int wr, int wc, int fr, int fq) const {
        const int pn = u.pn; const int row0 = u.pm * BM + wr * 64 + fr;
        size_t off; int ld, colb, mode = 0;
        if (pn < 2)       { off = oQNA; ld = 512;  colb = pn * 256; }
        else if (pn < 4)  { off = oKNA; ld = 512;  colb = (pn - 2) * 256; }
        else if (pn < 6)  { off = oVNA; ld = 512;  colb = (pn - 4) * 256; }
        else if (pn < 8)  { off = oGQ;  ld = 512;  colb = (pn - 6) * 256; }
        else if (pn == 8) { off = oGK;  ld = 256;  colb = 0; }
        else if (pn == 9) { off = oGV;  ld = 256;  colb = 0; }
        else if (pn < 14) { off = oZ;   ld = 1024; colb = (pn - 10) * 256; }
        else if (pn < 20) { off = oXBC; ld = 1536; colb = (pn - 14) * 256; }
        else if (pn == 20){ off = oDT;  ld = 32;   colb = 0; mode = 1; }
        else              { off = oGATE; ld = 6144; colb = (pn - 21) * 256; mode = 2; }
        const int col0 = colb + wc * 32 + 8 * fq;
        if (mode == 1) {
            if (wc == 0) {
                float* base = (float*)(r1 + off);
#pragma unroll
                for (int ai = 0; ai < 2; ++ai)
#pragma unroll
                    for (int m = 0; m < 4; ++m) { float* rowp = base + (size_t)(row0 + ai * HALF + m * 16) * 32 + 8 * fq;
                        *(f32x4*)(rowp) = acc[ai][0][m][0]; *(f32x4*)(rowp + 4) = acc[ai][0][m][1]; }
            }
            return;
        }
        bf16_t* base = (bf16_t*)(r1 + off);
#pragma unroll
        for (int ai = 0; ai < 2; ++ai)
#pragma unroll
            for (int m = 0; m < 4; ++m) { bf16_t* rowp = base + (size_t)(row0 + ai * HALF + m * 16) * ld + col0;
#pragma unroll
                for (int bj = 0; bj < 2; ++bj) { f32x4 v0 = acc[ai][bj][m][0], v1 = acc[ai][bj][m][1];
                    if (mode == 2) {
#pragma unroll
                        for (int e = 0; e < 4; ++e) { v0[e] = sigmoidf_(v0[e]); v1[e] = sigmoidf_(v1[e]); } }
                    u32x4 w; w.x = pk2(v0[0], v0[1]); w.y = pk2(v0[2], v0[3]); w.z = pk2(v1[0], v1[1]); w.w = pk2(v1[2], v1[3]);
                    *(u32x4*)(rowp + bj * HALF) = w; } }
    }
};
struct EpiBf16Plain {
    static constexpr bool PERM = true, AFTER_DRAIN = false;
    bf16_t* O; int ldc;
    __device__ __forceinline__ void operator()(const f32x4 (&acc)[2][2][4][2], const Unit& u, int wr, int wc, int fr, int fq) const {
        const int row0 = u.pm * BM + wr * 64 + fr, col0 = u.pn * BM + wc * 32 + 8 * fq;
#pragma unroll
        for (int ai = 0; ai < 2; ++ai)
#pragma unroll
            for (int m = 0; m < 4; ++m) { bf16_t* rowp = O + (size_t)(row0 + ai * HALF + m * 16) * ldc + col0;
#pragma unroll
                for (int bj = 0; bj < 2; ++bj) { const f32x4 v0 = acc[ai][bj][m][0], v1 = acc[ai][bj][m][1];
                    u32x4 w; w.x = pk2(v0[0], v0[1]); w.y = pk2(v0[2], v0[3]); w.z = pk2(v1[0], v1[1]); w.w = pk2(v1[2], v1[3]);
                    *(u32x4*)(rowp + bj * HALF) = w; } }
    }
};
struct EpiMerge {
    static constexpr bool PERM = true, AFTER_DRAIN = false;
    const bf16_t* gates; float* tmp; bf16_t* merged; int j;
    __device__ __forceinline__ void operator()(const f32x4 (&acc)[2][2][4][2], const Unit& u, int wr, int wc, int fr, int fq) const {
        const int row0 = u.pm * BM + wr * 64 + fr, col0 = u.pn * BM + wc * 32 + 8 * fq;
#pragma unroll
        for (int ai = 0; ai < 2; ++ai)
#pragma unroll
            for (int m = 0; m < 4; ++m) { const size_t row = (size_t)(row0 + ai * HALF + m * 16);
#pragma unroll
                for (int bj = 0; bj < 2; ++bj) { const int col = col0 + bj * HALF;
                    const u32x4 gw = *(const u32x4*)(gates + row * 6144 + (size_t)j * 2048 + col);
                    float g[8]; unpack8(gw, g);
                    f32x4 v0 = acc[ai][bj][m][0], v1 = acc[ai][bj][m][1];
                    v0[0] *= g[0]; v0[1] *= g[1]; v0[2] *= g[2]; v0[3] *= g[3]; v1[0] *= g[4]; v1[1] *= g[5]; v1[2] *= g[6]; v1[3] *= g[7];
                    float* tp = tmp + row * 2048 + col;
                    if (j > 0) { v0 += *(const f32x4*)tp; v1 += *(const f32x4*)(tp + 4); }
                    if (j < 2) { *(f32x4*)tp = v0; *(f32x4*)(tp + 4) = v1; }
                    else { u32x4 w; w.x = pk2(v0[0], v0[1]); w.y = pk2(v0[2], v0[3]); w.z = pk2(v1[0], v1[1]); w.w = pk2(v1[2], v1[3]);
                        *(u32x4*)(merged + row * 2048 + col) = w; } } }
    }
};
struct EpiResid {
    static constexpr bool PERM = false, AFTER_DRAIN = false;
    const float* xin; float* xout;
    __device__ __forceinline__ void operator()(const f32x4 (&acc)[2][2][4][2], const Unit& u, int wr, int wc, int fr, int fq) const {
        const int row0 = u.pm * BM + wr * 64 + fr, col0 = u.pn * BM + wc * 32 + 4 * fq;
#pragma unroll
        for (int ai = 0; ai < 2; ++ai)
#pragma unroll
            for (int m = 0; m < 4; ++m) { const size_t off = (size_t)(row0 + ai * HALF + m * 16) * 2048 + col0;
#pragma unroll
                for (int bj = 0; bj < 2; ++bj)
#pragma unroll
                    for (int n = 0; n < 2; ++n) { const f32x4 xi = *(const f32x4*)(xin + off + bj * HALF + n * 16);
                        *(f32x4*)(xout + off + bj * HALF + n * 16) = xi + acc[ai][bj][m][n]; } }
    }
};

template <class Epi, class Sched, bool ALIGN_EPI = false, bool SP2 = false>
__device__ __forceinline__ void gemm_phase(PG8_LAS unsigned char* lds, const Gemm g, const Sched& S, const Epi& E, int wave_) {
    const int tid_ = tid_of(wave_);
    const int tid = tid_, wid = __builtin_amdgcn_readfirstlane(tid >> 6), lane = tid & 63, wr = wid >> 2, wc = wid & 3, fr = lane & 15, fq = lane >> 4;
    const int K = g.K, nt = K / BK;
    unsigned voffA[2], voffB[2];
#pragma unroll
    for (int i = 0; i < 2; ++i) { int R, C; stage_rc(tid * 16 + i * 8192, R, C); const int Rb = Epi::PERM ? ((R & ~31) + perm32(R & 31)) : R;
        voffA[i] = (unsigned)(R * g.lda + C) * 2u; voffB[i] = (unsigned)(Rb * g.ldb + C) * 2u; }
    const size_t kstep = (size_t)(BK * 2);
    const size_t hstepA = (size_t)HALF * g.lda * 2, hstepB = (size_t)HALF * g.ldb * 2;
    const size_t tstepA = 2 * hstepA, tstepB = 2 * hstepB;
    const unsigned ldsw = (unsigned)wid * 1024u;
    const int aoff = lds_byte(wr * 64 + fr, fq * 8), boff = lds_byte(wc * 32 + fr, fq * 8);
#define PG8_SA(b, h) (((b) * 2 + (h)) * HTB)
#define PG8_SB(b, h) ((4 + (b) * 2 + (h)) * HTB)
#define PG8_STAGE(bufoff, gbase, voff) do { _Pragma("unroll") for (int _i = 0; _i < 2; ++_i) \
        __builtin_amdgcn_global_load_lds((const unsigned*)((const char*)(gbase) + (voff)[_i]), (PG8_LAS unsigned*)(lds + (bufoff) + ldsw + _i * 8192), 16, 0, 0); } while (0)
#define PG8_LDA(dst, b, h) do { _Pragma("unroll") for (int m = 0; m < 4; ++m) _Pragma("unroll") for (int k = 0; k < 2; ++k) dst[m][k] = *(const PG8_LAS bf16x8*)(lds + PG8_SA(b, h) + aoff + m * 2048 + k * 1024); } while (0)
#define PG8_LDB(dst, b, h) do { _Pragma("unroll") for (int n = 0; n < 2; ++n) _Pragma("unroll") for (int k = 0; k < 2; ++k) dst[n][k] = *(const PG8_LAS bf16x8*)(lds + PG8_SB(b, h) + boff + n * 2048 + k * 1024); } while (0)
#define PG8_MMA(ai, bj, At, Bt) do { __builtin_amdgcn_s_setprio(1); _Pragma("unroll") for (int m = 0; m < 4; ++m) _Pragma("unroll") for (int n = 0; n < 2; ++n) _Pragma("unroll") for (int k = 0; k < 2; ++k) \
        acc[ai][bj][m][n] = __builtin_amdgcn_mfma_f32_16x16x32_bf16(Bt[n][k], At[m][k], acc[ai][bj][m][n], 0, 0, 0); __builtin_amdgcn_s_setprio(0); } while (0)
#define PG8_WAIT_V(n) asm volatile("s_waitcnt vmcnt(" #n ")" ::: "memory")
#define PG8_WAIT_L(n) asm volatile("s_waitcnt lgkmcnt(" #n ")" ::: "memory")
#define PG8_BAR __builtin_amdgcn_s_barrier()
#define PG8_SCHED __builtin_amdgcn_sched_barrier(0)
    Unit cur, nxt; int ui = 0;
    if (!S.next(0, cur)) return;
    f32x4 acc[2][2][4][2];
#pragma unroll
    for (int a = 0; a < 2; ++a)
#pragma unroll
        for (int b = 0; b < 2; ++b)
#pragma unroll
            for (int m = 0; m < 4; ++m)
#pragma unroll
                for (int n = 0; n < 2; ++n) acc[a][b][m][n] = (f32x4){0.f, 0.f, 0.f, 0.f};
    bf16x8 At[4][2], B0[2][2], B1[2][2];
    const char* cA = (const char*)g.A + (size_t)cur.pm * tstepA; const char* cB = (const char*)g.Bt + (size_t)cur.pn * tstepB;
    S.a_ready(cur);
    if constexpr (SP2) {
        PG8_STAGE(PG8_SB(0, 0), cB, voffB); PG8_STAGE(PG8_SB(0, 1), cB + hstepB, voffB); PG8_STAGE(PG8_SA(0, 0), cA, voffA); PG8_STAGE(PG8_SA(0, 1), cA + hstepA, voffA);
        if (wr == 1) PG8_BAR;
        PG8_WAIT_V(2); PG8_BAR;
        PG8_STAGE(PG8_SB(1, 0), cB + kstep, voffB); PG8_STAGE(PG8_SA(1, 0), cA + kstep, voffA); PG8_STAGE(PG8_SB(1, 1), cB + hstepB + kstep, voffB);
        PG8_WAIT_V(6); PG8_BAR;
    } else {
        PG8_STAGE(PG8_SB(0, 0), cB, voffB); PG8_STAGE(PG8_SA(0, 0), cA, voffA); PG8_STAGE(PG8_SB(0, 1), cB + hstepB, voffB); PG8_STAGE(PG8_SA(0, 1), cA + hstepA, voffA);
        if (wr == 1) PG8_BAR;
        PG8_WAIT_V(4); PG8_BAR;
        PG8_STAGE(PG8_SB(1, 0), cB + kstep, voffB); PG8_STAGE(PG8_SA(1, 0), cA + kstep, voffA); PG8_STAGE(PG8_SB(1, 1), cB + hstepB + kstep, voffB);
        PG8_WAIT_V(6); PG8_BAR;
    }
    for (;;) {
        const bool has_next = S.next(ui + 1, nxt);
        const char* nA = has_next ? (const char*)g.A + (size_t)nxt.pm * tstepA : cA; const char* nB = has_next ? (const char*)g.Bt + (size_t)nxt.pn * tstepB : cB;
        for (int t = 0; t < nt; t += 2) {
            const bool last = (t == nt - 2);
            const char* a1 = cA + (size_t)(t + 1) * kstep;
            const char* a2 = last ? nA : cA + (size_t)(t + 2) * kstep; const char* b2 = last ? nB : cB + (size_t)(t + 2) * kstep;
            const char* a3 = a2 + kstep; const char* b3 = b2 + kstep;
            if (last && has_next) S.a_ready(nxt);
            if constexpr (SP2) {
            PG8_LDB(B0, 0, 0); PG8_LDB(B1, 0, 1); PG8_SCHED; PG8_LDA(At, 0, 0); PG8_STAGE(PG8_SA(1, 1), a1 + hstepA, voffA);
            PG8_WAIT_V(8); PG8_WAIT_L(0); PG8_BAR; PG8_MMA(0, 0, At, B0); PG8_MMA(0, 1, At, B1); PG8_BAR; PG8_SCHED;
            PG8_LDA(At, 0, 1); PG8_STAGE(PG8_SB(0, 0), b2, voffB); PG8_STAGE(PG8_SB(0, 1), b2 + hstepB, voffB); PG8_STAGE(PG8_SA(0, 0), a2, voffA);
            PG8_WAIT_V(8); PG8_WAIT_L(0); PG8_BAR; PG8_MMA(1, 0, At, B0); PG8_MMA(1, 1, At, B1); PG8_BAR; PG8_SCHED;
            PG8_LDB(B0, 1, 0); PG8_LDB(B1, 1, 1); PG8_SCHED; PG8_LDA(At, 1, 0); PG8_STAGE(PG8_SA(0, 1), a2 + hstepA, voffA);
            PG8_WAIT_V(8); PG8_WAIT_L(0); PG8_BAR; PG8_MMA(0, 0, At, B0); PG8_MMA(0, 1, At, B1); PG8_BAR; PG8_SCHED;
            PG8_LDA(At, 1, 1); PG8_STAGE(PG8_SB(1, 0), b3, voffB); PG8_STAGE(PG8_SB(1, 1), b3 + hstepB, voffB); PG8_STAGE(PG8_SA(1, 0), a3, voffA);
            PG8_WAIT_V(8); PG8_WAIT_L(0); PG8_BAR; PG8_MMA(1, 0, At, B0); PG8_MMA(1, 1, At, B1); PG8_BAR; PG8_SCHED;
            } else {
            PG8_LDB(B0, 0, 0); PG8_SCHED; PG8_LDA(At, 0, 0); PG8_STAGE(PG8_SA(1, 1), a1 + hstepA, voffA);
            PG8_WAIT_L(8); PG8_BAR; PG8_WAIT_L(0); PG8_MMA(0, 0, At, B0); PG8_BAR; PG8_SCHED;
            PG8_LDB(B1, 0, 1); PG8_STAGE(PG8_SB(0, 0), b2, voffB);
            PG8_BAR; PG8_WAIT_L(0); PG8_MMA(0, 1, At, B1); PG8_BAR;
            PG8_LDA(At, 0, 1); PG8_STAGE(PG8_SA(0, 0), a2, voffA);
            PG8_BAR; PG8_WAIT_L(0); PG8_MMA(1, 0, At, B0); PG8_BAR; PG8_SCHED;
            PG8_STAGE(PG8_SB(0, 1), b2 + hstepB, voffB);
            PG8_WAIT_V(6); PG8_BAR; PG8_MMA(1, 1, At, B1); PG8_BAR;
            PG8_LDB(B0, 1, 0); PG8_SCHED; PG8_LDA(At, 1, 0); PG8_STAGE(PG8_SA(0, 1), a2 + hstepA, voffA);
            PG8_WAIT_L(8); PG8_BAR; PG8_WAIT_L(0); PG8_MMA(0, 0, At, B0); PG8_BAR; PG8_SCHED;
            PG8_LDB(B1, 1, 1); PG8_STAGE(PG8_SB(1, 0), b3, voffB);
            PG8_BAR; PG8_WAIT_L(0); PG8_MMA(0, 1, At, B1); PG8_BAR;
            PG8_LDA(At, 1, 1); PG8_STAGE(PG8_SA(1, 0), a3, voffA);
            PG8_BAR; PG8_WAIT_L(0); PG8_MMA(1, 0, At, B0); PG8_BAR; PG8_SCHED;
            PG8_STAGE(PG8_SB(1, 1), b3 + hstepB, voffB);
            PG8_WAIT_V(6); PG8_BAR; PG8_MMA(1, 1, At, B1); PG8_BAR;
            }
        }
        if constexpr (ALIGN_EPI) { if (wr == 0) PG8_BAR; }
        if constexpr (!Epi::AFTER_DRAIN) { E(acc, cur, wr, wc, fr, fq); S.done(cur); }
        if (!has_next) break;
#pragma unroll
        for (int a = 0; a < 2; ++a)
#pragma unroll
            for (int b = 0; b < 2; ++b)
#pragma unroll
                for (int m = 0; m < 4; ++m)
#pragma unroll
                    for (int n = 0; n < 2; ++n) acc[a][b][m][n] = (f32x4){0.f, 0.f, 0.f, 0.f};
        cur = nxt; cA = nA; cB = nB; ++ui;
        if constexpr (ALIGN_EPI) { if (wr == 1) PG8_BAR; }
    }
    PG8_WAIT_V(0);
    if constexpr (!ALIGN_EPI) { if (wr == 0) PG8_BAR; }
    PG8_BAR;
    if constexpr (Epi::AFTER_DRAIN) { E.fused(acc, cur, wr, wc, fr, fq, lds, wid, lane); S.done(cur); }
#undef PG8_SA
#undef PG8_SB
#undef PG8_STAGE
#undef PG8_LDA
#undef PG8_LDB
#undef PG8_MMA
#undef PG8_WAIT_V
#undef PG8_WAIT_L
#undef PG8_BAR
#undef PG8_SCHED
}
}
namespace att {
constexpr int D = 128, NW = 8, QBLK = 32, KVBLK = 64;
constexpr float SCALE = 0.088388347648318440f;
constexpr float THR = 8.f;
constexpr size_t SHM_V = KVBLK * D * 2, SHM_K = KVBLK * D * 2, SHM_ATTN = 2 * SHM_V + 2 * SHM_K + NW * 64 * 4;
constexpr size_t SHM_RPB = SHM_ATTN;
#define KSWZ(row, colB) ((row) * 256 + ((colB) ^ (((row) & 7) << 4)))
#define SBAR() __builtin_amdgcn_sched_barrier(0)
DI int crow(int r, int hi) { return (r & 3) + 8 * (r >> 2) + 4 * hi; }
DI unsigned cvtpk(float lo, float hi) { unsigned r; asm volatile("v_cvt_pk_bf16_f32 %0, %1, %2" : "=v"(r) : "v"(lo), "v"(hi)); return r; }

struct NaCtx { int jlo; int dr0; int cq; int cs; const float* rpb; };

template <bool NA> DI void mask_bias(f32x16& p0, f32x16& p1, int j, const NaCtx& c, int hi) {
  if constexpr (NA) {
    const bool tv = (unsigned)(j - c.jlo) < 8u;
    int ri = c.dr0 + j + 7; ri = ri < 0 ? 0 : (ri > 14 ? 14 : ri);
    int boff = ri * 32 + 15 - c.cq + 4 * hi, t = 4 * hi - c.cs;
    asm volatile("" : "+v"(boff), "+v"(t));
    const float* bp = c.rpb + boff;
#pragma unroll
    for (int q4 = 0; q4 < 4; ++q4) {
#pragma unroll
      for (int rr = 0; rr < 4; ++rr) { const int r = 4 * q4 + rr;
        const int k0 = (r & 3) + 8 * (r >> 2);
        const bool ok0 = tv && ((unsigned)(t + k0) < 16u), ok1 = tv && ((unsigned)(t + k0 + 32) < 16u);
        const float b0 = bp[k0], b1 = bp[k0 + 32];
        p0[r] = ok0 ? p0[r] + b0 : -INFINITY; p1[r] = ok1 ? p1[r] + b1 : -INFINITY; }
      __builtin_amdgcn_sched_barrier(0);
    }
  }
}
DI void partialSM(f32x16& p0, f32x16& p1, float& m_reg, float& mn, float& alpha) {
  constexpr float C = SCALE * 1.4426950408889634f;
  float pmax = p0[0];
#pragma unroll
  for (int r = 1; r < 16; ++r) pmax = fmaxf(pmax, p0[r]);
#pragma unroll
  for (int r = 0; r < 16; ++r) pmax = fmaxf(pmax, p1[r]);
  { auto rr = __builtin_amdgcn_permlane32_swap(__float_as_uint(pmax), __float_as_uint(pmax), false, false);
    pmax = fmaxf(__uint_as_float(rr[0]), __uint_as_float(rr[1])); }
  if (__builtin_expect(__all(pmax - m_reg <= THR / SCALE), 1)) { mn = m_reg; alpha = 1.f; }
  else { mn = fmaxf(m_reg, pmax); alpha = __builtin_amdgcn_exp2f((m_reg - mn) * C); m_reg = mn; }
  float mnC = -mn * C;
#pragma unroll
  for (int r = 0; r < 16; ++r) p0[r] = fmaf(p0[r], C, mnC);
#pragma unroll
  for (int r = 0; r < 16; ++r) p1[r] = fmaf(p1[r], C, mnC);
#pragma unroll
  for (int r = 0; r < 16; ++r) p0[r] = __builtin_amdgcn_exp2f(p0[r]);
}
DI void finishSM(f32x16& p0, f32x16& p1, float alpha, float& l_reg, bf16x8& pa0, bf16x8& pa1, bf16x8& pa2, bf16x8& pa3) {
#pragma unroll
  for (int r = 0; r < 16; ++r) p1[r] = __builtin_amdgcn_exp2f(p1[r]);
  float ps = 0;
#pragma unroll
  for (int r = 0; r < 16; ++r) ps += p0[r];
#pragma unroll
  for (int r = 0; r < 16; ++r) ps += p1[r];
  { auto rr = __builtin_amdgcn_permlane32_swap(__float_as_uint(ps), __float_as_uint(ps), false, false);
    ps = __uint_as_float(rr[0]) + __uint_as_float(rr[1]); }
  l_reg = l_reg * alpha + ps;
#define PK4(P, BASE, OUT) do { unsigned a0 = cvtpk(P[BASE + 0], P[BASE + 1]), a1 = cvtpk(P[BASE + 2], P[BASE + 3]);   \
    unsigned b0 = cvtpk(P[BASE + 4], P[BASE + 5]), b1 = cvtpk(P[BASE + 6], P[BASE + 7]);                              \
    auto r0 = __builtin_amdgcn_permlane32_swap(a0, b0, false, false); auto r1 = __builtin_amdgcn_permlane32_swap(a1, b1, false, false); \
    v4u w = {r0[0], r1[0], r0[1], r1[1]}; OUT = *reinterpret_cast<bf16x8*>(&w); } while (0)
  PK4(p0, 0, pa0); PK4(p0, 8, pa1); PK4(p1, 0, pa2); PK4(p1, 8, pa3);
#undef PK4
}
DI void qkt(f32x16& p0, f32x16& p1, const bf16* Ks, const bf16x8* qr, int r32, int hi) {
  p0 = f32x16{}; p1 = f32x16{};
#pragma unroll
  for (int d0 = 0; d0 < 8; ++d0) { int cb = (d0 * 16 + hi * 8) * 2;
    bf16x8 b0 = *reinterpret_cast<const bf16x8*>((const char*)Ks + KSWZ(r32, cb));
    bf16x8 b1 = *reinterpret_cast<const bf16x8*>((const char*)Ks + KSWZ(32 + r32, cb));
    p0 = __builtin_amdgcn_mfma_f32_32x32x16_bf16(b0, qr[d0], p0, 0, 0, 0);
    p1 = __builtin_amdgcn_mfma_f32_32x32x16_bf16(b1, qr[d0], p1, 0, 0, 0); }
}
DI int v_st(int k, int c) { const int kk = (k & ~0xC) | ((k & 4) << 1) | ((k & 8) >> 1); return ((kk >> 3) * 4 + (c >> 5)) * 512 + ((kk & 7) * 32 + (c & 31)) * 2; }
DI int v_rd_base(int lane) { return ((lane & 3) << 3) | (((lane >> 2) & 3) << 6) | (((lane >> 4) & 1) << 5) | (((lane >> 5) & 1) << 8); }
constexpr int v_rd_off(int d0, int ks, int half) { return d0 * 512 + ks * 4096 + half * 2048; }
template <int OFF> DI s16x4 tr_read(int vb) { s16x4 r; asm volatile("ds_read_b64_tr_b16 %0, %1 offset:%2" : "=&v"(r) : "v"(vb), "i"(OFF) : "memory"); return r; }
template <int D0> DI void pv_one(f32x16& od, int vb, bf16x8 pa0, bf16x8 pa1, bf16x8 pa2, bf16x8 pa3) {
  const s16x4 l0 = tr_read<v_rd_off(D0, 0, 0)>(vb), h0 = tr_read<v_rd_off(D0, 0, 1)>(vb), l1 = tr_read<v_rd_off(D0, 1, 0)>(vb), h1 = tr_read<v_rd_off(D0, 1, 1)>(vb);
  const s16x4 l2 = tr_read<v_rd_off(D0, 2, 0)>(vb), h2 = tr_read<v_rd_off(D0, 2, 1)>(vb), l3 = tr_read<v_rd_off(D0, 3, 0)>(vb), h3 = tr_read<v_rd_off(D0, 3, 1)>(vb);
  asm volatile("s_waitcnt lgkmcnt(0)" ::: "memory"); SBAR();
#define PK(L, H) (bf16x8){L[0], L[1], L[2], L[3], H[0], H[1], H[2], H[3]}
  od = __builtin_amdgcn_mfma_f32_32x32x16_bf16(pa0, PK(l0, h0), od, 0, 0, 0);
  od = __builtin_amdgcn_mfma_f32_32x32x16_bf16(pa1, PK(l1, h1), od, 0, 0, 0);
  od = __builtin_amdgcn_mfma_f32_32x32x16_bf16(pa2, PK(l2, h2), od, 0, 0, 0);
  od = __builtin_amdgcn_mfma_f32_32x32x16_bf16(pa3, PK(l3, h3), od, 0, 0, 0);
#undef PK
}
DI void pv_d0(f32x16* o, int vb, bf16x8 pa0, bf16x8 pa1, bf16x8 pa2, bf16x8 pa3) {
  pv_one<0>(o[0], vb, pa0, pa1, pa2, pa3); pv_one<1>(o[1], vb, pa0, pa1, pa2, pa3); pv_one<2>(o[2], vb, pa0, pa1, pa2, pa3); pv_one<3>(o[3], vb, pa0, pa1, pa2, pa3);
}
template <int LDQ, int LDK, int LDO, bool NA, int SDEPTH>
DI void attn_body(const bf16* __restrict__ Qb, const bf16* __restrict__ Kh, const bf16* __restrict__ Vh, bf16* __restrict__ Ob, int NT, char* lds, const NaCtx& nc, int wave_) {
  const int tid_ = tid_of(wave_);
  const int tid = tid_, wid = tid >> 6, lane = tid & 63, r32 = lane & 31, hi = lane >> 5;
  bf16* V_lds = (bf16*)lds; bf16* K_lds = (bf16*)(lds + 2 * SHM_V);
  float* ws = (float*)(lds + 2 * SHM_V + 2 * SHM_K) + wid * 64; float* li_l = ws; float* al_l = ws + 32;
  float m_reg = -1e30f, l_reg = 0; f32x16 o[4] = {}; bf16x8 qr[8];
  const bf16* Qw = Qb + (long)(wid * QBLK + r32) * LDQ + hi * 8;
#pragma unroll
  for (int d0 = 0; d0 < 8; ++d0) qr[d0] = *reinterpret_cast<const bf16x8*>(Qw + d0 * 16);
  const int sr = tid >> 4, sc = (tid & 15) * 8, vst0 = v_st(sr, sc), vst1 = v_st(32 + sr, sc);
  const int vb0 = (int)(uintptr_t)V_lds + v_rd_base(lane);
  struct { bf16x8 vs0, vs1, ks0, ks1; } sr_[SDEPTH];
#define SLOAD(i, k0) do { sr_[i].vs0 = *reinterpret_cast<const bf16x8*>(&Vh[(long)((k0) + sr) * LDK + sc]); sr_[i].vs1 = *reinterpret_cast<const bf16x8*>(&Vh[(long)((k0) + 32 + sr) * LDK + sc]); \
    sr_[i].ks0 = *reinterpret_cast<const bf16x8*>(&Kh[(long)((k0) + sr) * LDK + sc]); sr_[i].ks1 = *reinterpret_cast<const bf16x8*>(&Kh[(long)((k0) + 32 + sr) * LDK + sc]); } while (0)
#define SWRITE(b, i) do { *(bf16x8*)((char*)V_lds + (b) * SHM_V + vst0) = sr_[i].vs0;          \
    *(bf16x8*)((char*)V_lds + (b) * SHM_V + vst1) = sr_[i].vs1; int kc = sc * 2;               \
    *(bf16x8*)((char*)K_lds + (b) * SHM_K + KSWZ(sr, kc)) = sr_[i].ks0;                       \
    *(bf16x8*)((char*)K_lds + (b) * SHM_K + KSWZ(32 + sr, kc)) = sr_[i].ks1; } while (0)
#define SWAIT() do { if constexpr (SDEPTH == 2) asm volatile("s_waitcnt vmcnt(4)" ::: "memory"); else asm volatile("s_waitcnt vmcnt(0)" ::: "memory"); } while (0)
#define RESC(a) do { if (__any((a) < 1.f)) { if (hi == 0) al_l[r32] = (a); asm volatile("s_waitcnt lgkmcnt(0)" ::: "memory"); \
    _Pragma("unroll") for (int d = 0; d < 4; ++d) _Pragma("unroll") for (int r = 0; r < 16; ++r) o[d][r] *= al_l[crow(r, hi)]; } } while (0)
  f32x16 pA0, pA1, pB0, pB1; float mnA, mnB, alA, alB; bf16x8 pa0, pa1, pa2, pa3;
  constexpr int SE = 0, SO = SDEPTH - 1;
  SLOAD(SE, 0); asm volatile("s_waitcnt vmcnt(0)" ::: "memory"); SWRITE(0, SE); __syncthreads();
  qkt(pA0, pA1, K_lds, qr, r32, hi); mask_bias<NA>(pA0, pA1, 0, nc, hi); partialSM(pA0, pA1, m_reg, mnA, alA);
  SLOAD(SO, KVBLK); if constexpr (SDEPTH == 2) { if (2 < NT) SLOAD(SE, 2 * KVBLK); }
  SWAIT(); SWRITE(1, SO); __syncthreads();
  for (int j = 1; j + 1 < NT; j += 2) {
    SBAR(); qkt(pB0, pB1, (bf16*)((char*)K_lds + SHM_K), qr, r32, hi); mask_bias<NA>(pB0, pB1, j, nc, hi);
    finishSM(pA0, pA1, alA, l_reg, pa0, pa1, pa2, pa3); SBAR();
    SLOAD(SO, (j + SDEPTH) * KVBLK); SBAR();
    pv_d0(o, vb0, pa0, pa1, pa2, pa3); partialSM(pB0, pB1, m_reg, mnB, alB);
    __syncthreads(); SWAIT(); SWRITE(0, SE);
    RESC(alB); __syncthreads();
    SBAR(); qkt(pA0, pA1, K_lds, qr, r32, hi); mask_bias<NA>(pA0, pA1, j + 1, nc, hi);
    finishSM(pB0, pB1, alB, l_reg, pa0, pa1, pa2, pa3); SBAR();
    if (SDEPTH == 1 || j + 3 < NT) SLOAD(SE, (j + 1 + SDEPTH) * KVBLK); SBAR();
    pv_d0(o, vb0 + (int)SHM_V, pa0, pa1, pa2, pa3); partialSM(pA0, pA1, m_reg, mnA, alA);
    __syncthreads(); SWAIT(); SWRITE(1, SO);
    RESC(alA); __syncthreads();
  }
  SBAR(); qkt(pB0, pB1, (bf16*)((char*)K_lds + SHM_K), qr, r32, hi); mask_bias<NA>(pB0, pB1, NT - 1, nc, hi);
  finishSM(pA0, pA1, alA, l_reg, pa0, pa1, pa2, pa3); SBAR();
  pv_d0(o, vb0, pa0, pa1, pa2, pa3); partialSM(pB0, pB1, m_reg, mnB, alB);
  __syncthreads(); RESC(alB);
  finishSM(pB0, pB1, alB, l_reg, pa0, pa1, pa2, pa3); SBAR();
  pv_d0(o, vb0 + (int)SHM_V, pa0, pa1, pa2, pa3);
  if (hi == 0) li_l[r32] = l_reg; asm volatile("s_waitcnt lgkmcnt(0)" ::: "memory");
  float rli[16];
#pragma unroll
  for (int r = 0; r < 16; ++r) rli[r] = __builtin_amdgcn_rcpf(li_l[crow(r, hi)]);
  bf16* Ow = Ob + (long)(wid * QBLK) * LDO;
#pragma unroll
  for (int r = 0; r < 16; ++r) { int orow = crow(r, hi);
#pragma unroll
    for (int d0 = 0; d0 < 4; ++d0) Ow[(long)orow * LDO + d0 * 32 + r32] = f2bf(o[d0][r] * rli[r]); }
  __syncthreads();
#undef SLOAD
#undef SWRITE
#undef SWAIT
#undef RESC
}
#undef KSWZ
#undef SBAR
}
#define XB_TMO      128
#define XB_XCNT(j)  (256  + 64 * (j))
#define XB_XSUB(j)  (1280 + 64 * (j))
#define XB_XGEN(j)  (2304 + 64 * (j))
#define XB_TOP      3328
#define XB_TOPGEN   3392
#define XCD_BAR_WORDS 3456
#define XB_SPIN_CAP (1u << 18)

__device__ __forceinline__ unsigned xb_ld(unsigned* p)              { return __hip_atomic_load(p, __ATOMIC_RELAXED, __HIP_MEMORY_SCOPE_AGENT); }
__device__ __forceinline__ unsigned xb_add(unsigned* p, unsigned v) { return __hip_atomic_fetch_add(p, v, __ATOMIC_RELAXED, __HIP_MEMORY_SCOPE_AGENT); }
__device__ __forceinline__ unsigned xb_xcc_id() { return (unsigned)__builtin_amdgcn_s_getreg((3 << 11) | 20) & 0xFu; }
#define XB_SPIN(cond, bar) do { unsigned _sp = 0; while (cond) { __builtin_amdgcn_s_sleep(1); \
    if ((++_sp & 255u) == 0u) { if (xb_ld(&(bar)[XB_TMO])) break; if (_sp > XB_SPIN_CAP) { atomicAdd(&(bar)[XB_TMO], 1u); break; } } } } while (0)

struct XcdBarrier {
    unsigned* bar; unsigned x; int wave;
    volatile LAS unsigned* st;
};

__device__ __forceinline__ XcdBarrier xcd_barrier_post(unsigned* bar, volatile LAS unsigned* st, int wave) {
    XcdBarrier b; b.bar = bar; b.x = xb_xcc_id(); b.st = st; b.wave = wave;
    if (wave == 0 && lane_id() == 0) (void)xb_add(&bar[XB_XCNT(b.x)], 1u);
    return b;
}
__device__ __forceinline__ void xcd_barrier_complete(unsigned* bar, unsigned x, unsigned& nloc, unsigned& nx) {
    const unsigned G = gridDim.x * gridDim.y * gridDim.z;
    unsigned sum, cnt, mine, sp = 0u;
    for (;;) {
        sum = 0u; cnt = 0u; mine = 0u;
#pragma unroll
        for (unsigned j = 0; j < 16; ++j) { const unsigned c = xb_ld(&bar[XB_XCNT(j)]); sum += c; cnt += (c > 0u) ? 1u : 0u; mine = (j == x) ? c : mine; }
        if (sum == G) break;
        __builtin_amdgcn_s_sleep(1);
        if ((++sp & 255u) == 0u) { if (xb_ld(&bar[XB_TMO])) break; if (sp > XB_SPIN_CAP) { atomicAdd(&bar[XB_TMO], 1u); break; } }
    }
    nloc = mine > 0u ? mine : 1u; nx = cnt > 0u ? cnt : 1u;
}

__device__ __forceinline__ void xcd_barrier(const XcdBarrier& b) {
    asm volatile("s_waitcnt vmcnt(0)" ::: "memory");
    __syncthreads();
    if (b.wave == 0 && lane_id() == 0) {
        unsigned* bar = b.bar;
        __builtin_amdgcn_s_waitcnt(0);
        unsigned nloc = b.st[0], nx = b.st[1];
        if (nloc == 0u) { xcd_barrier_complete(bar, b.x, nloc, nx); b.st[0] = nloc; b.st[1] = nx; }
        const unsigned old = xb_add(&bar[XB_XSUB(b.x)], 1u);
        const unsigned gen = old / nloc;
        if (old + 1u == (gen + 1u) * nloc) {
            __builtin_amdgcn_fence(__ATOMIC_RELEASE, "agent");
            asm volatile("s_waitcnt vmcnt(0)" ::: "memory");
            const unsigned og = xb_add(&bar[XB_TOP], 1u);
            const unsigned tg = og / nx;
            if (og + 1u == (tg + 1u) * nx) xb_add(&bar[XB_TOPGEN], 1u);
            else XB_SPIN(xb_ld(&bar[XB_TOPGEN]) == tg, bar);
            __builtin_amdgcn_fence(__ATOMIC_ACQUIRE, "agent");
            xb_add(&bar[XB_XGEN(b.x)], 1u);
            asm volatile("s_waitcnt vmcnt(0)" ::: "memory");
        } else {
            XB_SPIN(xb_ld(&bar[XB_XGEN(b.x)]) == gen, bar);
            __builtin_amdgcn_fence(__ATOMIC_ACQUIRE, "agent");
            asm volatile("s_waitcnt vmcnt(0)" ::: "memory");
        }
    }
    __syncthreads();
}
struct Ctx { int tid, lane, wave, G, blk; int gw, ngw; };

DI void tr_item(const float* __restrict__ W, int ldw, int K, bf16* __restrict__ WT, int k0, int n0, int drow0, LAS float* scr, int lane) {
#pragma unroll 8
    for (int i = 0; i < 32; ++i) { const int kk = 2 * i + (lane >> 5); scr[kk * 33 + (lane & 31)] = W[(size_t)(k0 + kk) * ldw + n0 + (lane & 31)]; }
    LDS_WAIT(); asm volatile("" ::: "memory");
    const int c = lane & 7;
#pragma unroll
    for (int j = 0; j < 4; ++j) { const int n = (lane >> 3) + 8 * j; const LAS float* s = scr + (8 * c) * 33 + n;
        v4u o; o.x = pk2(s[0 * 33], s[1 * 33]); o.y = pk2(s[2 * 33], s[3 * 33]); o.z = pk2(s[4 * 33], s[5 * 33]); o.w = pk2(s[6 * 33], s[7 * 33]);
        *(v4u*)(WT + (size_t)(drow0 + n) * K + k0 + 8 * c) = o; }
    LDS_WAIT(); asm volatile("" ::: "memory");
}
struct WPtrs { const float *w_in, *w_br, *w_out, *w_up, *w_dn; bf16 *t_in, *t_br, *t_out, *t_up, *t_dn; };
DI void convert_weights(const Ctx& F, const WPtrs& P, LAS unsigned char* lds) {
    LAS float* scr = (LAS float*)(lds + F.wave * 8704);
    constexpr int I_IN = 32 * (NIN / 32), I_BR = 32 * 64, I_OUT = 32 * 64, I_UP = 32 * (NUP / 32), I_DN = (DFF / 64) * 64;
    constexpr int NITEMS = I_IN + I_BR + I_OUT + I_UP + I_DN;
    for (int it = F.gw; it < NITEMS; it += F.ngw) {
        int r = it;
        if (r < I_IN) { const int nblk = NIN / 32, kb = r / nblk, nb = r % nblk, n0 = nb * 32; tr_item(P.w_in, NIN, DM, P.t_in, kb * 64, n0, n0 < GATE_SRC0 ? n0 : n0 + (GATE_DST0 - GATE_SRC0), scr, F.lane); continue; } r -= I_IN;
        if (r < I_BR) { const int kb = r / 64, nb = r % 64; tr_item(P.w_br, DM, DM, P.t_br, kb * 64, nb * 32, nb * 32, scr, F.lane); continue; } r -= I_BR;
        if (r < I_OUT) { const int kb = r / 64, nb = r % 64; tr_item(P.w_out, DM, DM, P.t_out, kb * 64, nb * 32, nb * 32, scr, F.lane); continue; } r -= I_OUT;
        if (r < I_UP) { const int nblk = NUP / 32, kb = r / nblk, nb = r % nblk; tr_item(P.w_up, NUP, DM, P.t_up, kb * 64, nb * 32, nb * 32, scr, F.lane); continue; } r -= I_UP;
        { const int kb = r / 64, nb = r % 64; tr_item(P.w_dn, DM, DFF, P.t_dn, kb * 64, nb * 32, nb * 32, scr, F.lane); }
    }
}
DI void rmsnorm_rows(const Ctx& F, const float* __restrict__ x, const float* __restrict__ w, bf16* __restrict__ out, int rows) {
    for (int m = F.gw; m < rows; m += F.ngw) {
        const f32x4* xr = (const f32x4*)(x + (size_t)m * DM) + F.lane;
        f32x4 v[8]; float s = 0.f;
#pragma unroll
        for (int j = 0; j < 8; ++j) { v[j] = xr[64 * j]; s += (v[j].x * v[j].x + v[j].y * v[j].y) + (v[j].z * v[j].z + v[j].w * v[j].w); }
        const float rstd = 1.f / sqrtf(wave_sum(s) * (1.f / DM) + EPSN);
        v2u* o8 = (v2u*)(out + (size_t)m * DM) + F.lane;
#pragma unroll
        for (int j = 0; j < 8; ++j) { const f32x4 wv = ((const f32x4*)w)[F.lane + 64 * j];
            v2u o; o.x = pk2(v[j].x * rstd * wv.x, v[j].y * rstd * wv.y); o.y = pk2(v[j].z * rstd * wv.z, v[j].w * rstd * wv.w); o8[64 * j] = o; }
    }
}
struct PrepPtrs { bf16 *qna, *kna, *gq, *gk; const float *nq_na, *nk_na, *nq_g, *nk_g; };
DI void prep_qk(const Ctx& F, const PrepPtrs& P, int L) {
    const int sub = F.lane >> 4, j = F.lane & 15;
    const int a = j >> 3, b = (j >> 2) & 1, f0 = (j & 3) * 8;
    float wq_na[8], wk_na[8], wq_g[8], wk_g[8], invf[8];
#pragma unroll
    for (int e = 0; e < 8; ++e) { wq_na[e] = P.nq_na[j * 8 + e]; wk_na[e] = P.nk_na[j * 8 + e]; wq_g[e] = P.nq_g[j * 8 + e]; wk_g[e] = P.nk_g[j * 8 + e];
        invf[e] = exp2f(-(float)(f0 + e) * (13.287712379549449f / 32.f)); }
    for (int tok = F.gw * 4 + sub; tok < MG; tok += F.ngw * 4) {
        const int t = tok & (L - 1); const float pos = (float)(a ? (t & 63) : (t >> 6));
        float cs[8], sn[8];
#pragma unroll
        for (int e = 0; e < 8; ++e) { float rev = pos * invf[e] * 0.15915494309189535f; rev -= floorf(rev); sn[e] = __builtin_amdgcn_sinf(rev); cs[e] = __builtin_amdgcn_cosf(rev); }
#pragma unroll
        for (int v = 0; v < 14; ++v) {
            bf16* p; const float* w; bool rope;
            if (v < 4)       { p = P.qna + (size_t)tok * 512 + v * 128;        w = wq_na; rope = false; }
            else if (v < 8)  { p = P.kna + (size_t)tok * 512 + (v - 4) * 128;  w = wk_na; rope = false; }
            else if (v < 12) { p = P.gq + (size_t)tok * 512 + (v - 8) * 128;   w = wq_g;  rope = true; }
            else             { p = P.gk + (size_t)tok * 256 + (v - 12) * 128;  w = wk_g;  rope = true; }
            p += j * 8;
            float x[8]; unpack8(*(const v4u*)p, x);
            float ss = 0.f;
#pragma unroll
            for (int e = 0; e < 8; ++e) ss += x[e] * x[e];
            ss += xor_lane<1>(ss); ss += xor_lane<2>(ss); ss += xor_lane<4>(ss); ss += xor_lane<8>(ss);
            const float rstd = 1.f / sqrtf(ss * (1.f / 128.f) + EPSN);
            float y[8];
#pragma unroll
            for (int e = 0; e < 8; ++e) y[e] = x[e] * rstd * w[e];
            if (rope) {
#pragma unroll
                for (int e = 0; e < 8; ++e) { const float pr = xor_lane<4>(y[e]); y[e] = b ? (pr * sn[e] + y[e] * cs[e]) : (y[e] * cs[e] - pr * sn[e]); }
            }
            *(v4u*)p = pack8(y);
        }
    }
}
DI void prep_xbc(const Ctx& F, const bf16* __restrict__ src, bf16* __restrict__ dst, const float* __restrict__ cw, const float* __restrict__ cb, int L) {
    constexpr int NIT = (MG / 16) * 3;
    for (int it = F.gw; it < NIT; it += F.ngw) {
        const int tb = it / 3, cs = it % 3, c0 = cs * 512 + F.lane * 8, tok0 = tb * 16, slo = tok0 & ~(L - 1), shi = slo + L;
        float w[5][8], bias[8];
#pragma unroll
        for (int i = 0; i < 5; ++i) { const f32x4 a = *(const f32x4*)(cw + i * 1536 + c0), bq = *(const f32x4*)(cw + i * 1536 + c0 + 4);
            w[i][0] = a.x; w[i][1] = a.y; w[i][2] = a.z; w[i][3] = a.w; w[i][4] = bq.x; w[i][5] = bq.y; w[i][6] = bq.z; w[i][7] = bq.w; }
        { const f32x4 a = *(const f32x4*)(cb + c0), bq = *(const f32x4*)(cb + c0 + 4); bias[0] = a.x; bias[1] = a.y; bias[2] = a.z; bias[3] = a.w; bias[4] = bq.x; bias[5] = bq.y; bias[6] = bq.z; bias[7] = bq.w; }
        float r[5][8];
#define LDROW(dstr, tk) do { const int t_ = (tk); if (t_ >= slo && t_ < shi) unpack8(*(const v4u*)(src + (size_t)t_ * 1536 + c0), dstr); else { _Pragma("unroll") for (int e = 0; e < 8; ++e) dstr[e] = 0.f; } } while (0)
        LDROW(r[0], tok0 - 2); LDROW(r[1], tok0 - 1); LDROW(r[2], tok0); LDROW(r[3], tok0 + 1);
#pragma unroll
        for (int k = 0; k < 16; ++k) {
            LDROW(r[4], tok0 + k + 2);
            float y[8];
#pragma unroll
            for (int e = 0; e < 8; ++e) { float s = bias[e] + r[0][e] * w[0][e] + r[1][e] * w[1][e] + r[2][e] * w[2][e] + r[3][e] * w[3][e] + r[4][e] * w[4][e]; y[e] = siluf_(s); }
            *(v4u*)(dst + (size_t)(tok0 + k) * 1536 + c0) = pack8(y);
#pragma unroll
            for (int e = 0; e < 8; ++e) { r[0][e] = r[1][e]; r[1][e] = r[2][e]; r[2][e] = r[3][e]; r[3][e] = r[4][e]; }
        }
#undef LDROW
    }
}
DI void ffn_act(const Ctx& F, const bf16* __restrict__ U, bf16* __restrict__ act, const float* __restrict__ cw, const float* __restrict__ cb, int L) {
    constexpr int NS = DFF / 512, NIT = (MG / 16) * NS;
    for (int it = F.gw; it < NIT; it += F.ngw) {
        const int tb = it / NS, cs = it % NS, c0 = cs * 512 + F.lane * 8, tok0 = tb * 16, slo = tok0 & ~(L - 1), shi = slo + L;
        float w[3][8], bias[8];
#pragma unroll
        for (int i = 0; i < 3; ++i) { const f32x4 a = *(const f32x4*)(cw + i * DFF + c0), bq = *(const f32x4*)(cw + i * DFF + c0 + 4);
            w[i][0] = a.x; w[i][1] = a.y; w[i][2] = a.z; w[i][3] = a.w; w[i][4] = bq.x; w[i][5] = bq.y; w[i][6] = bq.z; w[i][7] = bq.w; }
        { const f32x4 a = *(const f32x4*)(cb + c0), bq = *(const f32x4*)(cb + c0 + 4); bias[0] = a.x; bias[1] = a.y; bias[2] = a.z; bias[3] = a.w; bias[4] = bq.x; bias[5] = bq.y; bias[6] = bq.z; bias[7] = bq.w; }
        float r[3][8];
#define LDROW(dstr, tk) do { const int t_ = (tk); if (t_ >= slo && t_ < shi) unpack8(*(const v4u*)(U + (size_t)t_ * NUP + c0), dstr); else { _Pragma("unroll") for (int e = 0; e < 8; ++e) dstr[e] = 0.f; } } while (0)
        LDROW(r[0], tok0 - 1); LDROW(r[1], tok0);
#pragma unroll
        for (int k = 0; k < 16; ++k) {
            LDROW(r[2], tok0 + k + 1);
            float vv[8]; unpack8(*(const v4u*)(U + (size_t)(tok0 + k) * NUP + DFF + c0), vv);
            float y[8];
#pragma unroll
            for (int e = 0; e < 8; ++e) { float s = bias[e] + r[0][e] * w[0][e] + r[1][e] * w[1][e] + r[2][e] * w[2][e]; y[e] = siluf_(s) * vv[e]; }
            *(v4u*)(act + (size_t)(tok0 + k) * DFF + c0) = pack8(y);
#pragma unroll
            for (int e = 0; e < 8; ++e) { r[0][e] = r[1][e]; r[1][e] = r[2][e]; }
        }
#undef LDROW
    }
}
namespace ssd {
constexpr int IMG = 32768;
DI unsigned off_b(unsigned row, unsigned ch) { return 256u * row + 16u * (ch ^ (((row & 3) << 2) | ((row >> 2) & 3))); }
DI bf16x8 row_read(const LAS unsigned char* img, unsigned lane, unsigned rowbase, unsigned s) {
    return *(const LAS bf16x8*)(img + off_b(rowbase + (lane & 31), 2 * s + (lane >> 5)));
}
DI s16x4 tr_read4(const LAS unsigned char* img, unsigned lane, unsigned r0, unsigned c) {
    const unsigned blk = (lane >> 4) & 1, q = (lane & 15) >> 2, p = lane & 3;
    const LAS unsigned char* a = img + off_b(r0 + q, 4 * c + 2 * blk + (p >> 1)) + 8 * (p & 1);
    return __builtin_bit_cast(s16x4, __builtin_amdgcn_ds_read_tr16_b64_v4i16((LAS s16x4*)a));
}
DI bf16x8 cat8(s16x4 lo, s16x4 hi) { return (bf16x8){lo[0], lo[1], lo[2], lo[3], hi[0], hi[1], hi[2], hi[3]}; }
DI int crow(int r, int hi) { return (r & 3) + 8 * (r >> 2) + 4 * hi; }
DI void stage_img(LAS unsigned char* img, const bf16* __restrict__ src, int ld, int tid) {
#pragma unroll
    for (int i = 0; i < 4; ++i) { const int id = tid + 512 * i, row = id >> 4, ch = id & 15;
        const v4u v = *(const v4u*)(src + (size_t)row * ld + ch * 8);
        *(LAS v4u*)(img + off_b(row, ch)) = v; }
}
DI float softplusf_(float x) { return x > 20.f ? x : log1pf(__expf(x)); }
DI void dt_cum(const float* __restrict__ DT, int rowbase, int h, int dir, float bias, float a, int lane, float& dt0, float& dt1, float& c0, float& c1, float& tot) {
    const float r0 = DT[(size_t)(rowbase + 2 * lane) * 32 + dir * 16 + h], r1 = DT[(size_t)(rowbase + 2 * lane + 1) * 32 + dir * 16 + h];
    dt0 = softplusf_(r0 + bias); dt1 = softplusf_(r1 + bias);
    const float d0 = dt0 * a, d1 = dt1 * a;
    const float sc = wave_scan_incl(d0 + d1);
    tot = __int_as_float(__builtin_amdgcn_readlane(__float_as_int(sc), 63));
    if (dir == 0) { c1 = sc; c0 = sc - d1; }
    else { c1 = tot - sc + d1; c0 = tot - sc + d1 + d0; }
}
struct Ptrs {
    const bf16* xbca;
    const float* dt;
    const bf16* z;
    bf16* states;
    float* dec;
    bf16* o;
    float* ys;
    const float *dt_bias, *a_log, *dskip, *norm_w;
};
constexpr int L_B = 0, L_C = IMG, L_X0 = 2 * IMG, L_X1 = 3 * IMG, L_ARR = 4 * IMG, L_SSQ = 4 * IMG + 8192;

DI void s1_unit(const Ptrs& P, LAS unsigned char* lds, int c, int g, int tid) {
    const int lane = tid & 63, w = __builtin_amdgcn_readfirstlane(tid >> 6), hl = w >> 1, nh = w & 1, hh = lane >> 5, r = lane & 31;
    const int rowbase = c * 128;
    __syncthreads();
    stage_img(lds + L_B, P.xbca + (size_t)rowbase * 1536 + 1024 + g * 128, 1536, tid);
#pragma unroll 1
    for (int quad = 0; quad < 2; ++quad) {
        const int hq = 8 * g + 4 * quad;
        if (quad) __syncthreads();
        stage_img(lds + L_X0, P.xbca + (size_t)rowbase * 1536 + hq * 64, 1536, tid);
        stage_img(lds + L_X1, P.xbca + (size_t)rowbase * 1536 + hq * 64 + 128, 1536, tid);
        {
            const int h = hq + hl, dir = nh; float dt0, dt1, c0, c1, tot;
            dt_cum(P.dt, rowbase, h, dir, P.dt_bias[dir * 16 + h], -__expf(P.a_log[dir * 16 + h]), lane, dt0, dt1, c0, c1, tot);
            LAS float* wg = (LAS float*)(lds + L_ARR) + (hl * 2 + dir) * 128;
            wg[2 * lane] = dt0 * __expf(tot - c0); wg[2 * lane + 1] = dt1 * __expf(tot - c1);
            if (lane == 0) P.dec[(size_t)(c * 2 + dir) * 16 + h] = __expf(tot);
        }
        __syncthreads();
        const LAS unsigned char* ximg = lds + (hl >> 1 ? L_X1 : L_X0);
        const int h = hq + hl;
#pragma unroll 1
        for (int dir = 0; dir < 2; ++dir) {
            const LAS float* wg = (const LAS float*)(lds + L_ARR) + (hl * 2 + dir) * 128;
            f32x16 acc[2][2];
#pragma unroll
            for (int i = 0; i < 2; ++i)
#pragma unroll
                for (int k = 0; k < 2; ++k) acc[i][k] = f32x16{};
#pragma unroll 2
            for (int ks = 0; ks < 8; ++ks) {
                bf16x8 af[2], bfr[2];
#pragma unroll
                for (int nb = 0; nb < 2; ++nb) af[nb] = cat8(tr_read4(lds + L_B, lane, 16 * ks + 8 * hh, 2 * nh + nb), tr_read4(lds + L_B, lane, 16 * ks + 8 * hh + 4, 2 * nh + nb));
                const f32x4 w0 = *(const LAS f32x4*)(wg + 16 * ks + 8 * hh), w1 = *(const LAS f32x4*)(wg + 16 * ks + 8 * hh + 4);
#pragma unroll
                for (int pb = 0; pb < 2; ++pb) {
                    const s16x4 lo = tr_read4(ximg, lane, 16 * ks + 8 * hh, 2 * (hl & 1) + pb), hi4 = tr_read4(ximg, lane, 16 * ks + 8 * hh + 4, 2 * (hl & 1) + pb);
                    v4u pk; pk.x = pk2(bf2f((unsigned short)lo[0]) * w0.x, bf2f((unsigned short)lo[1]) * w0.y); pk.y = pk2(bf2f((unsigned short)lo[2]) * w0.z, bf2f((unsigned short)lo[3]) * w0.w);
                    pk.z = pk2(bf2f((unsigned short)hi4[0]) * w1.x, bf2f((unsigned short)hi4[1]) * w1.y); pk.w = pk2(bf2f((unsigned short)hi4[2]) * w1.z, bf2f((unsigned short)hi4[3]) * w1.w);
                    bfr[pb] = __builtin_bit_cast(bf16x8, pk);
                }
#pragma unroll
                for (int nb = 0; nb < 2; ++nb)
#pragma unroll
                    for (int pb = 0; pb < 2; ++pb) acc[nb][pb] = __builtin_amdgcn_mfma_f32_32x32x16_bf16(af[nb], bfr[pb], acc[nb][pb], 0, 0, 0);
            }
            bf16* sp = P.states + ((size_t)(c * 2 + dir) * 16 + h) * 8192;
#pragma unroll
            for (int nb = 0; nb < 2; ++nb)
#pragma unroll
                for (int pb = 0; pb < 2; ++pb)
#pragma unroll
                    for (int i4 = 0; i4 < 4; ++i4) { const int n0 = 64 * nh + 32 * nb + 8 * i4 + 4 * hh, p = 32 * pb + r;
                        v2u o; o.x = pk2(acc[nb][pb][4 * i4], acc[nb][pb][4 * i4 + 1]); o.y = pk2(acc[nb][pb][4 * i4 + 2], acc[nb][pb][4 * i4 + 3]);
                        *(v2u*)(sp + p * 128 + n0) = o; }
        }
    }
}
DI void scan_states(const Ctx& F, bf16* __restrict__ states, const float* __restrict__ dec, int nseq, int ncs) {
    const int ntask = nseq * 65536, nthr = F.G * 512;
    for (int task = F.blk * 512 + F.tid; task < ntask; task += nthr) {
        const int n4 = task & 31, p = (task >> 5) & 63, h = (task >> 11) & 15, dir = (task >> 15) & 1, s = task >> 16;
        const int cbase = s * ncs;
        float run[4] = {0.f, 0.f, 0.f, 0.f};
        for (int k0 = 0; k0 < ncs; k0 += 8) {
            v2u v[8]; float dc[8];
#pragma unroll
            for (int k = 0; k < 8; ++k) { const int cc = cbase + (dir ? ncs - 1 - (k0 + k) : (k0 + k));
                v[k] = *(const v2u*)(states + (((size_t)(cc * 2 + dir) * 16 + h) * 64 + p) * 128 + n4 * 4); dc[k] = dec[(size_t)(cc * 2 + dir) * 16 + h]; }
#pragma unroll
            for (int k = 0; k < 8; ++k) { const int cc = cbase + (dir ? ncs - 1 - (k0 + k) : (k0 + k));
                v2u o; o.x = pk2(run[0], run[1]); o.y = pk2(run[2], run[3]);
                *(v2u*)(states + (((size_t)(cc * 2 + dir) * 16 + h) * 64 + p) * 128 + n4 * 4) = o;
                run[0] = run[0] * dc[k] + bflo(v[k].x); run[1] = run[1] * dc[k] + bfhi(v[k].x); run[2] = run[2] * dc[k] + bflo(v[k].y); run[3] = run[3] * dc[k] + bfhi(v[k].y); }
        }
    }
}
template <int QUAD>
DI void s3_pass(const Ptrs& P, LAS unsigned char* lds, int c, int g, int tid) {
    const int lane = tid & 63, w = __builtin_amdgcn_readfirstlane(tid >> 6), hl = w >> 1, lh = w & 1, hh = lane >> 5, r = lane & 31;
    const int rowbase = c * 128, hq = 8 * g + 4 * QUAD, h = hq + hl;
    if (QUAD) __syncthreads();
    stage_img(lds + L_X0, P.xbca + (size_t)rowbase * 1536 + hq * 64, 1536, tid);
    stage_img(lds + L_X1, P.xbca + (size_t)rowbase * 1536 + hq * 64 + 128, 1536, tid);
    LAS float* arr = (LAS float*)(lds + L_ARR);
    {   const int dir = lh; float dt0, dt1, c0, c1, tot;
        dt_cum(P.dt, rowbase, h, dir, P.dt_bias[dir * 16 + h], -__expf(P.a_log[dir * 16 + h]), lane, dt0, dt1, c0, c1, tot);
        LAS float* a = arr + hl * 512;
        a[dir * 128 + 2 * lane] = dt0; a[dir * 128 + 2 * lane + 1] = dt1; a[(2 + dir) * 128 + 2 * lane] = c0; a[(2 + dir) * 128 + 2 * lane + 1] = c1; }
    __syncthreads();
    const LAS float* aD0 = arr + hl * 512, *aD1 = aD0 + 128, *aCF = aD0 + 256, *aCR = aD0 + 384;
    const LAS unsigned char* ximg = lds + (hl >> 1 ? L_X1 : L_X0);
    const bf16* pf = P.states + ((size_t)(c * 2 + 0) * 16 + h) * 8192, *pb_ = P.states + ((size_t)(c * 2 + 1) * 16 + h) * 8192;
    const float dsk = P.dskip[h];
    LAS float* ssq = (LAS float*)(lds + L_SSQ);
#pragma unroll 1
    for (int lb = 0; lb < 2; ++lb) {
        f32x16 acc[2];
        acc[0] = f32x16{}; acc[1] = f32x16{};
        const int l0 = 64 * lh + 32 * lb, l = l0 + r; const float cf_l = aCF[l], cr_l = aCR[l];
#pragma unroll 1
        for (int sb = 0; sb < 4; ++sb) {
            const int s0 = 32 * sb;
            f32x16 X = f32x16{};
#pragma unroll
            for (int ks = 0; ks < 8; ++ks) X = __builtin_amdgcn_mfma_f32_32x32x16_bf16(row_read(lds + L_B, lane, s0, ks), row_read(lds + L_C, lane, l0, ks), X, 0, 0, 0);
#pragma unroll
            for (int i = 0; i < 16; ++i) { const int s = s0 + crow(i, hh);
                float f = 0.f;
                if (s <= l) f += __expf(cf_l - aCF[s]) * aD0[s];
                if (s >= l) f += __expf(cr_l - aCR[s]) * aD1[s];
                X[i] *= f; }
#pragma unroll
            for (int sp = 0; sp < 2; ++sp) {
                v4u pk; pk.x = pk2(X[8 * sp], X[8 * sp + 1]); pk.y = pk2(X[8 * sp + 2], X[8 * sp + 3]); pk.z = pk2(X[8 * sp + 4], X[8 * sp + 5]); pk.w = pk2(X[8 * sp + 6], X[8 * sp + 7]);
                const bf16x8 af = __builtin_bit_cast(bf16x8, pk);
#pragma unroll
                for (int pb = 0; pb < 2; ++pb) {
                    const bf16x8 bfr = cat8(tr_read4(ximg, lane, s0 + 16 * sp + 4 * hh, 2 * (hl & 1) + pb), tr_read4(ximg, lane, s0 + 16 * sp + 8 + 4 * hh, 2 * (hl & 1) + pb));
                    acc[pb] = __builtin_amdgcn_mfma_f32_32x32x16_bf16(af, bfr, acc[pb], 0, 0, 0);
                }
            }
        }
        {
            const float ef = __expf(cf_l), eb = __expf(cr_l);
#pragma unroll 2
            for (int ks = 0; ks < 8; ++ks) {
                bf16x8 bF[2], bB[2];
#pragma unroll
                for (int pb = 0; pb < 2; ++pb) { bF[pb] = *(const bf16x8*)(pf + (32 * pb + r) * 128 + 16 * ks + 8 * hh); bB[pb] = *(const bf16x8*)(pb_ + (32 * pb + r) * 128 + 16 * ks + 8 * hh); }
                const bf16x8 cfr = row_read(lds + L_C, lane, l0, ks);
                float x[8]; unpack8(__builtin_bit_cast(v4u, cfr), x);
                float xf[8], xb[8];
#pragma unroll
                for (int e = 0; e < 8; ++e) { xf[e] = x[e] * ef; xb[e] = x[e] * eb; }
                const bf16x8 aF = __builtin_bit_cast(bf16x8, pack8(xf)), aB = __builtin_bit_cast(bf16x8, pack8(xb));
#pragma unroll
                for (int pb = 0; pb < 2; ++pb) { acc[pb] = __builtin_amdgcn_mfma_f32_32x32x16_bf16(aF, bF[pb], acc[pb], 0, 0, 0);
                    acc[pb] = __builtin_amdgcn_mfma_f32_32x32x16_bf16(aB, bB[pb], acc[pb], 0, 0, 0); }
            }
        }
#pragma unroll
        for (int i = 0; i < 16; ++i) {
            const int li = l0 + crow(i, hh);
            float sq = 0.f;
#pragma unroll
            for (int pb = 0; pb < 2; ++pb) {
                const int p = 32 * pb + r, col = (hl & 1) * 64 + p;
                const float xs = bf2f(*(const LAS unsigned short*)(ximg + off_b(li, col >> 3) + 2 * (col & 7)));
                const float zz = bf2f(P.z[(size_t)(rowbase + li) * 1024 + h * 64 + p]);
                const float y = (acc[pb][i] + dsk * xs) * siluf_(zz);
                P.ys[(size_t)(rowbase + li) * 1024 + h * 64 + p] = y; sq += y * y;
            }
            sq += xor_lane<1>(sq); sq += xor_lane<2>(sq); sq += xor_lane<4>(sq); sq += xor_lane<8>(sq); sq += xor_lane<16>(sq);
            if (r == 0) ssq[(QUAD * 4 + hl) * 128 + li] = sq;
        }
    }
}
DI void s3_store(const Ptrs& P, LAS unsigned char* lds, int c, int g, int quad, int tid) {
    const int lane = tid & 63, w = __builtin_amdgcn_readfirstlane(tid >> 6), hl = w >> 1, lh = w & 1, hh = lane >> 5, r = lane & 31;
    const int rowbase = c * 128, h = 8 * g + 4 * quad + hl;
    const LAS float* ssq = (const LAS float*)(lds + L_SSQ);
    float nw[2];
#pragma unroll
    for (int pb = 0; pb < 2; ++pb) nw[pb] = P.norm_w[h * 64 + 32 * pb + r];
#pragma unroll
    for (int lb = 0; lb < 2; ++lb)
#pragma unroll 4
        for (int i = 0; i < 16; ++i) { const int l = 64 * lh + 32 * lb + crow(i, hh);
            float tot = 0.f;
#pragma unroll
            for (int k = 0; k < 8; ++k) tot += ssq[k * 128 + l];
            const float rstd = 1.f / sqrtf(tot * (1.f / 512.f) + EPSN);
#pragma unroll
            for (int pb = 0; pb < 2; ++pb) { const size_t e = (size_t)(rowbase + l) * 1024 + h * 64 + 32 * pb + r;
                P.o[(size_t)(rowbase + l) * 2048 + 512 + h * 64 + 32 * pb + r] = f2bf(P.ys[e] * rstd * nw[pb]); } }
}
DI void s3_unit(const Ptrs& P, LAS unsigned char* lds, int c, int g, int tid) {
    const int rowbase = c * 128;
    __syncthreads();
    stage_img(lds + L_B, P.xbca + (size_t)rowbase * 1536 + 1024 + g * 128, 1536, tid);
    stage_img(lds + L_C, P.xbca + (size_t)rowbase * 1536 + 1280 + g * 128, 1536, tid);
    s3_pass<0>(P, lds, c, g, tid);
    s3_pass<1>(P, lds, c, g, tid);
    VM_WAIT();
    __syncthreads();
    s3_store(P, lds, c, g, 0, tid);
    s3_store(P, lds, c, g, 1, tid);
}
}
constexpr size_t MiB = 1u << 20;
constexpr size_t WS_CTL = 0, CTL_ZERO_BYTES = 1 * MiB;
constexpr size_t WS_TIN = 2 * MiB, WS_TBR = 47 * MiB, WS_TOUT = 55 * MiB, WS_TUP = 63 * MiB, WS_TDN = 107 * MiB;
constexpr size_t WS_H = 129 * MiB;
constexpr size_t WS_R1 = 193 * MiB;
constexpr size_t R_QNA = 0, R_KNA = 16 * MiB, R_VNA = 32 * MiB, R_GQ = 48 * MiB, R_GK = 64 * MiB, R_GV = 72 * MiB, R_Z = 80 * MiB, R_XBC = 112 * MiB, R_DT = 160 * MiB, R_GATE = 162 * MiB;
constexpr size_t WS_XBCA = 547 * MiB, WS_ST = 595 * MiB, WS_O = 659 * MiB, WS_TMPF = 723 * MiB, WS_MRG = 851 * MiB, WS_DEC = 915 * MiB, WS_END = 916 * MiB;
constexpr size_t WS_ACT = 547 * MiB;
static_assert(WS_TIN + (size_t)NINP * DM * 2 <= WS_TBR && WS_TUP + (size_t)NUP * DM * 2 <= WS_TDN && WS_TDN + (size_t)DM * DFF * 2 <= WS_H, "weights map");
static_assert(WS_R1 + R_GATE + (size_t)MG * 6144 * 2 <= WS_XBCA && WS_R1 + (size_t)MG * NUP * 2 <= WS_XBCA && WS_ACT + (size_t)MG * DFF * 2 <= WS_MRG, "activation map");
constexpr int CW_BAR = 4096;

constexpr int LDS_BYTES = 147456, MISC_OFF = LDS_BYTES - 256;


#ifndef DBG_STOP
#define DBG_STOP 0
#endif
DI void dbg_fold(const Ctx& F, float* out, const bf16* buf, int rows, int ld, int c0, int nc, bool first) {
    const size_t n = (size_t)rows * 2048; const int t_ = tid_of(F.wave);
    for (size_t i = (size_t)F.blk * 512 + t_; i < n; i += (size_t)F.G * 512) {
        const int row = (int)(i >> 11), c = (int)(i & 2047); float s = first ? 0.f : out[i];
        for (int cc = c; cc < nc; cc += 2048) s += (float)buf[(size_t)row * ld + c0 + cc];
        out[i] = s; }
}
struct Args { const float* in[22]; float* out; unsigned char* ws; };

#define REFRESH() do { const int tv_ = tid_of(F.wave); F.tid = tv_; F.lane = tv_ & 63; } while (0)
#define GRID_BAR() do { XcdBarrier b_ = bar; asm volatile("" : "+s"(b_.bar)); b_.bar = (unsigned*)(GAS unsigned*)b_.bar; b_.x = xb_xcc_id(); xcd_barrier(b_); REFRESH(); } while (0)
#define OPQ_PTRS() \
    bf16* T_IN = (bf16*)(ws + WS_TIN); bf16* T_BR = (bf16*)(ws + WS_TBR); bf16* T_OUT = (bf16*)(ws + WS_TOUT); bf16* T_UP = (bf16*)(ws + WS_TUP); bf16* T_DN = (bf16*)(ws + WS_TDN); \
    bf16* H = (bf16*)(ws + WS_H); unsigned char* R1 = ws + WS_R1; \
    bf16* QNA = (bf16*)(R1 + R_QNA); bf16* KNA = (bf16*)(R1 + R_KNA); bf16* VNA = (bf16*)(R1 + R_VNA); bf16* GQ = (bf16*)(R1 + R_GQ); bf16* GK = (bf16*)(R1 + R_GK); bf16* GV = (bf16*)(R1 + R_GV); \
    bf16* Z = (bf16*)(R1 + R_Z); bf16* XBC = (bf16*)(R1 + R_XBC); float* DT = (float*)(R1 + R_DT); bf16* GATE = (bf16*)(R1 + R_GATE); bf16* U = (bf16*)R1; \
    bf16* XBCA = (bf16*)(ws + WS_XBCA); bf16* ST = (bf16*)(ws + WS_ST); bf16* O = (bf16*)(ws + WS_O); float* TMPF = (float*)(ws + WS_TMPF); bf16* MRG = (bf16*)(ws + WS_MRG); \
    float* DEC = (float*)(ws + WS_DEC); bf16* ACT = (bf16*)(ws + WS_ACT);
__global__ void __launch_bounds__(512, 2) fwd_kernel(Args args) {
    extern __shared__ __attribute__((aligned(16))) unsigned char lds_raw[];
    LAS unsigned char* lds = (LAS unsigned char*)lds_raw;
    Ctx F; F.tid = threadIdx.x; F.lane = F.tid & 63; F.wave = __builtin_amdgcn_readfirstlane(F.tid >> 6); F.G = gridDim.x; F.blk = blockIdx.x;
    F.gw = F.blk * 8 + F.wave; F.ngw = F.G * 8;
    typedef const __attribute__((address_space(4))) Args* KArgs;
    const KArgs kp0 = (KArgs)__builtin_amdgcn_kernarg_segment_ptr();
#define KP() ({ KArgs k_ = kp0; asm volatile("" : "+s"(k_)); k_; })
#define GIN(i) ((const float*)(const GAS float*)(KP()->in[i]))
#define GOUT() ((float*)(GAS float*)(KP()->out))
#define GWS() ((unsigned char*)(GAS unsigned char*)(KP()->ws))
    unsigned char* ws = GWS();
    if (F.tid < 64) ((LAS unsigned*)(lds + MISC_OFF))[F.tid] = 0u;
    __syncthreads();
    XcdBarrier bar = xcd_barrier_post((unsigned*)(ws + WS_CTL) + CW_BAR, (volatile LAS unsigned*)(lds + MISC_OFF), F.wave);

#if DBG_STOP
    { float* o_ = GOUT(); const int t_ = tid_of(F.wave); for (size_t i = (size_t)MG * DM + (size_t)F.blk * 512 + t_; i < (size_t)MTOT * DM; i += (size_t)F.G * 512) o_[i] = 0.f; }
#endif
#pragma unroll 1
    for (int layer = 0; layer < (DBG_STOP ? 1 : DEPTH); ++layer) {
#pragma unroll 1
        for (int grp = 0; grp < (DBG_STOP ? 1 : NGRP); ++grp) {
            REFRESH();
            ws = GWS();
            OPQ_PTRS();
            const int L = grp == 0 ? 16384 : 2048, nseq = MG / L, ncs = L / 128;
            const float* xin0 = grp == 0 ? GIN(0) : GIN(1) + (size_t)(grp - 1) * MG * DM;
            float* xo = GOUT() + (size_t)grp * MG * DM;
            const float* xcur = layer == 0 ? xin0 : xo;
#ifndef SKIP_CONV
            if (grp == 0) {
                WPtrs WP{GIN(3) + (size_t)layer * DM * NIN, GIN(15) + (size_t)layer * DM * DM, GIN(16) + (size_t)layer * DM * DM, GIN(18) + (size_t)layer * DM * NUP,
                         GIN(21) + (size_t)layer * DFF * DM, T_IN, T_BR, T_OUT, T_UP, T_DN};
                convert_weights(F, WP, lds);
            }
#endif
            REFRESH();
            rmsnorm_rows(F, xcur, GIN(2) + layer * DM, H, MG);
            GRID_BAR();
#if DBG_STOP == 1
            { dbg_fold(F, GOUT(), H, MG, 2048, 0, 2048, true); dbg_fold(F, GOUT(), T_IN, 11264, 2048, 0, 2048, false); dbg_fold(F, GOUT(), T_UP, 11264, 2048, 0, 2048, false); break; }
#endif
#ifndef SKIP_P1
            {   pg8::Gemm g{H, T_IN, MG, NINP, DM, DM, DM}; pg8::StaticOrder S; S.init(MG, NINP, F.G, F.blk);
                pg8::EpiInProj E{R1, R_QNA, R_KNA, R_VNA, R_GQ, R_GK, R_GV, R_Z, R_XBC, R_DT, R_GATE};
                pg8::gemm_phase<pg8::EpiInProj, pg8::StaticOrder, true, true>(lds, g, S, E, F.wave); }
#endif
            GRID_BAR();
#if DBG_STOP == 2
            { dbg_fold(F, GOUT(), QNA, MG, 512, 0, 512, true); dbg_fold(F, GOUT(), KNA, MG, 512, 0, 512, false); dbg_fold(F, GOUT(), VNA, MG, 512, 0, 512, false); dbg_fold(F, GOUT(), GQ, MG, 512, 0, 512, false); dbg_fold(F, GOUT(), GK, MG, 256, 0, 256, false); dbg_fold(F, GOUT(), GV, MG, 256, 0, 256, false); dbg_fold(F, GOUT(), Z, MG, 1024, 0, 1024, false); dbg_fold(F, GOUT(), XBC, MG, 1536, 0, 1536, false); dbg_fold(F, GOUT(), GATE, MG, 6144, 0, 6144, false); dbg_fold(F, GOUT(), (const bf16*)DT, MG, 64, 0, 64, false); break; }
#endif
#ifndef SKIP_P2
            {   PrepPtrs PP{QNA, KNA, GQ, GK, GIN(4) + layer * 128, GIN(5) + layer * 128, GIN(13) + layer * 128, GIN(14) + layer * 128};
                prep_qk(F, PP, L);
                REFRESH();
                prep_xbc(F, XBC, XBCA, GIN(7) + (size_t)layer * 5 * 1536, GIN(8) + (size_t)layer * 1536, L); }
#endif
            GRID_BAR();
#if DBG_STOP == 3
            { dbg_fold(F, GOUT(), QNA, MG, 512, 0, 512, true); dbg_fold(F, GOUT(), KNA, MG, 512, 0, 512, false); dbg_fold(F, GOUT(), GQ, MG, 512, 0, 512, false); dbg_fold(F, GOUT(), GK, MG, 256, 0, 256, false); dbg_fold(F, GOUT(), XBCA, MG, 1536, 0, 1536, false); break; }
#endif
            ssd::Ptrs SP{XBCA, DT, Z, ST, DEC, O, TMPF, GIN(9) + layer * 32, GIN(10) + layer * 32, GIN(11) + layer * 16, GIN(12) + layer * 1024};
            {
#ifndef SKIP_NA
                const int rows = L / 64;
                for (int u = F.blk; u < (MG / 256) * 4; u += F.G) {
                    const int b = u >> 2, h = u & 3, row0 = b * 256, t0 = row0 & (L - 1), r0 = t0 >> 6, seq0 = row0 - t0;
                    int rs0 = r0 - 4; rs0 = rs0 < 0 ? 0 : (rs0 > rows - 8 ? rows - 8 : rs0);
                    const int NT = (r0 == 0 || r0 == rows - 4) ? 8 : 12;
                    __syncthreads();
                    {   LAS float* rp = (LAS float*)(lds + att::SHM_RPB); const float* src = GIN(6) + ((size_t)layer * 4 + h) * 15 * 31;
                        for (int i = F.tid; i < 15 * 31; i += 512) rp[(i / 31) * 32 + (i % 31)] = src[i] * (1.f / att::SCALE); }
                    const int r = r0 + (F.wave >> 1); int rs = r - 4; rs = rs < 0 ? 0 : (rs > rows - 8 ? rows - 8 : rs);
                    const int cq = 32 * (F.wave & 1) + (F.lane & 31); int cs = cq - 8; cs = cs < 0 ? 0 : (cs > 48 ? 48 : cs);
                    att::NaCtx nc{__builtin_amdgcn_readfirstlane(rs - rs0), __builtin_amdgcn_readfirstlane(rs0 - r), cq, cs, (const float*)(lds_raw + att::SHM_RPB)};
                    att::attn_body<512, 512, 2048, true, 1>(QNA + (size_t)row0 * 512 + h * 128, KNA + (size_t)(seq0 + rs0 * 64) * 512 + h * 128, VNA + (size_t)(seq0 + rs0 * 64) * 512 + h * 128,
                                                         O + (size_t)row0 * 2048 + h * 128, NT, (char*)lds_raw, nc, F.wave);
                }
#endif
                REFRESH();
#ifndef SKIP_GQA
                const int qbs = L / 256;
                for (int u = F.blk; u < nseq * 4 * qbs; u += F.G) {
                    const int qb = u % qbs, h = (u / qbs) & 3, s = u / (qbs * 4), seq0 = s * L;
                    att::NaCtx nc{0, 0, 0, 0, nullptr};
                    att::attn_body<512, 256, 2048, false, 2>(GQ + (size_t)(seq0 + qb * 256) * 512 + h * 128, GK + (size_t)seq0 * 256 + (h >> 1) * 128, GV + (size_t)seq0 * 256 + (h >> 1) * 128,
                                                          O + (size_t)(seq0 + qb * 256) * 2048 + 1536 + h * 128, L / 64, (char*)lds_raw, nc, F.wave);
                }
#endif
                REFRESH();
#ifndef SKIP_S1
                for (int u = F.blk; u < (MG / 128) * 2; u += F.G) ssd::s1_unit(SP, lds, u >> 1, u & 1, F.tid);
#endif
            }
            GRID_BAR();
#if DBG_STOP == 4
            { dbg_fold(F, GOUT(), O, MG, 2048, 0, 512, true); dbg_fold(F, GOUT(), O, MG, 2048, 1536, 512, false); dbg_fold(F, GOUT(), ST, MG, 2048, 0, 2048, false); break; }
#endif
#ifndef SKIP_S2
            ssd::scan_states(F, ST, DEC, nseq, ncs);
#endif
            GRID_BAR();
#if DBG_STOP == 5
            { dbg_fold(F, GOUT(), ST, MG, 2048, 0, 2048, true); break; }
#endif
#ifndef SKIP_S3
            for (int u = F.blk; u < (MG / 128) * 2; u += F.G) ssd::s3_unit(SP, lds, u >> 1, u & 1, F.tid);
#endif
            GRID_BAR();
#if DBG_STOP == 6
            { dbg_fold(F, GOUT(), O, MG, 2048, 0, 2048, true); break; }
#endif
#ifndef SKIP_P6
#pragma unroll 1
            for (int j = 0; j < 3; ++j) {
                const int koff = j == 0 ? 0 : (j == 1 ? 512 : 1536), Kj = j == 1 ? 1024 : 512;
                pg8::Gemm g{O + koff, T_BR + koff, MG, DM, Kj, DM, DM}; pg8::StaticOrder S; S.init(MG, DM, F.G, F.blk);
                pg8::EpiMerge E{GATE, TMPF, MRG, j};
                pg8::gemm_phase<pg8::EpiMerge, pg8::StaticOrder, true, true>(lds, g, S, E, F.wave);
            }
#endif
            GRID_BAR();
#if DBG_STOP == 7
            { dbg_fold(F, GOUT(), MRG, MG, 2048, 0, 2048, true); break; }
#endif
#ifndef SKIP_P7
            {   pg8::Gemm g{MRG, T_OUT, MG, DM, DM, DM, DM}; pg8::StaticOrder S; S.init(MG, DM, F.G, F.blk);
                pg8::EpiResid E{xcur, xo};
                pg8::gemm_phase<pg8::EpiResid, pg8::StaticOrder, true, true>(lds, g, S, E, F.wave); }
#endif
            GRID_BAR();
#if DBG_STOP == 8
            {  break; }
#endif
            rmsnorm_rows(F, xo, GIN(17) + layer * DM, H, MG);
            GRID_BAR();
#ifndef SKIP_P9
            {   pg8::Gemm g{H, T_UP, MG, NUP, DM, DM, DM}; pg8::StaticOrder S; S.init(MG, NUP, F.G, F.blk);
                pg8::EpiBf16Plain E{U, NUP};
                pg8::gemm_phase<pg8::EpiBf16Plain, pg8::StaticOrder, true, true>(lds, g, S, E, F.wave); }
#endif
            GRID_BAR();
#if DBG_STOP == 10
            { dbg_fold(F, GOUT(), U, MG, 11264, 0, 11264, true); break; }
#endif
#ifndef SKIP_P10
            ffn_act(F, U, ACT, GIN(19) + (size_t)layer * 3 * DFF, GIN(20) + (size_t)layer * DFF, L);
#endif
            GRID_BAR();
#if DBG_STOP == 11
            { dbg_fold(F, GOUT(), ACT, MG, 5632, 0, 5632, true); break; }
#endif
#ifndef SKIP_P11
            {   pg8::Gemm g{ACT, T_DN, MG, DM, DFF, DFF, DFF}; pg8::StaticOrder S; S.init(MG, DM, F.G, F.blk);
                pg8::EpiResid E{xo, xo};
                pg8::gemm_phase<pg8::EpiResid, pg8::StaticOrder, true, true>(lds, g, S, E, F.wave); }
#endif
            GRID_BAR();
        }
    }
}

extern "C" void kernel_launch(void* const* d_in, const int* in_sizes, int n_in, void* d_out, int out_size, void* d_ws, size_t ws_size, hipStream_t stream) {
    static int grid = 0;
    if (grid == 0) {
        if (n_in != 22 || out_size != MTOT * DM || ws_size < WS_END) { fprintf(stderr, "kernel_launch: unexpected shapes n_in %d out %d ws %zu (need %zu)\n", n_in, out_size, ws_size, (size_t)WS_END); grid = -1; return; }
        int dev = 0, cus = 0, per_cu = 0;
        if (hipGetDevice(&dev) != hipSuccess || hipDeviceGetAttribute(&cus, hipDeviceAttributeMultiprocessorCount, dev) != hipSuccess) { grid = -1; return; }
        if (hipFuncSetAttribute((const void*)fwd_kernel, hipFuncAttributeMaxDynamicSharedMemorySize, LDS_BYTES) != hipSuccess) { fprintf(stderr, "kernel_launch: hipFuncSetAttribute failed\n"); grid = -1; return; }
        if (hipOccupancyMaxActiveBlocksPerMultiprocessor(&per_cu, (const void*)fwd_kernel, 512, LDS_BYTES) != hipSuccess || per_cu < 1) { fprintf(stderr, "kernel_launch: occupancy query says %d blocks per CU\n", per_cu); (void)hipGetLastError(); grid = -1; return; }
        grid = cus;
    }
    if (grid < 0) return;
    if (hipMemsetAsync((char*)d_ws + WS_CTL, 0, CTL_ZERO_BYTES, stream) != hipSuccess) return;
    Args a{};
    for (int i = 0; i < 22; ++i) a.in[i] = (const float*)d_in[i];
    a.out = (float*)d_out; a.ws = (unsigned char*)d_ws;
    hipLaunchKernelGGL(fwd_kernel, dim3(grid), dim3(512), LDS_BYTES, stream, a);
    const hipError_t le = hipPeekAtLastError();
    if (le != hipSuccess) fprintf(stderr, "kernel_launch: launch failed: %s\n", hipGetErrorName(le));
}
```

```cpp
#define DBG_STOP 0
#include <hip/hip_runtime.h>
#include <cstdio>
#include <cstdint>
#include <cmath>

#define GAS __attribute__((address_space(1)))
#define LAS __attribute__((address_space(3)))
typedef unsigned short bf16;
typedef unsigned v4u __attribute__((ext_vector_type(4)));
typedef unsigned v2u __attribute__((ext_vector_type(2)));
typedef float f32x4 __attribute__((ext_vector_type(4)));
typedef float f32x2 __attribute__((ext_vector_type(2)));
typedef float f32x16 __attribute__((ext_vector_type(16)));
typedef short bf16x8 __attribute__((ext_vector_type(8)));
typedef short s16x4 __attribute__((ext_vector_type(4)));
typedef __bf16 bf16x2_t __attribute__((ext_vector_type(2)));
#define DI __device__ __forceinline__

DI unsigned pk2(float lo, float hi) { f32x2 v = {lo, hi}; bf16x2_t b = __builtin_convertvector(v, bf16x2_t); return __builtin_bit_cast(unsigned, b); }
DI unsigned short f2bf(float f) { return (unsigned short)(pk2(f, 0.f) & 0xffffu); }
DI float bflo(unsigned u) { return __uint_as_float(u << 16); }
DI float bfhi(unsigned u) { return __uint_as_float(u & 0xffff0000u); }
DI float bf2f(unsigned short h) { return __uint_as_float((unsigned)h << 16); }
DI void unpack8(v4u v, float (&x)[8]) { x[0] = bflo(v.x); x[1] = bfhi(v.x); x[2] = bflo(v.y); x[3] = bfhi(v.y); x[4] = bflo(v.z); x[5] = bfhi(v.z); x[6] = bflo(v.w); x[7] = bfhi(v.w); }
DI v4u pack8(const float (&x)[8]) { v4u v; v.x = pk2(x[0], x[1]); v.y = pk2(x[2], x[3]); v.z = pk2(x[4], x[5]); v.w = pk2(x[6], x[7]); return v; }
DI float sigmoidf_(float x) { return __builtin_amdgcn_rcpf(1.f + __expf(-x)); }
DI float siluf_(float x) { return x * sigmoidf_(x); }

template <int K> DI float xor_lane(float v) {
    if constexpr (K == 32) { auto rr = __builtin_amdgcn_permlane32_swap(__float_as_uint(v), __float_as_uint(v), false, false); return __uint_as_float((__builtin_amdgcn_mbcnt_hi(~0u, __builtin_amdgcn_mbcnt_lo(~0u, 0u)) & 32u) ? rr[0] : rr[1]); }
    else return __int_as_float(__builtin_amdgcn_ds_swizzle(__float_as_int(v), (K << 10) | 0x1f));
}
DI float wave_sum(float v) {
    v += xor_lane<1>(v); v += xor_lane<2>(v); v += xor_lane<4>(v); v += xor_lane<8>(v); v += xor_lane<16>(v);
    { auto rr = __builtin_amdgcn_permlane32_swap(__float_as_uint(v), __float_as_uint(v), false, false); v = __uint_as_float(rr[0]) + __uint_as_float(rr[1]); }
    return v;
}
template <int CTRL, int RMASK> DI float dpp0(float v) { return __int_as_float(__builtin_amdgcn_update_dpp(0, __float_as_int(v), CTRL, RMASK, 0xf, false)); }
DI float wave_scan_incl(float v) {
    v += dpp0<0x111, 0xf>(v); v += dpp0<0x112, 0xf>(v); v += dpp0<0x114, 0xf>(v); v += dpp0<0x118, 0xf>(v);
    v += dpp0<0x142, 0xa>(v); v += dpp0<0x143, 0xc>(v);
    return v;
}
DI int lane_id() { return (int)__builtin_amdgcn_mbcnt_hi(~0u, __builtin_amdgcn_mbcnt_lo(~0u, 0u)); }
DI int tid_of(int wave) { int t = wave * 64 + lane_id(); asm volatile("" : "+v"(t)); return t; }
#define LDS_WAIT() asm volatile("s_waitcnt lgkmcnt(0)" ::: "memory")
#define VM_WAIT() asm volatile("s_waitcnt vmcnt(0)" ::: "memory")

constexpr int DM = 2048, DEPTH = 4, MTOT = 49152, MG = 16384, NGRP = 3;
constexpr int NIN = 11296, NINP = 11520, DFF = 5632, NUP = 11264, GATE_SRC0 = 5152, GATE_DST0 = 5376;
constexpr float EPSN = 1e-6f;
namespace pg8 {
#define PG8_LAS __attribute__((address_space(3)))
typedef unsigned short bf16_t;
typedef short bf16x8 __attribute__((ext_vector_type(8)));
typedef float f32x4 __attribute__((ext_vector_type(4)));
typedef unsigned u32x4 __attribute__((ext_vector_type(4)));
constexpr int BM = 256, BK = 64, HALF = 128, HTB = HALF * BK * 2  , STAGE_BYTES = 8 * HTB, NXCD = 8, WGM = 8;

__host__ __device__ __forceinline__ int lds_byte(int r, int c) { const int st = (r >> 4) * 2 + (c >> 5), rr = r & 15, cc = c & 31, ob = rr * 64 + cc * 2; return st * 1024 + (ob ^ (((ob >> 9) & 1) << 5)); }
__host__ __device__ __forceinline__ void stage_rc(int b, int& R, int& C) { const int st = b / 1024, sb = b % 1024, swz = sb ^ (((sb >> 9) & 1) << 5); R = (st >> 1) * 16 + swz / 64; C = (st & 1) * 32 + (swz % 64) / 2; }
__host__ __device__ __forceinline__ int perm32(int rho) { const int n = rho >> 4, i = rho & 15; return 8 * (i >> 2) + 4 * n + (i & 3); }

struct Unit { int pm, pn; };
struct Gemm { const bf16_t* A; const bf16_t* Bt; int M, N, K, lda, ldb; };

struct StaticOrder {
    int nM, nN, nwg, G, c;
    __host__ __device__ void init(int M, int N, int G_, int c_) { nM = M / BM; nN = N / BM; nwg = nM * nN; G = G_; c = c_; }
    __host__ __device__ bool next(int i, Unit& u) const {
        const long L = (long)i * G + c; if (L >= nwg) return false;
        int wgid = (int)L; { const int q = nwg / NXCD, r = nwg % NXCD, xcd = wgid % NXCD, off = wgid / NXCD; wgid = (xcd < r ? xcd * (q + 1) : r * (q + 1) + (xcd - r) * q) + off; }
        const int nig = WGM * nN, gid = wgid / nig, fm = gid * WGM, gsz = (nM - fm) < WGM ? (nM - fm) : WGM;
        u.pm = fm + ((wgid % nig) % gsz); u.pn = (wgid % nig) / gsz; return true;
    }
    __device__ __forceinline__ void a_ready(const Unit&) const {}
    __device__ __forceinline__ void done(const Unit&) const {}
};

struct EpiInProj {
    static constexpr bool PERM = true, AFTER_DRAIN = false, KHOOK = false;
    unsigned char* r1;
    size_t oQNA, oKNA, oVNA, oGQ, oGK, oGV, oZ, oXBC, oDT, oGATE;
    __device__ __forceinline__ void operator()(const f32x4 (&acc)[2][2][4][2], const Unit& u, int wr, int wc, int fr, int fq) const {
        const int pn = u.pn; const int row0 = u.pm * BM + wr * 64 + fr;
        size_t off; int ld, colb, mode = 0;
        if (pn < 2)       { off = oQNA; ld = 512;  colb = pn * 256; }
        else if (pn < 4)  { off = oKNA; ld = 512;  colb = (pn - 2) * 256; }
        else if (pn < 6)  { off = oVNA; ld = 512;  colb = (pn - 4) * 256; }
        else if (pn < 8)  { off = oGQ;  ld = 512;  colb = (pn - 6) * 256; }
        else if (pn == 8) { off = oGK;  ld = 256;  colb = 0; }
        else if (pn == 9) { off = oGV;  ld = 256;  colb = 0; }
        else if (pn < 14) { off = oZ;   ld = 1024; colb = (pn - 10) * 256; }
        else if (pn < 20) { off = oXBC; ld = 1536; colb = (pn - 14) * 256; }
        else if (pn == 20){ off = oDT;  ld = 32;   colb = 0; mode = 1; }
        else              { off = oGATE; ld = 6144; colb = (pn - 21) * 256; mode = 2; }
        const int col0 = colb + wc * 32 + 8 * fq;
        if (mode == 1) {
            if (wc == 0) {
                float* base = (float*)(r1 + off);
#pragma unroll
                for (int ai = 0; ai < 2; ++ai)
#pragma unroll
                    for (int m = 0; m < 4; ++m) { float* rowp = base + (size_t)(row0 + ai * HALF + m * 16) * 32 + 8 * fq;
                        *(f32x4*)(rowp) = acc[ai][0][m][0]; *(f32x4*)(rowp + 4) = acc[ai][0][m][1]; }
            }
            return;
        }
        bf16_t* base = (bf16_t*)(r1 + off);
#pragma unroll
        for (int ai = 0; ai < 2; ++ai)
#pragma unroll
            for (int m = 0; m < 4; ++m) { bf16_t* rowp = base + (size_t)(row0 + ai * HALF + m * 16) * ld + col0;
#pragma unroll
                for (int bj = 0; bj < 2; ++bj) { f32x4 v0 = acc[ai][bj][m][0], v1 = acc[ai][bj][m][1];
                    if (mode == 2) {
#pragma unroll
                        for (int e = 0; e < 4; ++e) { v0[e] = sigmoidf_(v0[e]); v1[e] = sigmoidf_(v1[e]); } }
                    u32x4 w; w.x = pk2(v0[0], v0[1]); w.y = pk2(v0[2], v0[3]); w.z = pk2(v1[0], v1[1]); w.w = pk2(v1[2], v1[3]);
                    *(u32x4*)(rowp + bj * HALF) = w; } }
    }
};
struct EpiBf16Plain {
    static constexpr bool PERM = true, AFTER_DRAIN = false, KHOOK = false;
    bf16_t* O; int ldc;
    __device__ __forceinline__ void operator()(const f32x4 (&acc)[2][2][4][2], const Unit& u, int wr, int wc, int fr, int fq) const {
        const int row0 = u.pm * BM + wr * 64 + fr, col0 = u.pn * BM + wc * 32 + 8 * fq;
#pragma unroll
        for (int ai = 0; ai < 2; ++ai)
#pragma unroll
            for (int m = 0; m < 4; ++m) { bf16_t* rowp = O + (size_t)(row0 + ai * HALF + m * 16) * ldc + col0;
#pragma unroll
                for (int bj = 0; bj < 2; ++bj) { const f32x4 v0 = acc[ai][bj][m][0], v1 = acc[ai][bj][m][1];
                    u32x4 w; w.x = pk2(v0[0], v0[1]); w.y = pk2(v0[2], v0[3]); w.z = pk2(v1[0], v1[1]); w.w = pk2(v1[2], v1[3]);
                    *(u32x4*)(rowp + bj * HALF) = w; } }
    }
};
struct EpiMerge {
    static constexpr bool PERM = true, AFTER_DRAIN = false, KHOOK = true;
    const bf16_t* gates; bf16_t* merged;
    __device__ __forceinline__ void khook(f32x4 (&acc)[2][2][4][2], const Unit& u, int t, int wr, int wc, int fr, int fq) const {
        if (t != 8 && t != 24) return;
        const int ja = t == 8 ? 0 : 1;
        int fr_ = fr, fq_ = fq; asm volatile("" : "+v"(fr_), "+v"(fq_));
        const int row0 = u.pm * BM + wr * 64 + fr_, col0 = u.pn * BM + wc * 32 + 8 * fq_;
#pragma unroll
        for (int ai = 0; ai < 2; ++ai)
#pragma unroll
            for (int m = 0; m < 4; ++m) { const bf16_t* gp = gates + (size_t)(row0 + ai * HALF + m * 16) * 6144 + (size_t)ja * 2048 + col0;
#pragma unroll
                for (int bj = 0; bj < 2; ++bj) {
                    float ga[8], gb[8]; unpack8(*(const u32x4*)(gp + bj * HALF), ga); unpack8(*(const u32x4*)(gp + 2048 + bj * HALF), gb);
#pragma unroll
                    for (int e = 0; e < 4; ++e) { acc[ai][bj][m][0][e] *= ga[e] * __builtin_amdgcn_rcpf(fmaxf(gb[e], 1e-30f)); acc[ai][bj][m][1][e] *= ga[4 + e] * __builtin_amdgcn_rcpf(fmaxf(gb[4 + e], 1e-30f)); } } }
    }
    __device__ __forceinline__ void operator()(const f32x4 (&acc)[2][2][4][2], const Unit& u, int wr, int wc, int fr, int fq) const {
        const int row0 = u.pm * BM + wr * 64 + fr, col0 = u.pn * BM + wc * 32 + 8 * fq;
#pragma unroll
        for (int ai = 0; ai < 2; ++ai)
#pragma unroll
            for (int m = 0; m < 4; ++m) { const size_t row = (size_t)(row0 + ai * HALF + m * 16);
#pragma unroll
                for (int bj = 0; bj < 2; ++bj) { const int col = col0 + bj * HALF;
                    float g[8]; unpack8(*(const u32x4*)(gates + row * 6144 + 2 * 2048 + col), g);
                    const f32x4 v0 = acc[ai][bj][m][0], v1 = acc[ai][bj][m][1];
                    u32x4 w; w.x = pk2(v0[0] * g[0], v0[1] * g[1]); w.y = pk2(v0[2] * g[2], v0[3] * g[3]); w.z = pk2(v1[0] * g[4], v1[1] * g[5]); w.w = pk2(v1[2] * g[6], v1[3] * g[7]);
                    *(u32x4*)(merged + row * 2048 + col) = w; } }
    }
};
template <int CTRL> __device__ __forceinline__ float dpp_rot(float v) { return __int_as_float(__builtin_amdgcn_update_dpp(0, __float_as_int(v), CTRL, 0xf, 0xf, false)); }
struct EpiFfnAct {
    static constexpr bool PERM = true, AFTER_DRAIN = false, KHOOK = false;
    bf16_t* act; const float* cw; const float* cb; float* side; PG8_LAS float* ex;
    __device__ __forceinline__ void operator()(const f32x4 (&acc)[2][2][4][2], const Unit& u, int wr, int wc, int fr, int fq) const {
        const int gc = u.pn * 128 + wc * 32 + 8 * fq, lc = wc * 32 + 8 * fq;
        const int row0 = u.pm * BM + wr * 64 + fr;
        f32x4 w0[2], w1[2], w2[2], bb[2];
#pragma unroll
        for (int n = 0; n < 2; ++n) { w0[n] = *(const f32x4*)(cw + gc + 4 * n); w1[n] = *(const f32x4*)(cw + 5632 + gc + 4 * n); w2[n] = *(const f32x4*)(cw + 2 * 5632 + gc + 4 * n); bb[n] = *(const f32x4*)(cb + gc + 4 * n); }
#pragma unroll
        for (int ai = 0; ai < 2; ++ai) { const int b = 2 * ai + wr;
            if (fr == 0)  { *(PG8_LAS f32x4*)(ex + (b * 2 + 0) * 128 + lc) = acc[ai][0][0][0]; *(PG8_LAS f32x4*)(ex + (b * 2 + 0) * 128 + lc + 4) = acc[ai][0][0][1]; }
            if (fr == 15) { *(PG8_LAS f32x4*)(ex + (b * 2 + 1) * 128 + lc) = acc[ai][0][3][0]; *(PG8_LAS f32x4*)(ex + (b * 2 + 1) * 128 + lc + 4) = acc[ai][0][3][1]; } }
        asm volatile("s_waitcnt lgkmcnt(0)" ::: "memory"); __builtin_amdgcn_s_barrier(); asm volatile("" ::: "memory");
#pragma unroll
        for (int ai = 0; ai < 2; ++ai) { const int b = 2 * ai + wr;
            f32x4 hu[2], hd[2];
#pragma unroll
            for (int n = 0; n < 2; ++n) { hu[n] = b > 0 ? *(const PG8_LAS f32x4*)(ex + ((b - 1) * 2 + 1) * 128 + lc + 4 * n) : (f32x4){0.f, 0.f, 0.f, 0.f};
                                          hd[n] = b < 3 ? *(const PG8_LAS f32x4*)(ex + ((b + 1) * 2 + 0) * 128 + lc + 4 * n) : (f32x4){0.f, 0.f, 0.f, 0.f}; }
#pragma unroll
            for (int m = 0; m < 4; ++m) { f32x4 o[2];
#pragma unroll
                for (int n = 0; n < 2; ++n)
#pragma unroll
                    for (int e = 0; e < 4; ++e) { const float g = acc[ai][0][m][n][e];
                        const float u1 = dpp_rot<0x121>(g), u2 = m > 0 ? dpp_rot<0x121>(acc[ai][0][m > 0 ? m - 1 : 0][n][e]) : hu[n][e];
                        const float d1 = dpp_rot<0x12f>(g), d2 = m < 3 ? dpp_rot<0x12f>(acc[ai][0][m < 3 ? m + 1 : 3][n][e]) : hd[n][e];
                        const float gu = fr == 0 ? u2 : u1, gd = fr == 15 ? d2 : d1;
                        const float s = bb[n][e] + w0[n][e] * gu + w1[n][e] * g + w2[n][e] * gd;
                        o[n][e] = siluf_(s) * acc[ai][1][m][n][e];
                        if ((b == 0 && m == 0) || (b == 3 && m == 3)) {
                            const bool top = (b == 0 && m == 0);
                            if (fr == (top ? 0 : 15)) { float* sp = side + ((size_t)u.pm * 2 + (top ? 0 : 1)) * 3 * 5632 + gc + 4 * n + e; sp[0] = s; sp[5632] = acc[ai][1][m][n][e]; sp[2 * 5632] = g; } } }
                u32x4 w; w.x = pk2(o[0][0], o[0][1]); w.y = pk2(o[0][2], o[0][3]); w.z = pk2(o[1][0], o[1][1]); w.w = pk2(o[1][2], o[1][3]);
                *(u32x4*)(act + (size_t)(row0 + ai * HALF + m * 16) * 5632 + gc) = w; } }
    }
};
struct EpiResid {
    static constexpr bool PERM = false, AFTER_DRAIN = false, KHOOK = false;
    const float* xin; float* xout;
    __device__ __forceinline__ void operator()(const f32x4 (&acc)[2][2][4][2], const Unit& u, int wr, int wc, int fr, int fq) const {
        const int row0 = u.pm * BM + wr * 64 + fr, col0 = u.pn * BM + wc * 32 + 4 * fq;
#pragma unroll
        for (int ai = 0; ai < 2; ++ai)
#pragma unroll
            for (int m = 0; m < 4; ++m) { const size_t off = (size_t)(row0 + ai * HALF + m * 16) * 2048 + col0;
#pragma unroll
                for (int bj = 0; bj < 2; ++bj)
#pragma unroll
                    for (int n = 0; n < 2; ++n) { const f32x4 xi = *(const f32x4*)(xin + off + bj * HALF + n * 16);
                        *(f32x4*)(xout + off + bj * HALF + n * 16) = xi + acc[ai][bj][m][n]; } }
    }
};

template <class Epi, class Sched, bool ALIGN_EPI = false, bool SP2 = false>
__device__ __forceinline__ void gemm_phase(PG8_LAS unsigned char* lds, const Gemm g, const Sched& S, const Epi& E, int wave_) {
    const int tid_ = tid_of(wave_);
    const int tid = tid_, wid = __builtin_amdgcn_readfirstlane(tid >> 6), lane = tid & 63, wr = wid >> 2, wc = wid & 3, fr = lane & 15, fq = lane >> 4;
    const int K = g.K, nt = K / BK;
    unsigned voffA[2], voffB[2];
#pragma unroll
    for (int i = 0; i < 2; ++i) { int R, C; stage_rc(tid * 16 + i * 8192, R, C); const int Rb = Epi::PERM ? ((R & ~31) + perm32(R & 31)) : R;
        voffA[i] = (unsigned)(R * g.lda + C) * 2u; voffB[i] = (unsigned)(Rb * g.ldb + C) * 2u; }
    const size_t kstep = (size_t)(BK * 2);
    const size_t hstepA = (size_t)HALF * g.lda * 2, hstepB = (size_t)HALF * g.ldb * 2;
    const size_t tstepA = 2 * hstepA, tstepB = 2 * hstepB;
    const unsigned ldsw = (unsigned)wid * 1024u;
    const int aoff = lds_byte(wr * 64 + fr, fq * 8), boff = lds_byte(wc * 32 + fr, fq * 8);
#define PG8_SA(b, h) (((b) * 2 + (h)) * HTB)
#define PG8_SB(b, h) ((4 + (b) * 2 + (h)) * HTB)
#define PG8_STAGE(bufoff, gbase, voff) do { _Pragma("unroll") for (int _i = 0; _i < 2; ++_i) \
        __builtin_amdgcn_global_load_lds((const unsigned*)((const char*)(gbase) + (voff)[_i]), (PG8_LAS unsigned*)(lds + (bufoff) + ldsw + _i * 8192), 16, 0, 0); } while (0)
#define PG8_LDA(dst, b, h) do { _Pragma("unroll") for (int m = 0; m < 4; ++m) _Pragma("unroll") for (int k = 0; k < 2; ++k) dst[m][k] = *(const PG8_LAS bf16x8*)(lds + PG8_SA(b, h) + aoff + m * 2048 + k * 1024); } while (0)
#define PG8_LDB(dst, b, h) do { _Pragma("unroll") for (int n = 0; n < 2; ++n) _Pragma("unroll") for (int k = 0; k < 2; ++k) dst[n][k] = *(const PG8_LAS bf16x8*)(lds + PG8_SB(b, h) + boff + n * 2048 + k * 1024); } while (0)
#define PG8_MMA(ai, bj, At, Bt) do { __builtin_amdgcn_s_setprio(1); _Pragma("unroll") for (int m = 0; m < 4; ++m) _Pragma("unroll") for (int n = 0; n < 2; ++n) _Pragma("unroll") for (int k = 0; k < 2; ++k) \
        acc[ai][bj][m][n] = __builtin_amdgcn_mfma_f32_16x16x32_bf16(Bt[n][k], At[m][k], acc[ai][bj][m][n], 0, 0, 0); __builtin_amdgcn_s_setprio(0); } while (0)
#define PG8_WAIT_V(n) asm volatile("s_waitcnt vmcnt(" #n ")" ::: "memory")
#define PG8_WAIT_L(n) asm volatile("s_waitcnt lgkmcnt(" #n ")" ::: "memory")
#define PG8_BAR __builtin_amdgcn_s_barrier()
#define PG8_SCHED __builtin_amdgcn_sched_barrier(0)
    Unit cur, nxt; int ui = 0;
    if (!S.next(0, cur)) return;
    f32x4 acc[2][2][4][2];
#pragma unroll
    for (int a = 0; a < 2; ++a)
#pragma unroll
        for (int b = 0; b < 2; ++b)
#pragma unroll
            for (int m = 0; m < 4; ++m)
#pragma unroll
                for (int n = 0; n < 2; ++n) acc[a][b][m][n] = (f32x4){0.f, 0.f, 0.f, 0.f};
    bf16x8 At[4][2], B0[2][2], B1[2][2];
    const char* cA = (const char*)g.A + (size_t)cur.pm * tstepA; const char* cB = (const char*)g.Bt + (size_t)cur.pn * tstepB;
    S.a_ready(cur);
    if constexpr (SP2) {
        PG8_STAGE(PG8_SB(0, 0), cB, voffB); PG8_STAGE(PG8_SB(0, 1), cB + hstepB, voffB); PG8_STAGE(PG8_SA(0, 0), cA, voffA); PG8_STAGE(PG8_SA(0, 1), cA + hstepA, voffA);
        if (wr == 1) PG8_BAR;
        PG8_WAIT_V(2); PG8_BAR;
        PG8_STAGE(PG8_SB(1, 0), cB + kstep, voffB); PG8_STAGE(PG8_SA(1, 0), cA + kstep, voffA); PG8_STAGE(PG8_SB(1, 1), cB + hstepB + kstep, voffB);
        PG8_WAIT_V(6); PG8_BAR;
    } else {
        PG8_STAGE(PG8_SB(0, 0), cB, voffB); PG8_STAGE(PG8_SA(0, 0), cA, voffA); PG8_STAGE(PG8_SB(0, 1), cB + hstepB, voffB); PG8_STAGE(PG8_SA(0, 1), cA + hstepA, voffA);
        if (wr == 1) PG8_BAR;
        PG8_WAIT_V(4); PG8_BAR;
        PG8_STAGE(PG8_SB(1, 0), cB + kstep, voffB); PG8_STAGE(PG8_SA(1, 0), cA + kstep, voffA); PG8_STAGE(PG8_SB(1, 1), cB + hstepB + kstep, voffB);
        PG8_WAIT_V(6); PG8_BAR;
    }
    for (;;) {
        const bool has_next = S.next(ui + 1, nxt);
        const char* nA = has_next ? (const char*)g.A + (size_t)nxt.pm * tstepA : cA; const char* nB = has_next ? (const char*)g.Bt + (size_t)nxt.pn * tstepB : cB;
        for (int t = 0; t < nt; t += 2) {
            if constexpr (Epi::KHOOK) E.khook(acc, cur, t, wr, wc, fr, fq);
            const bool last = (t == nt - 2);
            const char* a1 = cA + (size_t)(t + 1) * kstep;
            const char* a2 = last ? nA : cA + (size_t)(t + 2) * kstep; const char* b2 = last ? nB : cB + (size_t)(t + 2) * kstep;
            const char* a3 = a2 + kstep; const char* b3 = b2 + kstep;
            if (last && has_next) S.a_ready(nxt);
            if constexpr (SP2) {
            PG8_LDB(B0, 0, 0); PG8_LDB(B1, 0, 1); PG8_SCHED; PG8_LDA(At, 0, 0); PG8_STAGE(PG8_SA(1, 1), a1 + hstepA, voffA);
            PG8_WAIT_V(8); PG8_WAIT_L(0); PG8_BAR; PG8_MMA(0, 0, At, B0); PG8_MMA(0, 1, At, B1); PG8_BAR; PG8_SCHED;
            PG8_LDA(At, 0, 1); PG8_STAGE(PG8_SB(0, 0), b2, voffB); PG8_STAGE(PG8_SB(0, 1), b2 + hstepB, voffB); PG8_STAGE(PG8_SA(0, 0), a2, voffA);
            PG8_WAIT_V(8); PG8_WAIT_L(0); PG8_BAR; PG8_MMA(1, 0, At, B0); PG8_MMA(1, 1, At, B1); PG8_BAR; PG8_SCHED;
            PG8_LDB(B0, 1, 0); PG8_LDB(B1, 1, 1); PG8_SCHED; PG8_LDA(At, 1, 0); PG8_STAGE(PG8_SA(0, 1), a2 + hstepA, voffA);
            PG8_WAIT_V(8); PG8_WAIT_L(0); PG8_BAR; PG8_MMA(0, 0, At, B0); PG8_MMA(0, 1, At, B1); PG8_BAR; PG8_SCHED;
            PG8_LDA(At, 1, 1); PG8_STAGE(PG8_SB(1, 0), b3, voffB); PG8_STAGE(PG8_SB(1, 1), b3 + hstepB, voffB); PG8_STAGE(PG8_SA(1, 0), a3, voffA);
            PG8_WAIT_V(8); PG8_WAIT_L(0); PG8_BAR; PG8_MMA(1, 0, At, B0); PG8_MMA(1, 1, At, B1); PG8_BAR; PG8_SCHED;
            } else {
            PG8_LDB(B0, 0, 0); PG8_SCHED; PG8_LDA(At, 0, 0); PG8_STAGE(PG8_SA(1, 1), a1 + hstepA, voffA);
            PG8_WAIT_L(8); PG8_BAR; PG8_WAIT_L(0); PG8_MMA(0, 0, At, B0); PG8_BAR; PG8_SCHED;
            PG8_LDB(B1, 0, 1); PG8_STAGE(PG8_SB(0, 0), b2, voffB);
            PG8_BAR; PG8_WAIT_L(0); PG8_MMA(0, 1, At, B1); PG8_BAR;
            PG8_LDA(At, 0, 1); PG8_STAGE(PG8_SA(0, 0), a2, voffA);
            PG8_BAR; PG8_WAIT_L(0); PG8_MMA(1, 0, At, B0); PG8_BAR; PG8_SCHED;
            PG8_STAGE(PG8_SB(0, 1), b2 + hstepB, voffB);
            PG8_WAIT_V(6); PG8_BAR; PG8_MMA(1, 1, At, B1); PG8_BAR;
            PG8_LDB(B0, 1, 0); PG8_SCHED; PG8_LDA(At, 1, 0); PG8_STAGE(PG8_SA(0, 1), a2 + hstepA, voffA);
            PG8_WAIT_L(8); PG8_BAR; PG8_WAIT_L(0); PG8_MMA(0, 0, At, B0); PG8_BAR; PG8_SCHED;
            PG8_LDB(B1, 1, 1); PG8_STAGE(PG8_SB(1, 0), b3, voffB);
            PG8_BAR; PG8_WAIT_L(0); PG8_MMA(0, 1, At, B1); PG8_BAR;
            PG8_LDA(At, 1, 1); PG8_STAGE(PG8_SA(1, 0), a3, voffA);
            PG8_BAR; PG8_WAIT_L(0); PG8_MMA(1, 0, At, B0); PG8_BAR; PG8_SCHED;
            PG8_STAGE(PG8_SB(1, 1), b3 + hstepB, voffB);
            PG8_WAIT_V(6); PG8_BAR; PG8_MMA(1, 1, At, B1); PG8_BAR;
            }
        }
        if constexpr (ALIGN_EPI) { if (wr == 0) PG8_BAR; }
        if constexpr (!Epi::AFTER_DRAIN) { E(acc, cur, wr, wc, fr, fq); S.done(cur); }
        if (!has_next) break;
#pragma unroll
        for (int a = 0; a < 2; ++a)
#pragma unroll
            for (int b = 0; b < 2; ++b)
#pragma unroll
                for (int m = 0; m < 4; ++m)
#pragma unroll
                    for (int n = 0; n < 2; ++n) acc[a][b][m][n] = (f32x4){0.f, 0.f, 0.f, 0.f};
        cur = nxt; cA = nA; cB = nB; ++ui;
        if constexpr (ALIGN_EPI) { if (wr == 1) PG8_BAR; }
    }
    PG8_WAIT_V(0);
    if constexpr (!ALIGN_EPI) { if (wr == 0) PG8_BAR; }
    PG8_BAR;
    if constexpr (Epi::AFTER_DRAIN) { E.fused(acc, cur, wr, wc, fr, fq, lds, wid, lane); S.done(cur); }
#undef PG8_SA
#undef PG8_SB
#undef PG8_STAGE
#undef PG8_LDA
#undef PG8_LDB
#undef PG8_MMA
#undef PG8_WAIT_V
#undef PG8_WAIT_L
#undef PG8_BAR
#undef PG8_SCHED
}
}
namespace att {
constexpr int D = 128, NW = 8, QBLK = 32, KVBLK = 64;
constexpr float SCALE = 0.088388347648318440f;
constexpr float THR = 8.f;
constexpr size_t SHM_V = KVBLK * D * 2, SHM_K = KVBLK * D * 2, SHM_ATTN = 2 * SHM_V + 2 * SHM_K + NW * 64 * 4;
constexpr size_t SHM_RPB = SHM_ATTN;
#define KSWZ(row, colB) ((row) * 256 + ((colB) ^ (((row) & 7) << 4)))
#define SBAR() __builtin_amdgcn_sched_barrier(0)
DI int crow(int r, int hi) { return (r & 3) + 8 * (r >> 2) + 4 * hi; }
DI unsigned cvtpk(float lo, float hi) { unsigned r; asm volatile("v_cvt_pk_bf16_f32 %0, %1, %2" : "=v"(r) : "v"(lo), "v"(hi)); return r; }

struct NaCtx { int jlo; int dr0; int cq; int cs; const float* rpb; };

template <bool NA> DI void mask_bias(f32x16& p0, f32x16& p1, int j, const NaCtx& c, int hi) {
  if constexpr (NA) {
    const bool tv = (unsigned)(j - c.jlo) < 8u;
    int ri = c.dr0 + j + 7; ri = ri < 0 ? 0 : (ri > 14 ? 14 : ri);
    int boff = ri * 32 + 15 - c.cq + 4 * hi, t = 4 * hi - c.cs;
    asm volatile("" : "+v"(boff), "+v"(t));
    const float* bp = c.rpb + boff;
#pragma unroll
    for (int q4 = 0; q4 < 4; ++q4) {
#pragma unroll
      for (int rr = 0; rr < 4; ++rr) { const int r = 4 * q4 + rr;
        const int k0 = (r & 3) + 8 * (r >> 2);
        const bool ok0 = tv && ((unsigned)(t + k0) < 16u), ok1 = tv && ((unsigned)(t + k0 + 32) < 16u);
        const float b0 = bp[k0], b1 = bp[k0 + 32];
        p0[r] = ok0 ? p0[r] + b0 : -INFINITY; p1[r] = ok1 ? p1[r] + b1 : -INFINITY; }
      __builtin_amdgcn_sched_barrier(0);
    }
  }
}
DI void partialSM(f32x16& p0, f32x16& p1, float& m_reg, float& mn, float& alpha) {
  constexpr float C = SCALE * 1.4426950408889634f;
  float pmax = p0[0];
#pragma unroll
  for (int r = 1; r < 16; ++r) pmax = fmaxf(pmax, p0[r]);
#pragma unroll
  for (int r = 0; r < 16; ++r) pmax = fmaxf(pmax, p1[r]);
  { auto rr = __builtin_amdgcn_permlane32_swap(__float_as_uint(pmax), __float_as_uint(pmax), false, false);
    pmax = fmaxf(__uint_as_float(rr[0]), __uint_as_float(rr[1])); }
  if (__builtin_expect(__all(pmax - m_reg <= THR / SCALE), 1)) { mn = m_reg; alpha = 1.f; }
  else { mn = fmaxf(m_reg, pmax); alpha = __builtin_amdgcn_exp2f((m_reg - mn) * C); m_reg = mn; }
  float mnC = -mn * C;
#pragma unroll
  for (int r = 0; r < 16; ++r) p0[r] = fmaf(p0[r], C, mnC);
#pragma unroll
  for (int r = 0; r < 16; ++r) p1[r] = fmaf(p1[r], C, mnC);
#pragma unroll
  for (int r = 0; r < 16; ++r) p0[r] = __builtin_amdgcn_exp2f(p0[r]);
}
DI void finishSM(f32x16& p0, f32x16& p1, float alpha, float& l_reg, bf16x8& pa0, bf16x8& pa1, bf16x8& pa2, bf16x8& pa3) {
#pragma unroll
  for (int r = 0; r < 16; ++r) p1[r] = __builtin_amdgcn_exp2f(p1[r]);
  float ps = 0;
#pragma unroll
  for (int r = 0; r < 16; ++r) ps += p0[r];
#pragma unroll
  for (int r = 0; r < 16; ++r) ps += p1[r];
  { auto rr = __builtin_amdgcn_permlane32_swap(__float_as_uint(ps), __float_as_uint(ps), false, false);
    ps = __uint_as_float(rr[0]) + __uint_as_float(rr[1]); }
  l_reg = l_reg * alpha + ps;
#define PK4(P, BASE, OUT) do { unsigned a0 = cvtpk(P[BASE + 0], P[BASE + 1]), a1 = cvtpk(P[BASE + 2], P[BASE + 3]);   \
    unsigned b0 = cvtpk(P[BASE + 4], P[BASE + 5]), b1 = cvtpk(P[BASE + 6], P[BASE + 7]);                              \
    auto r0 = __builtin_amdgcn_permlane32_swap(a0, b0, false, false); auto r1 = __builtin_amdgcn_permlane32_swap(a1, b1, false, false); \
    v4u w = {r0[0], r1[0], r0[1], r1[1]}; OUT = *reinterpret_cast<bf16x8*>(&w); } while (0)
  PK4(p0, 0, pa0); PK4(p0, 8, pa1); PK4(p1, 0, pa2); PK4(p1, 8, pa3);
#undef PK4
}
DI void qkt(f32x16& p0, f32x16& p1, const bf16* Ks, const bf16x8* qr, int r32, int hi) {
  p0 = f32x16{}; p1 = f32x16{};
#pragma unroll
  for (int d0 = 0; d0 < 8; ++d0) { int cb = (d0 * 16 + hi * 8) * 2;
    bf16x8 b0 = *reinterpret_cast<const bf16x8*>((const char*)Ks + KSWZ(r32, cb));
    bf16x8 b1 = *reinterpret_cast<const bf16x8*>((const char*)Ks + KSWZ(32 + r32, cb));
    p0 = __builtin_amdgcn_mfma_f32_32x32x16_bf16(b0, qr[d0], p0, 0, 0, 0);
    p1 = __builtin_amdgcn_mfma_f32_32x32x16_bf16(b1, qr[d0], p1, 0, 0, 0); }
}
DI int v_st(int k, int c) { const int kk = (k & ~0xC) | ((k & 4) << 1) | ((k & 8) >> 1); return ((kk >> 3) * 4 + (c >> 5)) * 512 + ((kk & 7) * 32 + (c & 31)) * 2; }
DI int v_rd_base(int lane) { return ((lane & 3) << 3) | (((lane >> 2) & 3) << 6) | (((lane >> 4) & 1) << 5) | (((lane >> 5) & 1) << 8); }
constexpr int v_rd_off(int d0, int ks, int half) { return d0 * 512 + ks * 4096 + half * 2048; }
template <int OFF> DI s16x4 tr_read(int vb) { s16x4 r; asm volatile("ds_read_b64_tr_b16 %0, %1 offset:%2" : "=&v"(r) : "v"(vb), "i"(OFF) : "memory"); return r; }
template <int D0> DI void pv_one(f32x16& od, int vb, bf16x8 pa0, bf16x8 pa1, bf16x8 pa2, bf16x8 pa3) {
  const s16x4 l0 = tr_read<v_rd_off(D0, 0, 0)>(vb), h0 = tr_read<v_rd_off(D0, 0, 1)>(vb), l1 = tr_read<v_rd_off(D0, 1, 0)>(vb), h1 = tr_read<v_rd_off(D0, 1, 1)>(vb);
  const s16x4 l2 = tr_read<v_rd_off(D0, 2, 0)>(vb), h2 = tr_read<v_rd_off(D0, 2, 1)>(vb), l3 = tr_read<v_rd_off(D0, 3, 0)>(vb), h3 = tr_read<v_rd_off(D0, 3, 1)>(vb);
  asm volatile("s_waitcnt lgkmcnt(0)" ::: "memory"); SBAR();
#define PK(L, H) (bf16x8){L[0], L[1], L[2], L[3], H[0], H[1], H[2], H[3]}
  od = __builtin_amdgcn_mfma_f32_32x32x16_bf16(pa0, PK(l0, h0), od, 0, 0, 0);
  od = __builtin_amdgcn_mfma_f32_32x32x16_bf16(pa1, PK(l1, h1), od, 0, 0, 0);
  od = __builtin_amdgcn_mfma_f32_32x32x16_bf16(pa2, PK(l2, h2), od, 0, 0, 0);
  od = __builtin_amdgcn_mfma_f32_32x32x16_bf16(pa3, PK(l3, h3), od, 0, 0, 0);
#undef PK
}
DI void pv_d0(f32x16* o, int vb, bf16x8 pa0, bf16x8 pa1, bf16x8 pa2, bf16x8 pa3) {
  pv_one<0>(o[0], vb, pa0, pa1, pa2, pa3); pv_one<1>(o[1], vb, pa0, pa1, pa2, pa3); pv_one<2>(o[2], vb, pa0, pa1, pa2, pa3); pv_one<3>(o[3], vb, pa0, pa1, pa2, pa3);
}
template <int LDQ, int LDK, int LDO, bool NA, int SDEPTH>
DI void attn_body(const bf16* __restrict__ Qb, const bf16* __restrict__ Kh, const bf16* __restrict__ Vh, bf16* __restrict__ Ob, int NT, char* lds, const NaCtx& nc, int wave_) {
  const int tid_ = tid_of(wave_);
  const int tid = tid_, wid = tid >> 6, lane = tid & 63, r32 = lane & 31, hi = lane >> 5;
  bf16* V_lds = (bf16*)lds; bf16* K_lds = (bf16*)(lds + 2 * SHM_V);
  float* ws = (float*)(lds + 2 * SHM_V + 2 * SHM_K) + wid * 64; float* li_l = ws; float* al_l = ws + 32;
  float m_reg = -1e30f, l_reg = 0; f32x16 o[4] = {}; bf16x8 qr[8];
  const bf16* Qw = Qb + (long)(wid * QBLK + r32) * LDQ + hi * 8;
#pragma unroll
  for (int d0 = 0; d0 < 8; ++d0) qr[d0] = *reinterpret_cast<const bf16x8*>(Qw + d0 * 16);
  const int sr = tid >> 4, sc = (tid & 15) * 8, vst0 = v_st(sr, sc), vst1 = v_st(32 + sr, sc);
  const int vb0 = (int)(uintptr_t)V_lds + v_rd_base(lane);
  struct { bf16x8 vs0, vs1, ks0, ks1; } sr_[SDEPTH];
#define SLOAD(i, k0) do { sr_[i].vs0 = *reinterpret_cast<const bf16x8*>(&Vh[(long)((k0) + sr) * LDK + sc]); sr_[i].vs1 = *reinterpret_cast<const bf16x8*>(&Vh[(long)((k0) + 32 + sr) * LDK + sc]); \
    sr_[i].ks0 = *reinterpret_cast<const bf16x8*>(&Kh[(long)((k0) + sr) * LDK + sc]); sr_[i].ks1 = *reinterpret_cast<const bf16x8*>(&Kh[(long)((k0) + 32 + sr) * LDK + sc]); } while (0)
#define SWRITE(b, i) do { *(bf16x8*)((char*)V_lds + (b) * SHM_V + vst0) = sr_[i].vs0;          \
    *(bf16x8*)((char*)V_lds + (b) * SHM_V + vst1) = sr_[i].vs1; int kc = sc * 2;               \
    *(bf16x8*)((char*)K_lds + (b) * SHM_K + KSWZ(sr, kc)) = sr_[i].ks0;                       \
    *(bf16x8*)((char*)K_lds + (b) * SHM_K + KSWZ(32 + sr, kc)) = sr_[i].ks1; } while (0)
#define SWAIT() do { if constexpr (SDEPTH == 2) asm volatile("s_waitcnt vmcnt(4)" ::: "memory"); else asm volatile("s_waitcnt vmcnt(0)" ::: "memory"); } while (0)
#define RESC(a) do { if (__any((a) < 1.f)) { if (hi == 0) al_l[r32] = (a); asm volatile("s_waitcnt lgkmcnt(0)" ::: "memory"); \
    _Pragma("unroll") for (int d = 0; d < 4; ++d) _Pragma("unroll") for (int r = 0; r < 16; ++r) o[d][r] *= al_l[crow(r, hi)]; } } while (0)
  f32x16 pA0, pA1, pB0, pB1; float mnA, mnB, alA, alB; bf16x8 pa0, pa1, pa2, pa3;
  constexpr int SE = 0, SO = SDEPTH - 1;
  SLOAD(SE, 0); asm volatile("s_waitcnt vmcnt(0)" ::: "memory"); SWRITE(0, SE); __syncthreads();
  qkt(pA0, pA1, K_lds, qr, r32, hi); mask_bias<NA>(pA0, pA1, 0, nc, hi); partialSM(pA0, pA1, m_reg, mnA, alA);
  SLOAD(SO, KVBLK); if constexpr (SDEPTH == 2) { if (2 < NT) SLOAD(SE, 2 * KVBLK); }
  SWAIT(); SWRITE(1, SO); __syncthreads();
  for (int j = 1; j + 1 < NT; j += 2) {
    SBAR(); qkt(pB0, pB1, (bf16*)((char*)K_lds + SHM_K), qr, r32, hi); mask_bias<NA>(pB0, pB1, j, nc, hi);
    finishSM(pA0, pA1, alA, l_reg, pa0, pa1, pa2, pa3); SBAR();
    SLOAD(SO, (j + SDEPTH) * KVBLK); SBAR();
    pv_d0(o, vb0, pa0, pa1, pa2, pa3); partialSM(pB0, pB1, m_reg, mnB, alB);
    __syncthreads(); SWAIT(); SWRITE(0, SE);
    RESC(alB); __syncthreads();
    SBAR(); qkt(pA0, pA1, K_lds, qr, r32, hi); mask_bias<NA>(pA0, pA1, j + 1, nc, hi);
    finishSM(pB0, pB1, alB, l_reg, pa0, pa1, pa2, pa3); SBAR();
    if (SDEPTH == 1 || j + 3 < NT) SLOAD(SE, (j + 1 + SDEPTH) * KVBLK); SBAR();
    pv_d0(o, vb0 + (int)SHM_V, pa0, pa1, pa2, pa3); partialSM(pA0, pA1, m_reg, mnA, alA);
    __syncthreads(); SWAIT(); SWRITE(1, SO);
    RESC(alA); __syncthreads();
  }
  SBAR(); qkt(pB0, pB1, (bf16*)((char*)K_lds + SHM_K), qr, r32, hi); mask_bias<NA>(pB0, pB1, NT - 1, nc, hi);
  finishSM(pA0, pA1, alA, l_reg, pa0, pa1, pa2, pa3); SBAR();
  pv_d0(o, vb0, pa0, pa1, pa2, pa3); partialSM(pB0, pB1, m_reg, mnB, alB);
  __syncthreads(); RESC(alB);
  finishSM(pB0, pB1, alB, l_reg, pa0, pa1, pa2, pa3); SBAR();
  pv_d0(o, vb0 + (int)SHM_V, pa0, pa1, pa2, pa3);
  if (hi == 0) li_l[r32] = l_reg; asm volatile("s_waitcnt lgkmcnt(0)" ::: "memory");
  float rli[16];
#pragma unroll
  for (int r = 0; r < 16; ++r) rli[r] = __builtin_amdgcn_rcpf(li_l[crow(r, hi)]);
  bf16* Ow = Ob + (long)(wid * QBLK) * LDO;
#pragma unroll
  for (int r = 0; r < 16; ++r) { int orow = crow(r, hi);
#pragma unroll
    for (int d0 = 0; d0 < 4; ++d0) Ow[(long)orow * LDO + d0 * 32 + r32] = f2bf(o[d0][r] * rli[r]); }
  __syncthreads();
#undef SLOAD
#undef SWRITE
#undef SWAIT
#undef RESC
}
#undef KSWZ
#undef SBAR
}
#define XB_TMO      128
#define XB_XCNT(j)  (256  + 64 * (j))
#define XB_XSUB(j)  (1280 + 64 * (j))
#define XB_XGEN(j)  (2304 + 64 * (j))
#define XB_TOP      3328
#define XB_TOPGEN   3392
#define XCD_BAR_WORDS 3456
#define XB_SPIN_CAP (1u << 18)

__device__ __forceinline__ unsigned xb_ld(unsigned* p)              { return __hip_atomic_load(p, __ATOMIC_RELAXED, __HIP_MEMORY_SCOPE_AGENT); }
__device__ __forceinline__ unsigned xb_add(unsigned* p, unsigned v) { return __hip_atomic_fetch_add(p, v, __ATOMIC_RELAXED, __HIP_MEMORY_SCOPE_AGENT); }
__device__ __forceinline__ unsigned xb_xcc_id() { return (unsigned)__builtin_amdgcn_s_getreg((3 << 11) | 20) & 0xFu; }
#define XB_SPIN(cond, bar) do { unsigned _sp = 0; while (cond) { __builtin_amdgcn_s_sleep(1); \
    if ((++_sp & 255u) == 0u) { if (xb_ld(&(bar)[XB_TMO])) break; if (_sp > XB_SPIN_CAP) { atomicAdd(&(bar)[XB_TMO], 1u); break; } } } } while (0)

struct XcdBarrier {
    unsigned* bar; unsigned x; int wave;
    volatile LAS unsigned* st;
};

__device__ __forceinline__ XcdBarrier xcd_barrier_post(unsigned* bar, volatile LAS unsigned* st, int wave) {
    XcdBarrier b; b.bar = bar; b.x = xb_xcc_id(); b.st = st; b.wave = wave;
    if (wave == 0 && lane_id() == 0) (void)xb_add(&bar[XB_XCNT(b.x)], 1u);
    return b;
}
__device__ __forceinline__ void xcd_barrier_complete(unsigned* bar, unsigned x, unsigned& nloc, unsigned& nx) {
    const unsigned G = gridDim.x * gridDim.y * gridDim.z;
    unsigned sum, cnt, mine, sp = 0u;
    for (;;) {
        sum = 0u; cnt = 0u; mine = 0u;
#pragma unroll
        for (unsigned j = 0; j < 16; ++j) { const unsigned c = xb_ld(&bar[XB_XCNT(j)]); sum += c; cnt += (c > 0u) ? 1u : 0u; mine = (j == x) ? c : mine; }
        if (sum == G) break;
        __builtin_amdgcn_s_sleep(1);
        if ((++sp & 255u) == 0u) { if (xb_ld(&bar[XB_TMO])) break; if (sp > XB_SPIN_CAP) { atomicAdd(&bar[XB_TMO], 1u); break; } }
    }
    nloc = mine > 0u ? mine : 1u; nx = cnt > 0u ? cnt : 1u;
}

__device__ __forceinline__ void xcd_barrier(const XcdBarrier& b) {
    asm volatile("s_waitcnt vmcnt(0)" ::: "memory");
    __syncthreads();
    if (b.wave == 0 && lane_id() == 0) {
        unsigned* bar = b.bar;
        __builtin_amdgcn_s_waitcnt(0);
        unsigned nloc = b.st[0], nx = b.st[1];
        if (nloc == 0u) { xcd_barrier_complete(bar, b.x, nloc, nx); b.st[0] = nloc; b.st[1] = nx; }
        const unsigned old = xb_add(&bar[XB_XSUB(b.x)], 1u);
        const unsigned gen = old / nloc;
        if (old + 1u == (gen + 1u) * nloc) {
            __builtin_amdgcn_fence(__ATOMIC_RELEASE, "agent");
            asm volatile("s_waitcnt vmcnt(0)" ::: "memory");
            const unsigned og = xb_add(&bar[XB_TOP], 1u);
            const unsigned tg = og / nx;
            if (og + 1u == (tg + 1u) * nx) xb_add(&bar[XB_TOPGEN], 1u);
            else XB_SPIN(xb_ld(&bar[XB_TOPGEN]) == tg, bar);
            __builtin_amdgcn_fence(__ATOMIC_ACQUIRE, "agent");
            xb_add(&bar[XB_XGEN(b.x)], 1u);
            asm volatile("s_waitcnt vmcnt(0)" ::: "memory");
        } else {
            XB_SPIN(xb_ld(&bar[XB_XGEN(b.x)]) == gen, bar);
            __builtin_amdgcn_fence(__ATOMIC_ACQUIRE, "agent");
            asm volatile("s_waitcnt vmcnt(0)" ::: "memory");
        }
    }
    __syncthreads();
}
struct Ctx { int tid, lane, wave, G, blk; int gw, ngw; };

DI void tr_item(const float* __restrict__ W, int ldw, int K, bf16* __restrict__ WT, int k0, int n0, int drow0, LAS float* scr, int lane) {
#pragma unroll 8
    for (int i = 0; i < 32; ++i) { const int kk = 2 * i + (lane >> 5); scr[kk * 33 + (lane & 31)] = W[(size_t)(k0 + kk) * ldw + n0 + (lane & 31)]; }
    LDS_WAIT(); asm volatile("" ::: "memory");
    const int c = lane & 7;
#pragma unroll
    for (int j = 0; j < 4; ++j) { const int n = (lane >> 3) + 8 * j; const LAS float* s = scr + (8 * c) * 33 + n;
        v4u o; o.x = pk2(s[0 * 33], s[1 * 33]); o.y = pk2(s[2 * 33], s[3 * 33]); o.z = pk2(s[4 * 33], s[5 * 33]); o.w = pk2(s[6 * 33], s[7 * 33]);
        *(v4u*)(WT + (size_t)(drow0 + n) * K + k0 + 8 * c) = o; }
    LDS_WAIT(); asm volatile("" ::: "memory");
}
struct WPtrs { const float *w_in, *w_br, *w_out, *w_up, *w_dn; bf16 *t_in, *t_br, *t_out, *t_up, *t_dn; };
DI void convert_weights(const Ctx& F, const WPtrs& P, LAS unsigned char* lds) {
    LAS float* scr = (LAS float*)(lds + F.wave * 8704);
    constexpr int I_IN = 32 * (NIN / 32), I_BR = 32 * 64, I_OUT = 32 * 64, I_UP = 32 * (NUP / 32), I_DN = (DFF / 64) * 64;
    constexpr int NITEMS = I_IN + I_BR + I_OUT + I_UP + I_DN;
    for (int it = F.gw; it < NITEMS; it += F.ngw) {
        int r = it;
        if (r < I_IN) { const int nblk = NIN / 32, kb = r / nblk, nb = r % nblk, n0 = nb * 32; tr_item(P.w_in, NIN, DM, P.t_in, kb * 64, n0, n0 < GATE_SRC0 ? n0 : n0 + (GATE_DST0 - GATE_SRC0), scr, F.lane); continue; } r -= I_IN;
        if (r < I_BR) { const int kb = r / 64, nb = r % 64; tr_item(P.w_br, DM, DM, P.t_br, kb * 64, nb * 32, nb * 32, scr, F.lane); continue; } r -= I_BR;
        if (r < I_OUT) { const int kb = r / 64, nb = r % 64; tr_item(P.w_out, DM, DM, P.t_out, kb * 64, nb * 32, nb * 32, scr, F.lane); continue; } r -= I_OUT;
        if (r < I_UP) { const int nblk = NUP / 32, kb = r / nblk, nb = r % nblk, n0 = nb * 32, isv = n0 >= DFF, nn = n0 - isv * DFF;
            tr_item(P.w_up, NUP, DM, P.t_up, kb * 64, n0, 256 * (nn >> 7) + 128 * isv + (nn & 127), scr, F.lane); continue; } r -= I_UP;
        { const int kb = r / 64, nb = r % 64; tr_item(P.w_dn, DM, DFF, P.t_dn, kb * 64, nb * 32, nb * 32, scr, F.lane); }
    }
}
DI void rmsnorm_rows(const Ctx& F, const float* __restrict__ x, const float* __restrict__ w, bf16* __restrict__ out, int rows) {
    for (int m = F.gw; m < rows; m += F.ngw) {
        const f32x4* xr = (const f32x4*)(x + (size_t)m * DM) + F.lane;
        f32x4 v[8]; float s = 0.f;
#pragma unroll
        for (int j = 0; j < 8; ++j) { v[j] = xr[64 * j]; s += (v[j].x * v[j].x + v[j].y * v[j].y) + (v[j].z * v[j].z + v[j].w * v[j].w); }
        const float rstd = 1.f / sqrtf(wave_sum(s) * (1.f / DM) + EPSN);
        v2u* o8 = (v2u*)(out + (size_t)m * DM) + F.lane;
#pragma unroll
        for (int j = 0; j < 8; ++j) { const f32x4 wv = ((const f32x4*)w)[F.lane + 64 * j];
            v2u o; o.x = pk2(v[j].x * rstd * wv.x, v[j].y * rstd * wv.y); o.y = pk2(v[j].z * rstd * wv.z, v[j].w * rstd * wv.w); o8[64 * j] = o; }
    }
}
struct PrepPtrs { bf16 *qna, *kna, *gq, *gk; const float *nq_na, *nk_na, *nq_g, *nk_g; };
DI void prep_qk(const Ctx& F, const PrepPtrs& P, int L) {
    const int sub = F.lane >> 4, j = F.lane & 15;
    const int a = j >> 3, b = (j >> 2) & 1, f0 = (j & 3) * 8;
    float wq_na[8], wk_na[8], wq_g[8], wk_g[8], invf[8];
#pragma unroll
    for (int e = 0; e < 8; ++e) { wq_na[e] = P.nq_na[j * 8 + e]; wk_na[e] = P.nk_na[j * 8 + e]; wq_g[e] = P.nq_g[j * 8 + e]; wk_g[e] = P.nk_g[j * 8 + e];
        invf[e] = exp2f(-(float)(f0 + e) * (13.287712379549449f / 32.f)); }
    for (int tok = F.gw * 4 + sub; tok < MG; tok += F.ngw * 4) {
        const int t = tok & (L - 1); const float pos = (float)(a ? (t & 63) : (t >> 6));
        float cs[8], sn[8];
#pragma unroll
        for (int e = 0; e < 8; ++e) { float rev = pos * invf[e] * 0.15915494309189535f; rev -= floorf(rev); sn[e] = __builtin_amdgcn_sinf(rev); cs[e] = __builtin_amdgcn_cosf(rev); }
#pragma unroll
        for (int v = 0; v < 14; ++v) {
            bf16* p; const float* w; bool rope;
            if (v < 4)       { p = P.qna + (size_t)tok * 512 + v * 128;        w = wq_na; rope = false; }
            else if (v < 8)  { p = P.kna + (size_t)tok * 512 + (v - 4) * 128;  w = wk_na; rope = false; }
            else if (v < 12) { p = P.gq + (size_t)tok * 512 + (v - 8) * 128;   w = wq_g;  rope = true; }
            else             { p = P.gk + (size_t)tok * 256 + (v - 12) * 128;  w = wk_g;  rope = true; }
            p += j * 8;
            float x[8]; unpack8(*(const v4u*)p, x);
            float ss = 0.f;
#pragma unroll
            for (int e = 0; e < 8; ++e) ss += x[e] * x[e];
            ss += xor_lane<1>(ss); ss += xor_lane<2>(ss); ss += xor_lane<4>(ss); ss += xor_lane<8>(ss);
            const float rstd = 1.f / sqrtf(ss * (1.f / 128.f) + EPSN);
            float y[8];
#pragma unroll
            for (int e = 0; e < 8; ++e) y[e] = x[e] * rstd * w[e];
            if (rope) {
#pragma unroll
                for (int e = 0; e < 8; ++e) { const float pr = xor_lane<4>(y[e]); y[e] = b ? (pr * sn[e] + y[e] * cs[e]) : (y[e] * cs[e] - pr * sn[e]); }
            }
            *(v4u*)p = pack8(y);
        }
    }
}
DI void prep_xbc(const Ctx& F, const bf16* __restrict__ src, bf16* __restrict__ dst, const float* __restrict__ cw, const float* __restrict__ cb, int L) {
    constexpr int NIT = (MG / 16) * 3;
    for (int it = F.gw; it < NIT; it += F.ngw) {
        const int tb = it / 3, cs = it % 3, c0 = cs * 512 + F.lane * 8, tok0 = tb * 16, slo = tok0 & ~(L - 1), shi = slo + L;
        float w[5][8], bias[8];
#pragma unroll
        for (int i = 0; i < 5; ++i) { const f32x4 a = *(const f32x4*)(cw + i * 1536 + c0), bq = *(const f32x4*)(cw + i * 1536 + c0 + 4);
            w[i][0] = a.x; w[i][1] = a.y; w[i][2] = a.z; w[i][3] = a.w; w[i][4] = bq.x; w[i][5] = bq.y; w[i][6] = bq.z; w[i][7] = bq.w; }
        { const f32x4 a = *(const f32x4*)(cb + c0), bq = *(const f32x4*)(cb + c0 + 4); bias[0] = a.x; bias[1] = a.y; bias[2] = a.z; bias[3] = a.w; bias[4] = bq.x; bias[5] = bq.y; bias[6] = bq.z; bias[7] = bq.w; }
        float r[5][8];
#define LDROW(dstr, tk) do { const int t_ = (tk); if (t_ >= slo && t_ < shi) unpack8(*(const v4u*)(src + (size_t)t_ * 1536 + c0), dstr); else { _Pragma("unroll") for (int e = 0; e < 8; ++e) dstr[e] = 0.f; } } while (0)
        LDROW(r[0], tok0 - 2); LDROW(r[1], tok0 - 1); LDROW(r[2], tok0); LDROW(r[3], tok0 + 1);
#pragma unroll
        for (int k = 0; k < 16; ++k) {
            LDROW(r[4], tok0 + k + 2);
            float y[8];
#pragma unroll
            for (int e = 0; e < 8; ++e) { float s = bias[e] + r[0][e] * w[0][e] + r[1][e] * w[1][e] + r[2][e] * w[2][e] + r[3][e] * w[3][e] + r[4][e] * w[4][e]; y[e] = siluf_(s); }
            *(v4u*)(dst + (size_t)(tok0 + k) * 1536 + c0) = pack8(y);
#pragma unroll
            for (int e = 0; e < 8; ++e) { r[0][e] = r[1][e]; r[1][e] = r[2][e]; r[2][e] = r[3][e]; r[3][e] = r[4][e]; }
        }
#undef LDROW
    }
}
DI void ffn_fix(const Ctx& F, const float* __restrict__ side, bf16* __restrict__ act, const float* __restrict__ cw, int L) {
    constexpr int NB = MG / 256 - 1, NIT = NB * DFF;
    for (int it = F.blk * 512 + F.tid; it < NIT; it += F.G * 512) {
        const int pmb = it / DFF + 1, c = it % DFF;
        if (((pmb * 256) & (L - 1)) == 0) continue;
        const float* sb = side + ((size_t)(pmb - 1) * 2 + 1) * 3 * DFF + c; const float* st = side + ((size_t)pmb * 2 + 0) * 3 * DFF + c;
        const float s_bot = sb[0], v_bot = sb[DFF], a_bot = sb[2 * DFF], s_top = st[0], v_top = st[DFF], a_top = st[2 * DFF];
        act[(size_t)(pmb * 256 - 1) * DFF + c] = f2bf(siluf_(s_bot + cw[2 * DFF + c] * a_top) * v_bot);
        act[(size_t)(pmb * 256) * DFF + c] = f2bf(siluf_(s_top + cw[c] * a_bot) * v_top);
    }
}
namespace ssd {
constexpr int IMG = 32768;
DI unsigned off_b(unsigned row, unsigned ch) { return 256u * row + 16u * (ch ^ (((row & 3) << 2) | ((row >> 2) & 3))); }
DI bf16x8 row_read(const LAS unsigned char* img, unsigned lane, unsigned rowbase, unsigned s) {
    return *(const LAS bf16x8*)(img + off_b(rowbase + (lane & 31), 2 * s + (lane >> 5)));
}
DI s16x4 tr_read4(const LAS unsigned char* img, unsigned lane, unsigned r0, unsigned c) {
    const unsigned blk = (lane >> 4) & 1, q = (lane & 15) >> 2, p = lane & 3;
    const LAS unsigned char* a = img + off_b(r0 + q, 4 * c + 2 * blk + (p >> 1)) + 8 * (p & 1);
    return __builtin_bit_cast(s16x4, __builtin_amdgcn_ds_read_tr16_b64_v4i16((LAS s16x4*)a));
}
DI bf16x8 cat8(s16x4 lo, s16x4 hi) { return (bf16x8){lo[0], lo[1], lo[2], lo[3], hi[0], hi[1], hi[2], hi[3]}; }
DI int crow(int r, int hi) { return (r & 3) + 8 * (r >> 2) + 4 * hi; }
DI void stage_img(LAS unsigned char* img, const bf16* __restrict__ src, int ld, int tid) {
#pragma unroll
    for (int i = 0; i < 4; ++i) { const int id = tid + 512 * i, row = id >> 4, ch = id & 15;
        const v4u v = *(const v4u*)(src + (size_t)row * ld + ch * 8);
        *(LAS v4u*)(img + off_b(row, ch)) = v; }
}
DI float softplusf_(float x) { return x > 20.f ? x : log1pf(__expf(x)); }
DI void dt_cum(const float* __restrict__ DT, int rowbase, int h, int dir, float bias, float a, int lane, float& dt0, float& dt1, float& c0, float& c1, float& tot) {
    const float r0 = DT[(size_t)(rowbase + 2 * lane) * 32 + dir * 16 + h], r1 = DT[(size_t)(rowbase + 2 * lane + 1) * 32 + dir * 16 + h];
    dt0 = softplusf_(r0 + bias); dt1 = softplusf_(r1 + bias);
    const float d0 = dt0 * a, d1 = dt1 * a;
    const float sc = wave_scan_incl(d0 + d1);
    tot = __int_as_float(__builtin_amdgcn_readlane(__float_as_int(sc), 63));
    if (dir == 0) { c1 = sc; c0 = sc - d1; }
    else { c1 = tot - sc + d1; c0 = tot - sc + d1 + d0; }
}
struct Ptrs {
    const bf16* xbca;
    const float* dt;
    const bf16* z;
    bf16* states;
    float* dec;
    bf16* o;
    float* ys;
    const float *dt_bias, *a_log, *dskip, *norm_w;
};
constexpr int L_B = 0, L_C = IMG, L_X0 = 2 * IMG, L_X1 = 3 * IMG, L_ARR = 4 * IMG, L_SSQ = 4 * IMG + 8192;

DI void s1_unit(const Ptrs& P, LAS unsigned char* lds, int c, int g, int tid) {
    const int lane = tid & 63, w = __builtin_amdgcn_readfirstlane(tid >> 6), hl = w >> 1, nh = w & 1, hh = lane >> 5, r = lane & 31;
    const int rowbase = c * 128;
    __syncthreads();
    stage_img(lds + L_B, P.xbca + (size_t)rowbase * 1536 + 1024 + g * 128, 1536, tid);
#pragma unroll 1
    for (int quad = 0; quad < 2; ++quad) {
        const int hq = 8 * g + 4 * quad;
        if (quad) __syncthreads();
        stage_img(lds + L_X0, P.xbca + (size_t)rowbase * 1536 + hq * 64, 1536, tid);
        stage_img(lds + L_X1, P.xbca + (size_t)rowbase * 1536 + hq * 64 + 128, 1536, tid);
        {
            const int h = hq + hl, dir = nh; float dt0, dt1, c0, c1, tot;
            dt_cum(P.dt, rowbase, h, dir, P.dt_bias[dir * 16 + h], -__expf(P.a_log[dir * 16 + h]), lane, dt0, dt1, c0, c1, tot);
            LAS float* wg = (LAS float*)(lds + L_ARR) + (hl * 2 + dir) * 128;
            wg[2 * lane] = dt0 * __expf(tot - c0); wg[2 * lane + 1] = dt1 * __expf(tot - c1);
            if (lane == 0) P.dec[(size_t)(c * 2 + dir) * 16 + h] = __expf(tot);
        }
        __syncthreads();
        const LAS unsigned char* ximg = lds + (hl >> 1 ? L_X1 : L_X0);
        const int h = hq + hl;
#pragma unroll 1
        for (int dir = 0; dir < 2; ++dir) {
            const LAS float* wg = (const LAS float*)(lds + L_ARR) + (hl * 2 + dir) * 128;
            f32x16 acc[2][2];
#pragma unroll
            for (int i = 0; i < 2; ++i)
#pragma unroll
                for (int k = 0; k < 2; ++k) acc[i][k] = f32x16{};
#pragma unroll 2
            for (int ks = 0; ks < 8; ++ks) {
                bf16x8 af[2], bfr[2];
#pragma unroll
                for (int nb = 0; nb < 2; ++nb) af[nb] = cat8(tr_read4(lds + L_B, lane, 16 * ks + 8 * hh, 2 * nh + nb), tr_read4(lds + L_B, lane, 16 * ks + 8 * hh + 4, 2 * nh + nb));
                const f32x4 w0 = *(const LAS f32x4*)(wg + 16 * ks + 8 * hh), w1 = *(const LAS f32x4*)(wg + 16 * ks + 8 * hh + 4);
#pragma unroll
                for (int pb = 0; pb < 2; ++pb) {
                    const s16x4 lo = tr_read4(ximg, lane, 16 * ks + 8 * hh, 2 * (hl & 1) + pb), hi4 = tr_read4(ximg, lane, 16 * ks + 8 * hh + 4, 2 * (hl & 1) + pb);
                    v4u pk; pk.x = pk2(bf2f((unsigned short)lo[0]) * w0.x, bf2f((unsigned short)lo[1]) * w0.y); pk.y = pk2(bf2f((unsigned short)lo[2]) * w0.z, bf2f((unsigned short)lo[3]) * w0.w);
                    pk.z = pk2(bf2f((unsigned short)hi4[0]) * w1.x, bf2f((unsigned short)hi4[1]) * w1.y); pk.w = pk2(bf2f((unsigned short)hi4[2]) * w1.z, bf2f((unsigned short)hi4[3]) * w1.w);
                    bfr[pb] = __builtin_bit_cast(bf16x8, pk);
                }
#pragma unroll
                for (int nb = 0; nb < 2; ++nb)
#pragma unroll
                    for (int pb = 0; pb < 2; ++pb) acc[nb][pb] = __builtin_amdgcn_mfma_f32_32x32x16_bf16(af[nb], bfr[pb], acc[nb][pb], 0, 0, 0);
            }
            bf16* sp = P.states + ((size_t)(c * 2 + dir) * 16 + h) * 8192;
#pragma unroll
            for (int nb = 0; nb < 2; ++nb)
#pragma unroll
                for (int pb = 0; pb < 2; ++pb)
#pragma unroll
                    for (int i4 = 0; i4 < 4; ++i4) { const int n0 = 64 * nh + 32 * nb + 8 * i4 + 4 * hh, p = 32 * pb + r;
                        v2u o; o.x = pk2(acc[nb][pb][4 * i4], acc[nb][pb][4 * i4 + 1]); o.y = pk2(acc[nb][pb][4 * i4 + 2], acc[nb][pb][4 * i4 + 3]);
                        *(v2u*)(sp + p * 128 + n0) = o; }
        }
    }
}
DI void scan_states(const Ctx& F, bf16* __restrict__ states, const float* __restrict__ dec, int nseq, int ncs) {
    const int ntask = nseq * 65536, nthr = F.G * 512;
    for (int task = F.blk * 512 + F.tid; task < ntask; task += nthr) {
        const int n4 = task & 31, p = (task >> 5) & 63, h = (task >> 11) & 15, dir = (task >> 15) & 1, s = task >> 16;
        const int cbase = s * ncs;
        float run[4] = {0.f, 0.f, 0.f, 0.f};
        for (int k0 = 0; k0 < ncs; k0 += 8) {
            v2u v[8]; float dc[8];
#pragma unroll
            for (int k = 0; k < 8; ++k) { const int cc = cbase + (dir ? ncs - 1 - (k0 + k) : (k0 + k));
                v[k] = *(const v2u*)(states + (((size_t)(cc * 2 + dir) * 16 + h) * 64 + p) * 128 + n4 * 4); dc[k] = dec[(size_t)(cc * 2 + dir) * 16 + h]; }
#pragma unroll
            for (int k = 0; k < 8; ++k) { const int cc = cbase + (dir ? ncs - 1 - (k0 + k) : (k0 + k));
                v2u o; o.x = pk2(run[0], run[1]); o.y = pk2(run[2], run[3]);
                *(v2u*)(states + (((size_t)(cc * 2 + dir) * 16 + h) * 64 + p) * 128 + n4 * 4) = o;
                run[0] = run[0] * dc[k] + bflo(v[k].x); run[1] = run[1] * dc[k] + bfhi(v[k].x); run[2] = run[2] * dc[k] + bflo(v[k].y); run[3] = run[3] * dc[k] + bfhi(v[k].y); }
        }
    }
}
template <int QUAD>
DI void s3_pass(const Ptrs& P, LAS unsigned char* lds, int c, int g, int tid) {
    const int lane = tid & 63, w = __builtin_amdgcn_readfirstlane(tid >> 6), hl = w >> 1, lh = w & 1, hh = lane >> 5, r = lane & 31;
    const int rowbase = c * 128, hq = 8 * g + 4 * QUAD, h = hq + hl;
    if (QUAD) __syncthreads();
    stage_img(lds + L_X0, P.xbca + (size_t)rowbase * 1536 + hq * 64, 1536, tid);
    stage_img(lds + L_X1, P.xbca + (size_t)rowbase * 1536 + hq * 64 + 128, 1536, tid);
    LAS float* arr = (LAS float*)(lds + L_ARR);
    {   const int dir = lh; float dt0, dt1, c0, c1, tot;
        dt_cum(P.dt, rowbase, h, dir, P.dt_bias[dir * 16 + h], -__expf(P.a_log[dir * 16 + h]), lane, dt0, dt1, c0, c1, tot);
        LAS float* a = arr + hl * 512;
        a[dir * 128 + 2 * lane] = dt0; a[dir * 128 + 2 * lane + 1] = dt1; a[(2 + dir) * 128 + 2 * lane] = c0; a[(2 + dir) * 128 + 2 * lane + 1] = c1; }
    __syncthreads();
    const LAS float* aD0 = arr + hl * 512, *aD1 = aD0 + 128, *aCF = aD0 + 256, *aCR = aD0 + 384;
    const LAS unsigned char* ximg = lds + (hl >> 1 ? L_X1 : L_X0);
    const bf16* pf = P.states + ((size_t)(c * 2 + 0) * 16 + h) * 8192, *pb_ = P.states + ((size_t)(c * 2 + 1) * 16 + h) * 8192;
    const float dsk = P.dskip[h];
    LAS float* ssq = (LAS float*)(lds + L_SSQ);
#pragma unroll 1
    for (int lb = 0; lb < 2; ++lb) {
        f32x16 acc[2];
        acc[0] = f32x16{}; acc[1] = f32x16{};
        const int l0 = 64 * lh + 32 * lb, l = l0 + r; const float cf_l = aCF[l], cr_l = aCR[l];
#pragma unroll 1
        for (int sb = 0; sb < 4; ++sb) {
            const int s0 = 32 * sb;
            f32x16 X = f32x16{};
#pragma unroll
            for (int ks = 0; ks < 8; ++ks) X = __builtin_amdgcn_mfma_f32_32x32x16_bf16(row_read(lds + L_B, lane, s0, ks), row_read(lds + L_C, lane, l0, ks), X, 0, 0, 0);
#pragma unroll
            for (int i = 0; i < 16; ++i) { const int s = s0 + crow(i, hh);
                float f = 0.f;
                if (s <= l) f += __expf(cf_l - aCF[s]) * aD0[s];
                if (s >= l) f += __expf(cr_l - aCR[s]) * aD1[s];
                X[i] *= f; }
#pragma unroll
            for (int sp = 0; sp < 2; ++sp) {
                v4u pk; pk.x = pk2(X[8 * sp], X[8 * sp + 1]); pk.y = pk2(X[8 * sp + 2], X[8 * sp + 3]); pk.z = pk2(X[8 * sp + 4], X[8 * sp + 5]); pk.w = pk2(X[8 * sp + 6], X[8 * sp + 7]);
                const bf16x8 af = __builtin_bit_cast(bf16x8, pk);
#pragma unroll
                for (int pb = 0; pb < 2; ++pb) {
                    const bf16x8 bfr = cat8(tr_read4(ximg, lane, s0 + 16 * sp + 4 * hh, 2 * (hl & 1) + pb), tr_read4(ximg, lane, s0 + 16 * sp + 8 + 4 * hh, 2 * (hl & 1) + pb));
                    acc[pb] = __builtin_amdgcn_mfma_f32_32x32x16_bf16(af, bfr, acc[pb], 0, 0, 0);
                }
            }
        }
        {
            const float ef = __expf(cf_l), eb = __expf(cr_l);
#pragma unroll 2
            for (int ks = 0; ks < 8; ++ks) {
                bf16x8 bF[2], bB[2];
#pragma unroll
                for (int pb = 0; pb < 2; ++pb) { bF[pb] = *(const bf16x8*)(pf + (32 * pb + r) * 128 + 16 * ks + 8 * hh); bB[pb] = *(const bf16x8*)(pb_ + (32 * pb + r) * 128 + 16 * ks + 8 * hh); }
                const bf16x8 cfr = row_read(lds + L_C, lane, l0, ks);
                float x[8]; unpack8(__builtin_bit_cast(v4u, cfr), x);
                float xf[8], xb[8];
#pragma unroll
                for (int e = 0; e < 8; ++e) { xf[e] = x[e] * ef; xb[e] = x[e] * eb; }
                const bf16x8 aF = __builtin_bit_cast(bf16x8, pack8(xf)), aB = __builtin_bit_cast(bf16x8, pack8(xb));
#pragma unroll
                for (int pb = 0; pb < 2; ++pb) { acc[pb] = __builtin_amdgcn_mfma_f32_32x32x16_bf16(aF, bF[pb], acc[pb], 0, 0, 0);
                    acc[pb] = __builtin_amdgcn_mfma_f32_32x32x16_bf16(aB, bB[pb], acc[pb], 0, 0, 0); }
            }
        }
#pragma unroll
        for (int i = 0; i < 16; ++i) {
            const int li = l0 + crow(i, hh);
            float sq = 0.f;
#pragma unroll
            for (int pb = 0; pb < 2; ++pb) {
                const int p = 32 * pb + r, col = (hl & 1) * 64 + p;
                const float xs = bf2f(*(const LAS unsigned short*)(ximg + off_b(li, col >> 3) + 2 * (col & 7)));
                const float zz = bf2f(P.z[(size_t)(rowbase + li) * 1024 + h * 64 + p]);
                const float y = (acc[pb][i] + dsk * xs) * siluf_(zz);
                P.ys[(size_t)(rowbase + li) * 1024 + h * 64 + p] = y; sq += y * y;
            }
            sq += xor_lane<1>(sq); sq += xor_lane<2>(sq); sq += xor_lane<4>(sq); sq += xor_lane<8>(sq); sq += xor_lane<16>(sq);
            if (r == 0) ssq[(QUAD * 4 + hl) * 128 + li] = sq;
        }
    }
}
DI void s3_store(const Ptrs& P, LAS unsigned char* lds, int c, int g, int quad, int tid) {
    const int lane = tid & 63, w = __builtin_amdgcn_readfirstlane(tid >> 6), hl = w >> 1, lh = w & 1, hh = lane >> 5, r = lane & 31;
    const int rowbase = c * 128, h = 8 * g + 4 * quad + hl;
    const LAS float* ssq = (const LAS float*)(lds + L_SSQ);
    float nw[2];
#pragma unroll
    for (int pb = 0; pb < 2; ++pb) nw[pb] = P.norm_w[h * 64 + 32 * pb + r];
#pragma unroll
    for (int lb = 0; lb < 2; ++lb)
#pragma unroll 4
        for (int i = 0; i < 16; ++i) { const int l = 64 * lh + 32 * lb + crow(i, hh);
            float tot = 0.f;
#pragma unroll
            for (int k = 0; k < 8; ++k) tot += ssq[k * 128 + l];
            const float rstd = 1.f / sqrtf(tot * (1.f / 512.f) + EPSN);
#pragma unroll
            for (int pb = 0; pb < 2; ++pb) { const size_t e = (size_t)(rowbase + l) * 1024 + h * 64 + 32 * pb + r;
                P.o[(size_t)(rowbase + l) * 2048 + 512 + h * 64 + 32 * pb + r] = f2bf(P.ys[e] * rstd * nw[pb]); } }
}
DI void s3_unit(const Ptrs& P, LAS unsigned char* lds, int c, int g, int tid) {
    const int rowbase = c * 128;
    __syncthreads();
    stage_img(lds + L_B, P.xbca + (size_t)rowbase * 1536 + 1024 + g * 128, 1536, tid);
    stage_img(lds + L_C, P.xbca + (size_t)rowbase * 1536 + 1280 + g * 128, 1536, tid);
    s3_pass<0>(P, lds, c, g, tid);
    s3_pass<1>(P, lds, c, g, tid);
    VM_WAIT();
    __syncthreads();
    s3_store(P, lds, c, g, 0, tid);
    s3_store(P, lds, c, g, 1, tid);
}
}
constexpr size_t MiB = 1u << 20;
constexpr size_t WS_CTL = 0, CTL_ZERO_BYTES = 1 * MiB;
constexpr size_t WS_TIN = 2 * MiB, WS_TBR = 47 * MiB, WS_TOUT = 55 * MiB, WS_TUP = 63 * MiB, WS_TDN = 107 * MiB;
constexpr size_t WS_H = 129 * MiB;
constexpr size_t WS_R1 = 193 * MiB;
constexpr size_t R_QNA = 0, R_KNA = 16 * MiB, R_VNA = 32 * MiB, R_GQ = 48 * MiB, R_GK = 64 * MiB, R_GV = 72 * MiB, R_Z = 80 * MiB, R_XBC = 112 * MiB, R_DT = 160 * MiB, R_GATE = 162 * MiB;
constexpr size_t WS_XBCA = 547 * MiB, WS_ST = 595 * MiB, WS_O = 659 * MiB, WS_TMPF = 723 * MiB, WS_MRG = 851 * MiB, WS_DEC = 915 * MiB, WS_SIDE = 916 * MiB, WS_END = 926 * MiB;
constexpr size_t WS_ACT = 547 * MiB;
static_assert(WS_TIN + (size_t)NINP * DM * 2 <= WS_TBR && WS_TUP + (size_t)NUP * DM * 2 <= WS_TDN && WS_TDN + (size_t)DM * DFF * 2 <= WS_H, "weights map");
static_assert(WS_R1 + R_GATE + (size_t)MG * 6144 * 2 <= WS_XBCA && WS_R1 + (size_t)MG * NUP * 2 <= WS_XBCA && WS_ACT + (size_t)MG * DFF * 2 <= WS_MRG, "activation map");
constexpr int CW_BAR = 4096;

constexpr int LDS_BYTES = 147456, MISC_OFF = LDS_BYTES - 256;


#ifndef DBG_STOP
#define DBG_STOP 0
#endif
DI void dbg_fold(const Ctx& F, float* out, const bf16* buf, int rows, int ld, int c0, int nc, bool first) {
    const size_t n = (size_t)rows * 2048; const int t_ = tid_of(F.wave);
    for (size_t i = (size_t)F.blk * 512 + t_; i < n; i += (size_t)F.G * 512) {
        const int row = (int)(i >> 11), c = (int)(i & 2047); float s = first ? 0.f : out[i];
        for (int cc = c; cc < nc; cc += 2048) s += (float)buf[(size_t)row * ld + c0 + cc];
        out[i] = s; }
}
struct Args { const float* in[22]; float* out; unsigned char* ws; };

#define REFRESH() do { const int tv_ = tid_of(F.wave); F.tid = tv_; F.lane = tv_ & 63; } while (0)
#define GRID_BAR() do { XcdBarrier b_ = bar; asm volatile("" : "+s"(b_.bar)); b_.bar = (unsigned*)(GAS unsigned*)b_.bar; b_.x = xb_xcc_id(); xcd_barrier(b_); REFRESH(); } while (0)
#define OPQ_PTRS() \
    bf16* T_IN = (bf16*)(ws + WS_TIN); bf16* T_BR = (bf16*)(ws + WS_TBR); bf16* T_OUT = (bf16*)(ws + WS_TOUT); bf16* T_UP = (bf16*)(ws + WS_TUP); bf16* T_DN = (bf16*)(ws + WS_TDN); \
    bf16* H = (bf16*)(ws + WS_H); unsigned char* R1 = ws + WS_R1; \
    bf16* QNA = (bf16*)(R1 + R_QNA); bf16* KNA = (bf16*)(R1 + R_KNA); bf16* VNA = (bf16*)(R1 + R_VNA); bf16* GQ = (bf16*)(R1 + R_GQ); bf16* GK = (bf16*)(R1 + R_GK); bf16* GV = (bf16*)(R1 + R_GV); \
    bf16* Z = (bf16*)(R1 + R_Z); bf16* XBC = (bf16*)(R1 + R_XBC); float* DT = (float*)(R1 + R_DT); bf16* GATE = (bf16*)(R1 + R_GATE); bf16* U = (bf16*)R1; \
    bf16* XBCA = (bf16*)(ws + WS_XBCA); bf16* ST = (bf16*)(ws + WS_ST); bf16* O = (bf16*)(ws + WS_O); float* TMPF = (float*)(ws + WS_TMPF); bf16* MRG = (bf16*)(ws + WS_MRG); \
    float* DEC = (float*)(ws + WS_DEC); bf16* ACT = (bf16*)(ws + WS_ACT); float* SIDE = (float*)(ws + WS_SIDE);
__global__ void __launch_bounds__(512, 2) fwd_kernel(Args args) {
    extern __shared__ __attribute__((aligned(16))) unsigned char lds_raw[];
    LAS unsigned char* lds = (LAS unsigned char*)lds_raw;
    Ctx F; F.tid = threadIdx.x; F.lane = F.tid & 63; F.wave = __builtin_amdgcn_readfirstlane(F.tid >> 6); F.G = gridDim.x; F.blk = blockIdx.x;
    F.gw = F.blk * 8 + F.wave; F.ngw = F.G * 8;
    typedef const __attribute__((address_space(4))) Args* KArgs;
    const KArgs kp0 = (KArgs)__builtin_amdgcn_kernarg_segment_ptr();
#define KP() ({ KArgs k_ = kp0; asm volatile("" : "+s"(k_)); k_; })
#define GIN(i) ((const float*)(const GAS float*)(KP()->in[i]))
#define GOUT() ((float*)(GAS float*)(KP()->out))
#define GWS() ((unsigned char*)(GAS unsigned char*)(KP()->ws))
    unsigned char* ws = GWS();
    if (F.tid < 64) ((LAS unsigned*)(lds + MISC_OFF))[F.tid] = 0u;
    __syncthreads();
    XcdBarrier bar = xcd_barrier_post((unsigned*)(ws + WS_CTL) + CW_BAR, (volatile LAS unsigned*)(lds + MISC_OFF), F.wave);

#if DBG_STOP
    { float* o_ = GOUT(); const int t_ = tid_of(F.wave); for (size_t i = (size_t)MG * DM + (size_t)F.blk * 512 + t_; i < (size_t)MTOT * DM; i += (size_t)F.G * 512) o_[i] = 0.f; }
#endif
#pragma unroll 1
    for (int layer = 0; layer < (DBG_STOP ? 1 : DEPTH); ++layer) {
#pragma unroll 1
        for (int grp = 0; grp < (DBG_STOP ? 1 : NGRP); ++grp) {
            REFRESH();
            ws = GWS();
            OPQ_PTRS();
            const int L = grp == 0 ? 16384 : 2048, nseq = MG / L, ncs = L / 128;
            const float* xin0 = grp == 0 ? GIN(0) : GIN(1) + (size_t)(grp - 1) * MG * DM;
            float* xo = GOUT() + (size_t)grp * MG * DM;
            const float* xcur = layer == 0 ? xin0 : xo;
#ifndef SKIP_CONV
            if (grp == 0) {
                WPtrs WP{GIN(3) + (size_t)layer * DM * NIN, GIN(15) + (size_t)layer * DM * DM, GIN(16) + (size_t)layer * DM * DM, GIN(18) + (size_t)layer * DM * NUP,
                         GIN(21) + (size_t)layer * DFF * DM, T_IN, T_BR, T_OUT, T_UP, T_DN};
                convert_weights(F, WP, lds);
            }
#endif
            REFRESH();
            rmsnorm_rows(F, xcur, GIN(2) + layer * DM, H, MG);
            GRID_BAR();
#if DBG_STOP == 1
            { dbg_fold(F, GOUT(), H, MG, 2048, 0, 2048, true); dbg_fold(F, GOUT(), T_IN, 11264, 2048, 0, 2048, false); dbg_fold(F, GOUT(), T_UP, 11264, 2048, 0, 2048, false); break; }
#endif
#ifndef SKIP_P1
            {   pg8::Gemm g{H, T_IN, MG, NINP, DM, DM, DM}; pg8::StaticOrder S; S.init(MG, NINP, F.G, F.blk);
                pg8::EpiInProj E{R1, R_QNA, R_KNA, R_VNA, R_GQ, R_GK, R_GV, R_Z, R_XBC, R_DT, R_GATE};
                pg8::gemm_phase<pg8::EpiInProj, pg8::StaticOrder, true, true>(lds, g, S, E, F.wave); }
#endif
            GRID_BAR();
#if DBG_STOP == 2
            { dbg_fold(F, GOUT(), QNA, MG, 512, 0, 512, true); dbg_fold(F, GOUT(), KNA, MG, 512, 0, 512, false); dbg_fold(F, GOUT(), VNA, MG, 512, 0, 512, false); dbg_fold(F, GOUT(), GQ, MG, 512, 0, 512, false); dbg_fold(F, GOUT(), GK, MG, 256, 0, 256, false); dbg_fold(F, GOUT(), GV, MG, 256, 0, 256, false); dbg_fold(F, GOUT(), Z, MG, 1024, 0, 1024, false); dbg_fold(F, GOUT(), XBC, MG, 1536, 0, 1536, false); dbg_fold(F, GOUT(), GATE, MG, 6144, 0, 6144, false); dbg_fold(F, GOUT(), (const bf16*)DT, MG, 64, 0, 64, false); break; }
#endif
#ifndef SKIP_P2
            {   PrepPtrs PP{QNA, KNA, GQ, GK, GIN(4) + layer * 128, GIN(5) + layer * 128, GIN(13) + layer * 128, GIN(14) + layer * 128};
                prep_qk(F, PP, L);
                REFRESH();
                prep_xbc(F, XBC, XBCA, GIN(7) + (size_t)layer * 5 * 1536, GIN(8) + (size_t)layer * 1536, L); }
#endif
            GRID_BAR();
#if DBG_STOP == 3
            { dbg_fold(F, GOUT(), QNA, MG, 512, 0, 512, true); dbg_fold(F, GOUT(), KNA, MG, 512, 0, 512, false); dbg_fold(F, GOUT(), GQ, MG, 512, 0, 512, false); dbg_fold(F, GOUT(), GK, MG, 256, 0, 256, false); dbg_fold(F, GOUT(), XBCA, MG, 1536, 0, 1536, false); break; }
#endif
            ssd::Ptrs SP{XBCA, DT, Z, ST, DEC, O, TMPF, GIN(9) + layer * 32, GIN(10) + layer * 32, GIN(11) + layer * 16, GIN(12) + layer * 1024};
            {
#ifndef SKIP_NA
                const int rows = L / 64;
                for (int u = F.blk; u < (MG / 256) * 4; u += F.G) {
                    const int b = u >> 2, h = u & 3, row0 = b * 256, t0 = row0 & (L - 1), r0 = t0 >> 6, seq0 = row0 - t0;
                    int rs0 = r0 - 4; rs0 = rs0 < 0 ? 0 : (rs0 > rows - 8 ? rows - 8 : rs0);
                    const int NT = (r0 == 0 || r0 == rows - 4) ? 8 : 12;
                    __syncthreads();
                    {   LAS float* rp = (LAS float*)(lds + att::SHM_RPB); const float* src = GIN(6) + ((size_t)layer * 4 + h) * 15 * 31;
                        for (int i = F.tid; i < 15 * 31; i += 512) rp[(i / 31) * 32 + (i % 31)] = src[i] * (1.f / att::SCALE); }
                    const int r = r0 + (F.wave >> 1); int rs = r - 4; rs = rs < 0 ? 0 : (rs > rows - 8 ? rows - 8 : rs);
                    const int cq = 32 * (F.wave & 1) + (F.lane & 31); int cs = cq - 8; cs = cs < 0 ? 0 : (cs > 48 ? 48 : cs);
                    att::NaCtx nc{__builtin_amdgcn_readfirstlane(rs - rs0), __builtin_amdgcn_readfirstlane(rs0 - r), cq, cs, (const float*)(lds_raw + att::SHM_RPB)};
                    att::attn_body<512, 512, 2048, true, 1>(QNA + (size_t)row0 * 512 + h * 128, KNA + (size_t)(seq0 + rs0 * 64) * 512 + h * 128, VNA + (size_t)(seq0 + rs0 * 64) * 512 + h * 128,
                                                         O + (size_t)row0 * 2048 + h * 128, NT, (char*)lds_raw, nc, F.wave);
                }
#endif
                REFRESH();
#ifdef ABL_GQA
                { const int t_ = tid_of(F.wave); for (size_t i = (size_t)F.blk * 512 + t_; i < (size_t)MG * 64; i += (size_t)F.G * 512) { const size_t row = i >> 6, c = (i & 63) * 8; *(v4u*)(O + row * 2048 + 1536 + c) = (v4u){0u, 0u, 0u, 0u}; } }
#else
                const int qbs = L / 256;
                for (int u = F.blk; u < nseq * 4 * qbs; u += F.G) {
                    const int qb = u % qbs, h = (u / qbs) & 3, s = u / (qbs * 4), seq0 = s * L;
                    att::NaCtx nc{0, 0, 0, 0, nullptr};
                    att::attn_body<512, 256, 2048, false, 2>(GQ + (size_t)(seq0 + qb * 256) * 512 + h * 128, GK + (size_t)seq0 * 256 + (h >> 1) * 128, GV + (size_t)seq0 * 256 + (h >> 1) * 128,
                                                          O + (size_t)(seq0 + qb * 256) * 2048 + 1536 + h * 128, L / 64, (char*)lds_raw, nc, F.wave);
                }
#endif
                REFRESH();
#ifndef SKIP_S1
                for (int u = F.blk; u < (MG / 128) * 2; u += F.G) ssd::s1_unit(SP, lds, u >> 1, u & 1, F.tid);
#endif
            }
            GRID_BAR();
#if DBG_STOP == 4
            { dbg_fold(F, GOUT(), O, MG, 2048, 0, 512, true); dbg_fold(F, GOUT(), O, MG, 2048, 1536, 512, false); dbg_fold(F, GOUT(), ST, MG, 2048, 0, 2048, false); break; }
#endif
#ifndef SKIP_S2
            ssd::scan_states(F, ST, DEC, nseq, ncs);
#endif
            GRID_BAR();
#if DBG_STOP == 5
            { dbg_fold(F, GOUT(), ST, MG, 2048, 0, 2048, true); break; }
#endif
#ifndef SKIP_S3
            for (int u = F.blk; u < (MG / 128) * 2; u += F.G) ssd::s3_unit(SP, lds, u >> 1, u & 1, F.tid);
#endif
            GRID_BAR();
#if DBG_STOP == 6
            { dbg_fold(F, GOUT(), O, MG, 2048, 0, 2048, true); break; }
#endif
#ifndef SKIP_P6
            {   pg8::Gemm g{O, T_BR, MG, DM, DM, DM, DM}; pg8::StaticOrder S; S.init(MG, DM, F.G, F.blk);
                pg8::EpiMerge E{GATE, MRG};
                pg8::gemm_phase<pg8::EpiMerge, pg8::StaticOrder, true, true>(lds, g, S, E, F.wave); }
#endif
            GRID_BAR();
#if DBG_STOP == 7
            { dbg_fold(F, GOUT(), MRG, MG, 2048, 0, 2048, true); break; }
#endif
#ifndef SKIP_P7
            {   pg8::Gemm g{MRG, T_OUT, MG, DM, DM, DM, DM}; pg8::StaticOrder S; S.init(MG, DM, F.G, F.blk);
                pg8::EpiResid E{xcur, xo};
                pg8::gemm_phase<pg8::EpiResid, pg8::StaticOrder, true, true>(lds, g, S, E, F.wave); }
#endif
            GRID_BAR();
#if DBG_STOP == 8
            {  break; }
#endif
            rmsnorm_rows(F, xo, GIN(17) + layer * DM, H, MG);
            GRID_BAR();
#ifndef SKIP_P9
            {   pg8::Gemm g{H, T_UP, MG, NUP, DM, DM, DM}; pg8::StaticOrder S; S.init(MG, NUP, F.G, F.blk);
                pg8::EpiFfnAct E{ACT, GIN(19) + (size_t)layer * 3 * DFF, GIN(20) + (size_t)layer * DFF, SIDE, (LAS float*)(lds + 131072)};
                pg8::gemm_phase<pg8::EpiFfnAct, pg8::StaticOrder, true, true>(lds, g, S, E, F.wave); }
#endif
            GRID_BAR();
#ifndef SKIP_P10
            ffn_fix(F, SIDE, ACT, GIN(19) + (size_t)layer * 3 * DFF, L);
#endif
            GRID_BAR();
#ifndef SKIP_P11
            {   pg8::Gemm g{ACT, T_DN, MG, DM, DFF, DFF, DFF}; pg8::StaticOrder S; S.init(MG, DM, F.G, F.blk);
                pg8::EpiResid E{xo, xo};
                pg8::gemm_phase<pg8::EpiResid, pg8::StaticOrder, true, true>(lds, g, S, E, F.wave); }
#endif
            GRID_BAR();
        }
    }
}

extern "C" void kernel_launch(void* const* d_in, const int* in_sizes, int n_in, void* d_out, int out_size, void* d_ws, size_t ws_size, hipStream_t stream) {
    static int grid = 0;
    if (grid == 0) {
        if (n_in != 22 || out_size != MTOT * DM || ws_size < WS_END) { fprintf(stderr, "kernel_launch: unexpected shapes n_in %d out %d ws %zu (need %zu)\n", n_in, out_size, ws_size, (size_t)WS_END); grid = -1; return; }
        int dev = 0, cus = 0, per_cu = 0;
        if (hipGetDevice(&dev) != hipSuccess || hipDeviceGetAttribute(&cus, hipDeviceAttributeMultiprocessorCount, dev) != hipSuccess) { grid = -1; return; }
        if (hipFuncSetAttribute((const void*)fwd_kernel, hipFuncAttributeMaxDynamicSharedMemorySize, LDS_BYTES) != hipSuccess) { fprintf(stderr, "kernel_launch: hipFuncSetAttribute failed\n"); grid = -1; return; }
        if (hipOccupancyMaxActiveBlocksPerMultiprocessor(&per_cu, (const void*)fwd_kernel, 512, LDS_BYTES) != hipSuccess || per_cu < 1) { fprintf(stderr, "kernel_launch: occupancy query says %d blocks per CU\n", per_cu); (void)hipGetLastError(); grid = -1; return; }
        grid = cus;
    }
    if (grid < 0) return;
    if (hipMemsetAsync((char*)d_ws + WS_CTL, 0, CTL_ZERO_BYTES, stream) != hipSuccess) return;
    Args a{};
    for (int i = 0; i < 22; ++i) a.in[i] = (const float*)d_in[i];
    a.out = (float*)d_out; a.ws = (unsigned char*)d_ws;
    hipLaunchKernelGGL(fwd_kernel, dim3(grid), dim3(512), LDS_BYTES, stream, a);
    const hipError_t le = hipPeekAtLastError();
    if (le != hipSuccess) fprintf(stderr, "kernel_launch: launch failed: %s\n", hipGetErrorName(le));
}
```

```cpp
#ifndef PROBE_G
#define PROBE_G 0
#endif
#ifndef PROBE_GS
#define PROBE_GS 0
#endif
#include <hip/hip_runtime.h>
#include <cstdio>
#include <cstdint>
#include <cmath>

#define GAS __attribute__((address_space(1)))
#define LAS __attribute__((address_space(3)))
typedef unsigned short bf16;
typedef unsigned v4u __attribute__((ext_vector_type(4)));
typedef unsigned v2u __attribute__((ext_vector_type(2)));
typedef float f32x4 __attribute__((ext_vector_type(4)));
typedef float f32x2 __attribute__((ext_vector_type(2)));
typedef float f32x16 __attribute__((ext_vector_type(16)));
typedef short bf16x8 __attribute__((ext_vector_type(8)));
typedef short s16x4 __attribute__((ext_vector_type(4)));
typedef __bf16 bf16x2_t __attribute__((ext_vector_type(2)));
#define DI __device__ __forceinline__

DI unsigned pk2(float lo, float hi) { f32x2 v = {lo, hi}; bf16x2_t b = __builtin_convertvector(v, bf16x2_t); return __builtin_bit_cast(unsigned, b); }
DI unsigned short f2bf(float f) { return (unsigned short)(pk2(f, 0.f) & 0xffffu); }
DI float bflo(unsigned u) { return __uint_as_float(u << 16); }
DI float bfhi(unsigned u) { return __uint_as_float(u & 0xffff0000u); }
DI float bf2f(unsigned short h) { return __uint_as_float((unsigned)h << 16); }
DI void unpack8(v4u v, float (&x)[8]) { x[0] = bflo(v.x); x[1] = bfhi(v.x); x[2] = bflo(v.y); x[3] = bfhi(v.y); x[4] = bflo(v.z); x[5] = bfhi(v.z); x[6] = bflo(v.w); x[7] = bfhi(v.w); }
DI v4u pack8(const float (&x)[8]) { v4u v; v.x = pk2(x[0], x[1]); v.y = pk2(x[2], x[3]); v.z = pk2(x[4], x[5]); v.w = pk2(x[6], x[7]); return v; }
DI float sigmoidf_(float x) { return __builtin_amdgcn_rcpf(1.f + __expf(-x)); }
DI float siluf_(float x) { return x * sigmoidf_(x); }

template <int K> DI float xor_lane(float v) {
    if constexpr (K == 32) { auto rr = __builtin_amdgcn_permlane32_swap(__float_as_uint(v), __float_as_uint(v), false, false); return __uint_as_float((__builtin_amdgcn_mbcnt_hi(~0u, __builtin_amdgcn_mbcnt_lo(~0u, 0u)) & 32u) ? rr[0] : rr[1]); }
    else return __int_as_float(__builtin_amdgcn_ds_swizzle(__float_as_int(v), (K << 10) | 0x1f));
}
DI float wave_sum(float v) {
    v += xor_lane<1>(v); v += xor_lane<2>(v); v += xor_lane<4>(v); v += xor_lane<8>(v); v += xor_lane<16>(v);
    { auto rr = __builtin_amdgcn_permlane32_swap(__float_as_uint(v), __float_as_uint(v), false, false); v = __uint_as_float(rr[0]) + __uint_as_float(rr[1]); }
    return v;
}
template <int CTRL> DI float dppx(float v) { return __int_as_float(__builtin_amdgcn_mov_dpp(__float_as_int(v), CTRL, 0xf, 0xf, true)); }
template <int CTRL, int RMASK> DI float dpp0(float v) { return __int_as_float(__builtin_amdgcn_update_dpp(0, __float_as_int(v), CTRL, RMASK, 0xf, false)); }
DI float wave_scan_incl(float v) {
    v += dpp0<0x111, 0xf>(v); v += dpp0<0x112, 0xf>(v); v += dpp0<0x114, 0xf>(v); v += dpp0<0x118, 0xf>(v);
    v += dpp0<0x142, 0xa>(v); v += dpp0<0x143, 0xc>(v);
    return v;
}
DI int lane_id() { return (int)__builtin_amdgcn_mbcnt_hi(~0u, __builtin_amdgcn_mbcnt_lo(~0u, 0u)); }
DI int tid_of(int wave) { unsigned z = 0u; asm volatile("" : "+v"(z));
    int t = wave * 64 + (int)__builtin_amdgcn_mbcnt_hi(~0u, __builtin_amdgcn_mbcnt_lo(~0u, z)); asm volatile("" : "+v"(t)); return t; }
#define LDS_WAIT() asm volatile("s_waitcnt lgkmcnt(0)" ::: "memory")
#define VM_WAIT() asm volatile("s_waitcnt vmcnt(0)" ::: "memory")

constexpr int DM = 2048, DEPTH = 4, MTOT = 49152, MG = 24576, NGRP = 2, LP = 16384, LS = 2048;
DI int seq_len(int grp, int tok) { return (grp == 0 && tok < LP) ? LP : LS; }
DI int seq_start(int grp, int tok) { return (grp == 0 && tok < LP) ? 0 : (tok & ~(LS - 1)); }
constexpr int NIN = 11296, NINP = 11520, DFF = 5632, NUP = 11264, GATE_SRC0 = 5152, GATE_DST0 = 5376;
constexpr float EPSN = 1e-6f;
namespace pg8 {
#define PG8_LAS __attribute__((address_space(3)))
typedef unsigned short bf16_t;
typedef short bf16x8 __attribute__((ext_vector_type(8)));
typedef float f32x4 __attribute__((ext_vector_type(4)));
typedef unsigned u32x4 __attribute__((ext_vector_type(4)));
constexpr int BM = 256, BK = 64, HALF = 128, HTB = HALF * BK * 2  , STAGE_BYTES = 8 * HTB, NXCD = 8, WGM = 8;

__host__ __device__ __forceinline__ int lds_byte(int r, int c) { const int st = (r >> 4) * 2 + (c >> 5), rr = r & 15, cc = c & 31, ob = rr * 64 + cc * 2; return st * 1024 + (ob ^ (((ob >> 9) & 1) << 5)); }
__host__ __device__ __forceinline__ void stage_rc(int b, int& R, int& C) { const int st = b / 1024, sb = b % 1024, swz = sb ^ (((sb >> 9) & 1) << 5); R = (st >> 1) * 16 + swz / 64; C = (st & 1) * 32 + (swz % 64) / 2; }
__host__ __device__ __forceinline__ int perm32(int rho) { const int n = rho >> 4, i = rho & 15; return 8 * (i >> 2) + 4 * n + (i & 3); }

struct Unit { int pm, pn; };
struct Gemm { const bf16_t* A; const bf16_t* Bt; int M, N, K, lda, ldb; };

struct StaticOrder {
    int nM, nN, nwg, G, c;
    __host__ __device__ void init(int M, int N, int G_, int c_) { nM = M / BM; nN = N / BM; nwg = nM * nN; G = G_; c = c_; }
    __host__ __device__ bool next(int i, Unit& u) const {
        const long L = (long)i * G + c; if (L >= nwg) return false;
        int wgid = (int)L; { const int q = nwg / NXCD, r = nwg % NXCD, xcd = wgid % NXCD, off = wgid / NXCD; wgid = (xcd < r ? xcd * (q + 1) : r * (q + 1) + (xcd - r) * q) + off; }
        const int nig = WGM * nN, gid = wgid / nig, fm = gid * WGM, gsz = (nM - fm) < WGM ? (nM - fm) : WGM;
        u.pm = fm + ((wgid % nig) % gsz); u.pn = (wgid % nig) / gsz; return true;
    }
    __device__ __forceinline__ void a_ready(const Unit&) const {}
    __device__ __forceinline__ void done(const Unit&) const {}
};

__device__ __forceinline__ void row_rstd(const float* rstd, int row0, float (&rs)[2][4]) {
#pragma unroll
    for (int ai = 0; ai < 2; ++ai)
#pragma unroll
        for (int m = 0; m < 4; ++m) rs[ai][m] = rstd[row0 + ai * HALF + m * 16];
}
struct EpiInProj {
    static constexpr bool APERM = false; static constexpr int PID = 0; static constexpr bool PERM = true, AFTER_DRAIN = false, KHOOK = false, KSTATE = true;
    unsigned char* r1;
    size_t oQNA, oKNA, oVNA, oGQ, oGK, oGV, oZ, oXBC, oDT, oGATE;
    const float* rstd; PG8_LAS float* rl;
    __device__ __forceinline__ void kpre(const Unit& u, int wr, int wc, int fr, int fq) const {
        int fr_ = fr, fq_ = fq; asm volatile("" : "+v"(fr_), "+v"(fq_)); const int lane = fq_ * 16 + fr_, wid = wr * 4 + wc;
#pragma unroll
        for (int k = 0; k < 2; ++k) __builtin_amdgcn_global_load_lds((const unsigned*)(rstd + u.pm * BM + k * HALF + wr * 64 + lane), (PG8_LAS unsigned*)(rl + wid * 128 + k * 64), 4, 0, 0);
    }
    __device__ __forceinline__ void operator()(const f32x4 (&acc)[2][2][4][2], const Unit& u, int wr, int wc, int fr, int fq) const {
        const int pn = u.pn; const int row0 = u.pm * BM + wr * 64 + fr;
        size_t off; int ld, colb, mode = 0;
        if (pn < 2)       { off = oQNA; ld = 512;  colb = pn * 256; }
        else if (pn < 4)  { off = oKNA; ld = 512;  colb = (pn - 2) * 256; }
        else if (pn < 6)  { off = oVNA; ld = 512;  colb = (pn - 4) * 256; }
        else if (pn < 8)  { off = oGQ;  ld = 512;  colb = (pn - 6) * 256; }
        else if (pn == 8) { off = oGK;  ld = 256;  colb = 0; }
        else if (pn == 9) { off = oGV;  ld = 256;  colb = 0; }
        else if (pn < 14) { off = oZ;   ld = 1024; colb = (pn - 10) * 256; }
        else if (pn < 20) { off = oXBC; ld = 1536; colb = (pn - 14) * 256; }
        else if (pn == 20){ off = oDT;  ld = 32;   colb = 0; mode = 1; }
        else              { off = oGATE; ld = 6144; colb = (pn - 21) * 256; mode = 2; }
        const int col0 = colb + wc * 32 + 8 * fq;
        float rs[2][4];
#pragma unroll
        for (int i = 0; i < 8; ++i) rs[i >> 2][i & 3] = rl[(wr * 4 + wc) * 128 + (i >> 2) * 64 + (i & 3) * 16 + fr];
        if (mode == 1) {
            if (wc == 0) {
                float* base = (float*)(r1 + off);
#pragma unroll
                for (int ai = 0; ai < 2; ++ai)
#pragma unroll
                    for (int m = 0; m < 4; ++m) { float* rowp = base + (size_t)(row0 + ai * HALF + m * 16) * 32 + 8 * fq;
                        *(f32x4*)(rowp) = acc[ai][0][m][0] * rs[ai][m]; *(f32x4*)(rowp + 4) = acc[ai][0][m][1] * rs[ai][m]; }
            }
            return;
        }
        if (mode == 2) {
            const int gt = pn - 21; int fr_ = fr, fq_ = fq; asm volatile("" : "+v"(fr_), "+v"(fq_));
            unsigned char* tb = (unsigned char*)(r1 + off) + ((size_t)((u.pm * 3 + (gt >> 3)) * 8 + (gt & 7)) * 8 + (wr * 4 + wc)) * 8192 + (fq_ * 16 + fr_) * 16;
#pragma unroll
            for (int ai = 0; ai < 2; ++ai)
#pragma unroll
                for (int m = 0; m < 4; ++m) { u32x4 w;
#pragma unroll
                    for (int bj = 0; bj < 2; ++bj) { const f32x4 v0 = acc[ai][bj][m][0] * rs[ai][m], v1 = acc[ai][bj][m][1] * rs[ai][m]; unsigned q[8];
#pragma unroll
                        for (int e = 0; e < 4; ++e) { q[e] = (unsigned)fmaxf(sigmoidf_(v0[e]) * 255.f + 0.5f, 1.f); q[4 + e] = (unsigned)fmaxf(sigmoidf_(v1[e]) * 255.f + 0.5f, 1.f); }
                        const unsigned lo = q[0] | (q[1] << 8) | (q[2] << 16) | (q[3] << 24), hi = q[4] | (q[5] << 8) | (q[6] << 16) | (q[7] << 24);
                        if (bj == 0) { w.x = lo; w.y = hi; } else { w.z = lo; w.w = hi; } }
                    *(u32x4*)(tb + (ai * 4 + m) * 1024) = w; }
            return;
        }
        bf16_t* base = (bf16_t*)(r1 + off);
#pragma unroll
        for (int ai = 0; ai < 2; ++ai)
#pragma unroll
            for (int m = 0; m < 4; ++m) { bf16_t* rowp = base + (size_t)(row0 + ai * HALF + m * 16) * ld + col0;
#pragma unroll
                for (int bj = 0; bj < 2; ++bj) { const f32x4 v0 = acc[ai][bj][m][0] * rs[ai][m], v1 = acc[ai][bj][m][1] * rs[ai][m];
                    u32x4 w; w.x = pk2(v0[0], v0[1]); w.y = pk2(v0[2], v0[3]); w.z = pk2(v1[0], v1[1]); w.w = pk2(v1[2], v1[3]);
                    *(u32x4*)(rowp + bj * HALF) = w; } }
    }
};
struct EpiBf16Plain {
    static constexpr bool APERM = false; static constexpr int PID = 1; static constexpr bool PERM = true, AFTER_DRAIN = false, KHOOK = false, KSTATE = false;
    bf16_t* O; int ldc;
    __device__ __forceinline__ void operator()(const f32x4 (&acc)[2][2][4][2], const Unit& u, int wr, int wc, int fr, int fq) const {
        const int row0 = u.pm * BM + wr * 64 + fr, col0 = u.pn * BM + wc * 32 + 8 * fq;
#pragma unroll
        for (int ai = 0; ai < 2; ++ai)
#pragma unroll
            for (int m = 0; m < 4; ++m) { bf16_t* rowp = O + (size_t)(row0 + ai * HALF + m * 16) * ldc + col0;
#pragma unroll
                for (int bj = 0; bj < 2; ++bj) { const f32x4 v0 = acc[ai][bj][m][0], v1 = acc[ai][bj][m][1];
                    u32x4 w; w.x = pk2(v0[0], v0[1]); w.y = pk2(v0[2], v0[3]); w.z = pk2(v1[0], v1[1]); w.w = pk2(v1[2], v1[3]);
                    *(u32x4*)(rowp + bj * HALF) = w; } }
    }
};
struct EpiMerge {
    static constexpr bool APERM = false; static constexpr int PID = 2; static constexpr bool PERM = true, AFTER_DRAIN = false, KHOOK = true, KSTATE = false;
    const unsigned char* gates; bf16_t* merged; const float* rss;
    typedef unsigned u32x2 __attribute__((ext_vector_type(2)));
    typedef float f32x2_ __attribute__((ext_vector_type(2)));
    static __device__ __forceinline__ void unq(u32x2 w, float (&g)[8]) {
        g[0] = (float)(w.x & 255u); g[1] = (float)((w.x >> 8) & 255u); g[2] = (float)((w.x >> 16) & 255u); g[3] = (float)(w.x >> 24);
        g[4] = (float)(w.y & 255u); g[5] = (float)((w.y >> 8) & 255u); g[6] = (float)((w.y >> 16) & 255u); g[7] = (float)(w.y >> 24); }
    __device__ __forceinline__ void khook(f32x4 (&acc)[2][2][4][2], const Unit& u, int t, int wr, int wc, int fr, int fq) const {
        if (t != 8 && t != 16 && t != 24) return;
        int fr_ = fr, fq_ = fq; asm volatile("" : "+v"(fr_), "+v"(fq_));
        const int row0 = u.pm * BM + wr * 64 + fr_;
        const int ja = t == 8 ? 0 : 1, jb = t == 24 ? 2 : 1;
        const float w8 = t == 8 ? 1.f : 0.f, w16 = t == 16 ? 1.f : 0.f, w24 = t == 24 ? 1.f : 0.f;
        const unsigned char* ta = gblob(u, ja, wr, wc, fr_, fq_); const unsigned char* tbp = gblob(u, jb, wr, wc, fr_, fq_);
        f32x2_ rr[2][4]; u32x4 qa[2][4], qb[2][4];
#pragma unroll
        for (int ai = 0; ai < 2; ++ai)
#pragma unroll
            for (int m = 0; m < 4; ++m) { rr[ai][m] = *(const f32x2_*)(rss + (size_t)(row0 + ai * HALF + m * 16) * 2);
                qa[ai][m] = *(const u32x4*)(ta + (ai * 4 + m) * 1024); qb[ai][m] = *(const u32x4*)(tbp + (ai * 4 + m) * 1024); }
#pragma unroll
        for (int ai = 0; ai < 2; ++ai)
#pragma unroll
            for (int m = 0; m < 4; ++m) { const float f = (w8 + w16 * rr[ai][m].x + w24 * rr[ai][m].y) * __builtin_amdgcn_rcpf(w8 * rr[ai][m].x + w16 * rr[ai][m].y + w24);
#pragma unroll
                for (int bj = 0; bj < 2; ++bj) {
                    float ga[8], gb[8]; unq(bj ? (u32x2){qa[ai][m].z, qa[ai][m].w} : (u32x2){qa[ai][m].x, qa[ai][m].y}, ga); unq(bj ? (u32x2){qb[ai][m].z, qb[ai][m].w} : (u32x2){qb[ai][m].x, qb[ai][m].y}, gb);
#pragma unroll
                    for (int e = 0; e < 4; ++e) { acc[ai][bj][m][0][e] *= ga[e] * f * __builtin_amdgcn_rcpf(gb[e]); acc[ai][bj][m][1][e] *= ga[4 + e] * f * __builtin_amdgcn_rcpf(gb[4 + e]); } } }
    }
    __device__ __forceinline__ const unsigned char* gblob(const Unit& u, int br, int wr, int wc, int fr, int fq) const {
        return gates + ((size_t)((u.pm * 3 + br) * 8 + u.pn) * 8 + (wr * 4 + wc)) * 8192 + (fq * 16 + fr) * 16; }
    __device__ __forceinline__ void operator()(const f32x4 (&acc)[2][2][4][2], const Unit& u, int wr, int wc, int fr, int fq) const {
        const int row0 = u.pm * BM + wr * 64 + fr, col0 = u.pn * BM + wc * 32 + 8 * fq;
        const unsigned char* tg = gblob(u, 2, wr, wc, fr, fq);
#pragma unroll
        for (int ai = 0; ai < 2; ++ai) { u32x4 gr[4];
#pragma unroll
            for (int m = 0; m < 4; ++m) gr[m] = *(const u32x4*)(tg + (ai * 4 + m) * 1024);
#pragma unroll
            for (int m = 0; m < 4; ++m) { const size_t row = (size_t)(row0 + ai * HALF + m * 16);
#pragma unroll
                for (int bj = 0; bj < 2; ++bj) { const int col = col0 + bj * HALF;
                    float g[8]; unq(bj ? (u32x2){gr[m].z, gr[m].w} : (u32x2){gr[m].x, gr[m].y}, g);
                    const f32x4 v0 = acc[ai][bj][m][0] * (1.f / 255.f), v1 = acc[ai][bj][m][1] * (1.f / 255.f);
                    u32x4 w; w.x = pk2(v0[0] * g[0], v0[1] * g[1]); w.y = pk2(v0[2] * g[2], v0[3] * g[3]); w.z = pk2(v1[0] * g[4], v1[1] * g[5]); w.w = pk2(v1[2] * g[6], v1[3] * g[7]);
                    *(u32x4*)(merged + row * 2048 + col) = w; } } }
    }
};
template <int CTRL> __device__ __forceinline__ float dpp_rot(float v) { return __int_as_float(__builtin_amdgcn_mov_dpp(__float_as_int(v), CTRL, 0xf, 0xf, true)); }
struct EpiFfnAct {
    static constexpr bool APERM = true; static constexpr int PID = 3; static constexpr bool PERM = true, AFTER_DRAIN = false, KHOOK = false, KSTATE = true;
    bf16_t* act; const float* cwp; float* side; PG8_LAS float* ex;
    const float* rstd; PG8_LAS float* rl;
    PG8_LAS float* wl;
    __device__ __forceinline__ void kpre(const Unit& u, int wr, int wc, int fr, int fq) const {
        int fr_ = fr, fq_ = fq; asm volatile("" : "+v"(fr_), "+v"(fq_)); const unsigned lo = (unsigned)(fq_ * 16 + fr_) * 4u; const int wid = wr * 4 + wc;
        const char* b0 = (const char*)(rstd + u.pm * BM + wr * 64); const char* b1 = (const char*)(cwp + (u.pn * 4 + wc) * 128);
        __builtin_amdgcn_global_load_lds((const unsigned*)(b0 + lo), (PG8_LAS unsigned*)(rl + wid * 128), 4, 0, 0);
        __builtin_amdgcn_global_load_lds((const unsigned*)(b0 + HALF * 4 + lo), (PG8_LAS unsigned*)(rl + wid * 128 + 64), 4, 0, 0);
        __builtin_amdgcn_global_load_lds((const unsigned*)(b1 + lo), (PG8_LAS unsigned*)(wl + wid * 128), 4, 0, 0);
        __builtin_amdgcn_global_load_lds((const unsigned*)(b1 + 256 + lo), (PG8_LAS unsigned*)(wl + wid * 128 + 64), 4, 0, 0);
    }
    __device__ __forceinline__ void operator()(const f32x4 (&acc)[2][2][4][2], const Unit& u, int wr, int wc, int fr_in, int fq_in) const {
        int fr = fr_in, fq = fq_in; asm volatile("" : "+v"(fr), "+v"(fq));
        const int gc = u.pn * 128 + wc * 32 + 8 * fq, lc = wc * 32 + 8 * fq;
        const int row0 = u.pm * BM + wr * 64 + 4 * fr;
        f32x4 rs[2];
#pragma unroll
        for (int ai = 0; ai < 2; ++ai) rs[ai] = *(const PG8_LAS f32x4*)(rl + (wr * 4 + wc) * 128 + ai * 64 + 4 * fr);
        f32x4 w0[2], w1[2], w2[2], bb[2];
        {   const PG8_LAS float* wp = wl + (wr * 4 + wc) * 128 + 8 * fq;
#pragma unroll
            for (int n = 0; n < 2; ++n) { w0[n] = *(const PG8_LAS f32x4*)(wp + 4 * n); w1[n] = *(const PG8_LAS f32x4*)(wp + 32 + 4 * n); w2[n] = *(const PG8_LAS f32x4*)(wp + 64 + 4 * n); bb[n] = *(const PG8_LAS f32x4*)(wp + 96 + 4 * n); } }
#pragma unroll
        for (int ai = 0; ai < 2; ++ai) { const int b = 2 * ai + wr;
            if (fr == 0)  { *(PG8_LAS f32x4*)(ex + (b * 2 + 0) * 128 + lc) = acc[ai][0][0][0] * rs[ai][0]; *(PG8_LAS f32x4*)(ex + (b * 2 + 0) * 128 + lc + 4) = acc[ai][0][0][1] * rs[ai][0]; }
            if (fr == 15) { *(PG8_LAS f32x4*)(ex + (b * 2 + 1) * 128 + lc) = acc[ai][0][3][0] * rs[ai][3]; *(PG8_LAS f32x4*)(ex + (b * 2 + 1) * 128 + lc + 4) = acc[ai][0][3][1] * rs[ai][3]; } }
        asm volatile("s_waitcnt lgkmcnt(0)" ::: "memory"); __builtin_amdgcn_s_barrier(); asm volatile("" ::: "memory");
        const bool f0 = fr == 0, f15 = fr == 15;
#pragma unroll
        for (int ai = 0; ai < 2; ++ai) { const int b = 2 * ai + wr;
            f32x4 hu[2], hd[2];
#pragma unroll
            for (int n = 0; n < 2; ++n) { hu[n] = b > 0 ? *(const PG8_LAS f32x4*)(ex + ((b - 1) * 2 + 1) * 128 + lc + 4 * n) : (f32x4){0.f, 0.f, 0.f, 0.f};
                                          hd[n] = b < 3 ? *(const PG8_LAS f32x4*)(ex + ((b + 1) * 2 + 0) * 128 + lc + 4 * n) : (f32x4){0.f, 0.f, 0.f, 0.f}; }
            f32x4 o[4][2];
            const bool sidew = ai == 0 ? (wr == 0 && f0) : (wr == 1 && f15);
#pragma unroll
            for (int n = 0; n < 2; ++n) { f32x4 sedge;
#pragma unroll
                for (int e = 0; e < 4; ++e) { float g[4];
#pragma unroll
                    for (int m = 0; m < 4; ++m) g[m] = acc[ai][0][m][n][e] * rs[ai][m];
                    float up = dpp_rot<0x121>(g[3]); up = f0 ? hu[n][e] : up;
                    float dn = dpp_rot<0x12f>(g[0]); dn = f15 ? hd[n][e] : dn;
#pragma unroll
                    for (int m = 0; m < 4; ++m) { const float gu = m == 0 ? up : g[m > 0 ? m - 1 : 0], gd = m == 3 ? dn : g[m < 3 ? m + 1 : 3];
                        const float s = bb[n][e] + w0[n][e] * gu + w1[n][e] * g[m] + w2[n][e] * gd;
                        o[m][n][e] = siluf_(s) * (acc[ai][1][m][n][e] * rs[ai][m]);
                        if ((ai == 0 && m == 0) || (ai == 1 && m == 3)) sedge[e] = s; } }
                if (sidew) { const int m = ai == 0 ? 0 : 3;
                    const f32x4 gg = acc[ai][0][m][n] * rs[ai][m], vg = acc[ai][1][m][n] * rs[ai][m];
                    f32x4* sp = (f32x4*)(side + (((size_t)u.pm * 2 + ai) * 5632 + gc + 4 * n) * 3);
                    sp[0] = (f32x4){sedge[0], vg[0], gg[0], sedge[1]}; sp[1] = (f32x4){vg[1], gg[1], sedge[2], vg[2]}; sp[2] = (f32x4){gg[2], sedge[3], vg[3], gg[3]}; } }
#pragma unroll
            for (int m = 0; m < 4; ++m) { u32x4 w; w.x = pk2(o[m][0][0], o[m][0][1]); w.y = pk2(o[m][0][2], o[m][0][3]); w.z = pk2(o[m][1][0], o[m][1][1]); w.w = pk2(o[m][1][2], o[m][1][3]);
                *(u32x4*)(act + (size_t)(row0 + ai * HALF + m) * 5632 + gc) = w; } }
    }
};
struct EpiResid {
    static constexpr bool APERM = false; static constexpr int PID = 4; static constexpr bool PERM = true, AFTER_DRAIN = false, KHOOK = false, KSTATE = false;
    bf16_t* xw; float* fout; int out_f32; float* ssq; float* rstd; unsigned* cnt; PG8_LAS float* part;
    __device__ __forceinline__ void operator()(const f32x4 (&acc)[2][2][4][2], const Unit& u, int wr, int wc, int fr, int fq) const {
        const int row0 = u.pm * BM + wr * 64 + fr, col0 = u.pn * BM + wc * 32 + 8 * fq;
#pragma unroll
        for (int ai = 0; ai < 2; ++ai) { u32x4 xr[4][2];
#pragma unroll
            for (int m = 0; m < 4; ++m)
#pragma unroll
                for (int bj = 0; bj < 2; ++bj) xr[m][bj] = *(const u32x4*)(xw + (size_t)(row0 + ai * HALF + m * 16) * 2048 + col0 + bj * HALF);
#pragma unroll
            for (int m = 0; m < 4; ++m) { const size_t off = (size_t)(row0 + ai * HALF + m * 16) * 2048 + col0; float sq = 0.f;
#pragma unroll
                for (int bj = 0; bj < 2; ++bj) { float t[8]; unpack8(xr[m][bj], t);
                    const f32x4 v0 = (f32x4){t[0], t[1], t[2], t[3]} + acc[ai][bj][m][0], v1 = (f32x4){t[4], t[5], t[6], t[7]} + acc[ai][bj][m][1];
                    sq += ((v0[0] * v0[0] + v0[1] * v0[1]) + (v0[2] * v0[2] + v0[3] * v0[3])) + ((v1[0] * v1[0] + v1[1] * v1[1]) + (v1[2] * v1[2] + v1[3] * v1[3]));
                    if (out_f32) { *(f32x4*)(fout + off + bj * HALF) = v0; *(f32x4*)(fout + off + bj * HALF + 4) = v1; }
                    else { u32x4 w; w.x = pk2(v0[0], v0[1]); w.y = pk2(v0[2], v0[3]); w.z = pk2(v1[0], v1[1]); w.w = pk2(v1[2], v1[3]); *(u32x4*)(xw + off + bj * HALF) = w; } }
                if (!out_f32) { sq += xor_lane<16>(sq);
                    { auto rr = __builtin_amdgcn_permlane32_swap(__float_as_uint(sq), __float_as_uint(sq), false, false); sq = __uint_as_float(rr[0]) + __uint_as_float(rr[1]); }
                    if (fq == 0) part[(ai * HALF + wr * 64 + m * 16 + fr) * 4 + wc] = sq; } } }
        if (out_f32) return;
        asm volatile("s_waitcnt lgkmcnt(0)" ::: "memory"); __builtin_amdgcn_s_barrier(); asm volatile("" ::: "memory");
        if (wr == 0) {
            const int lane = fq * 16 + fr, t = wc * 64 + lane;
            const f32x4 q = *(const PG8_LAS f32x4*)(part + t * 4);
            __hip_atomic_store(ssq + (size_t)(u.pm * BM + t) * 8 + u.pn, (q.x + q.y) + (q.z + q.w), __ATOMIC_RELAXED, __HIP_MEMORY_SCOPE_AGENT);
            asm volatile("s_waitcnt vmcnt(0)" ::: "memory");
            unsigned old = 0u; if (lane == 0) old = __hip_atomic_fetch_add(cnt + u.pm * 16, 1u, __ATOMIC_RELAXED, __HIP_MEMORY_SCOPE_AGENT);
            if ((unsigned)__builtin_amdgcn_readfirstlane(old) == 31u) {
                __builtin_amdgcn_fence(__ATOMIC_ACQUIRE, "agent");
#pragma unroll
                for (int k = 0; k < 4; ++k) { const int r = u.pm * BM + lane + 64 * k; float tot = 0.f;
#pragma unroll
                    for (int j = 0; j < 8; ++j) tot += __hip_atomic_load(ssq + (size_t)r * 8 + j, __ATOMIC_RELAXED, __HIP_MEMORY_SCOPE_AGENT);
                    rstd[r] = 1.f / sqrtf(tot * (1.f / 2048.f) + 1e-6f); } }
        }
    }
};

template <class Epi, class Sched, bool ALIGN_EPI = false, bool SP2 = false>
__device__ __forceinline__ void gemm_phase(PG8_LAS unsigned char* lds, const Gemm g, const Sched& S, const Epi& E, int wave_) {
    const int tid_ = tid_of(wave_);
    const int tid = tid_, wid = __builtin_amdgcn_readfirstlane(tid >> 6), lane = tid & 63, wr = wid >> 2, wc = wid & 3, fr = lane & 15, fq = lane >> 4;
    const int K = g.K, nt = K / BK;
    unsigned voffA[2], voffB[2];
#define PG8_VOFF(t_) do { _Pragma("unroll") for (int i = 0; i < 2; ++i) { int R, C; stage_rc((t_) * 16 + i * 8192, R, C); const int Rb = Epi::PERM ? ((R & ~31) + perm32(R & 31)) : R; \
        const int Ra = Epi::APERM ? ((R & ~63) + ((R & 15) * 4 + ((R >> 4) & 3))) : R; voffA[i] = (unsigned)(Ra * g.lda + C) * 2u; voffB[i] = (unsigned)(Rb * g.ldb + C) * 2u; } } while (0)
    PG8_VOFF(tid);
    const size_t kstep = (size_t)(BK * 2);
    const size_t hstepA = (size_t)HALF * g.lda * 2, hstepB = (size_t)HALF * g.ldb * 2;
    const size_t tstepA = 2 * hstepA, tstepB = 2 * hstepB;
    const unsigned ldsw = (unsigned)wid * 1024u;
    const int aoff = lds_byte(wr * 64 + fr, fq * 8), boff = lds_byte(wc * 32 + fr, fq * 8);
#define PG8_SA(b, h) (((b) * 2 + (h)) * HTB)
#define PG8_SB(b, h) ((4 + (b) * 2 + (h)) * HTB)
#define PG8_STAGE(bufoff, gbase, voff) do { _Pragma("unroll") for (int _i = 0; _i < 2; ++_i) \
        __builtin_amdgcn_global_load_lds((const unsigned*)((const char*)(gbase) + (voff)[_i]), (PG8_LAS unsigned*)(lds + (bufoff) + ldsw + _i * 8192), 16, 0, 0); } while (0)
#define PG8_LDA(dst, b, h) do { _Pragma("unroll") for (int m = 0; m < 4; ++m) _Pragma("unroll") for (int k = 0; k < 2; ++k) dst[m][k] = *(const PG8_LAS bf16x8*)(lds + PG8_SA(b, h) + aoff + m * 2048 + k * 1024); } while (0)
#define PG8_LDB(dst, b, h) do { _Pragma("unroll") for (int n = 0; n < 2; ++n) _Pragma("unroll") for (int k = 0; k < 2; ++k) dst[n][k] = *(const PG8_LAS bf16x8*)(lds + PG8_SB(b, h) + boff + n * 2048 + k * 1024); } while (0)
#define PG8_MMA(ai, bj, At, Bt) do { __builtin_amdgcn_s_setprio(1); _Pragma("unroll") for (int m = 0; m < 4; ++m) _Pragma("unroll") for (int n = 0; n < 2; ++n) _Pragma("unroll") for (int k = 0; k < 2; ++k) \
        acc[ai][bj][m][n] = __builtin_amdgcn_mfma_f32_16x16x32_bf16(Bt[n][k], At[m][k], acc[ai][bj][m][n], 0, 0, 0); __builtin_amdgcn_s_setprio(0); } while (0)
#define PG8_WAIT_V(n) asm volatile("s_waitcnt vmcnt(" #n ")" ::: "memory")
#define PG8_WAIT_L(n) asm volatile("s_waitcnt lgkmcnt(" #n ")" ::: "memory")
#define PG8_BAR __builtin_amdgcn_s_barrier()
#define PG8_SCHED __builtin_amdgcn_sched_barrier(0)
    Unit cur, nxt; int ui = 0;
    if (!S.next(0, cur)) return;
    f32x4 acc[2][2][4][2];
#pragma unroll
    for (int a = 0; a < 2; ++a)
#pragma unroll
        for (int b = 0; b < 2; ++b)
#pragma unroll
            for (int m = 0; m < 4; ++m)
#pragma unroll
                for (int n = 0; n < 2; ++n) acc[a][b][m][n] = (f32x4){0.f, 0.f, 0.f, 0.f};
    bf16x8 At[4][2], B0[2][2], B1[2][2];
    const char* cA = (const char*)g.A + (size_t)cur.pm * tstepA; const char* cB = (const char*)g.Bt + (size_t)cur.pn * tstepB;
    S.a_ready(cur);
    if constexpr (SP2) {
        PG8_STAGE(PG8_SB(0, 0), cB, voffB); PG8_STAGE(PG8_SB(0, 1), cB + hstepB, voffB); PG8_STAGE(PG8_SA(0, 0), cA, voffA); PG8_STAGE(PG8_SA(0, 1), cA + hstepA, voffA);
        if (wr == 1) PG8_BAR;
        PG8_WAIT_V(2); PG8_BAR;
        PG8_STAGE(PG8_SB(1, 0), cB + kstep, voffB); PG8_STAGE(PG8_SA(1, 0), cA + kstep, voffA); PG8_STAGE(PG8_SB(1, 1), cB + hstepB + kstep, voffB);
        PG8_WAIT_V(6); PG8_BAR;
    } else {
        PG8_STAGE(PG8_SB(0, 0), cB, voffB); PG8_STAGE(PG8_SA(0, 0), cA, voffA); PG8_STAGE(PG8_SB(0, 1), cB + hstepB, voffB); PG8_STAGE(PG8_SA(0, 1), cA + hstepA, voffA);
        if (wr == 1) PG8_BAR;
        PG8_WAIT_V(4); PG8_BAR;
        PG8_STAGE(PG8_SB(1, 0), cB + kstep, voffB); PG8_STAGE(PG8_SA(1, 0), cA + kstep, voffA); PG8_STAGE(PG8_SB(1, 1), cB + hstepB + kstep, voffB);
        PG8_WAIT_V(6); PG8_BAR;
    }
    for (;;) {
        const bool has_next = S.next(ui + 1, nxt);
        const char* nA = has_next ? (const char*)g.A + (size_t)nxt.pm * tstepA : cA; const char* nB = has_next ? (const char*)g.Bt + (size_t)nxt.pn * tstepB : cB;
        for (int t = 0; t < nt; t += 2) {
            if constexpr (Epi::KHOOK) E.khook(acc, cur, t, wr, wc, fr, fq);
            const bool last = (t == nt - 2);
            if constexpr (Epi::KSTATE) { if (last) E.kpre(cur, wr, wc, fr, fq); }
            const char* a1 = cA + (size_t)(t + 1) * kstep;
            const char* a2 = last ? nA : cA + (size_t)(t + 2) * kstep; const char* b2 = last ? nB : cB + (size_t)(t + 2) * kstep;
            const char* a3 = a2 + kstep; const char* b3 = b2 + kstep;
            if (last && has_next) S.a_ready(nxt);
            if constexpr (SP2) {
            PG8_LDB(B0, 0, 0); PG8_LDB(B1, 0, 1); PG8_SCHED; PG8_LDA(At, 0, 0); PG8_STAGE(PG8_SA(1, 1), a1 + hstepA, voffA);
            PG8_WAIT_V(8); PG8_WAIT_L(0); PG8_BAR; PG8_MMA(0, 0, At, B0); PG8_MMA(0, 1, At, B1); PG8_BAR; PG8_SCHED;
            PG8_LDA(At, 0, 1); PG8_STAGE(PG8_SB(0, 0), b2, voffB); PG8_STAGE(PG8_SB(0, 1), b2 + hstepB, voffB); PG8_STAGE(PG8_SA(0, 0), a2, voffA);
            PG8_WAIT_V(8); PG8_WAIT_L(0); PG8_BAR; PG8_MMA(1, 0, At, B0); PG8_MMA(1, 1, At, B1); PG8_BAR; PG8_SCHED;
            PG8_LDB(B0, 1, 0); PG8_LDB(B1, 1, 1); PG8_SCHED; PG8_LDA(At, 1, 0); PG8_STAGE(PG8_SA(0, 1), a2 + hstepA, voffA);
            PG8_WAIT_V(8); PG8_WAIT_L(0); PG8_BAR; PG8_MMA(0, 0, At, B0); PG8_MMA(0, 1, At, B1); PG8_BAR; PG8_SCHED;
            PG8_LDA(At, 1, 1); PG8_STAGE(PG8_SB(1, 0), b3, voffB); PG8_STAGE(PG8_SB(1, 1), b3 + hstepB, voffB); PG8_STAGE(PG8_SA(1, 0), a3, voffA);
            PG8_WAIT_V(8); PG8_WAIT_L(0); PG8_BAR; PG8_MMA(1, 0, At, B0); PG8_MMA(1, 1, At, B1); PG8_BAR; PG8_SCHED;
            } else {
            PG8_LDB(B0, 0, 0); PG8_SCHED; PG8_LDA(At, 0, 0); PG8_STAGE(PG8_SA(1, 1), a1 + hstepA, voffA);
            PG8_WAIT_L(8); PG8_BAR; PG8_WAIT_L(0); PG8_MMA(0, 0, At, B0); PG8_BAR; PG8_SCHED;
            PG8_LDB(B1, 0, 1); PG8_STAGE(PG8_SB(0, 0), b2, voffB);
            PG8_BAR; PG8_WAIT_L(0); PG8_MMA(0, 1, At, B1); PG8_BAR;
            PG8_LDA(At, 0, 1); PG8_STAGE(PG8_SA(0, 0), a2, voffA);
            PG8_BAR; PG8_WAIT_L(0); PG8_MMA(1, 0, At, B0); PG8_BAR; PG8_SCHED;
            PG8_STAGE(PG8_SB(0, 1), b2 + hstepB, voffB);
            PG8_WAIT_V(6); PG8_BAR; PG8_MMA(1, 1, At, B1); PG8_BAR;
            PG8_LDB(B0, 1, 0); PG8_SCHED; PG8_LDA(At, 1, 0); PG8_STAGE(PG8_SA(0, 1), a2 + hstepA, voffA);
            PG8_WAIT_L(8); PG8_BAR; PG8_WAIT_L(0); PG8_MMA(0, 0, At, B0); PG8_BAR; PG8_SCHED;
            PG8_LDB(B1, 1, 1); PG8_STAGE(PG8_SB(1, 0), b3, voffB);
            PG8_BAR; PG8_WAIT_L(0); PG8_MMA(0, 1, At, B1); PG8_BAR;
            PG8_LDA(At, 1, 1); PG8_STAGE(PG8_SA(1, 0), a3, voffA);
            PG8_BAR; PG8_WAIT_L(0); PG8_MMA(1, 0, At, B0); PG8_BAR; PG8_SCHED;
            PG8_STAGE(PG8_SB(1, 1), b3 + hstepB, voffB);
            PG8_WAIT_V(6); PG8_BAR; PG8_MMA(1, 1, At, B1); PG8_BAR;
            }
        }
#if PROBE_G
        unsigned long long gt0_ = 0, gacc_ = 0; if constexpr ((PROBE_G >> Epi::PID) & 1) gt0_ = __builtin_amdgcn_s_memrealtime();
#define PG_SEG(k) if constexpr ((PROBE_G >> Epi::PID) & 1) { const unsigned long long tt_ = __builtin_amdgcn_s_memrealtime(); if (PROBE_GS == 0 || PROBE_GS == (k)) gacc_ += tt_ - gt0_; gt0_ = tt_; }
#else
#define PG_SEG(k)
#endif
        if constexpr (ALIGN_EPI) { if (wr == 0) PG8_BAR; }
        PG_SEG(1);
        if constexpr (!Epi::AFTER_DRAIN) { E(acc, cur, wr, wc, fr, fq); S.done(cur); }
        PG_SEG(2);
        if (!has_next) break;
#pragma unroll
        for (int a = 0; a < 2; ++a)
#pragma unroll
            for (int b = 0; b < 2; ++b)
#pragma unroll
                for (int m = 0; m < 4; ++m)
#pragma unroll
                    for (int n = 0; n < 2; ++n) acc[a][b][m][n] = (f32x4){0.f, 0.f, 0.f, 0.f};
        cur = nxt; cA = nA; cB = nB; ++ui;
        { int t2_ = tid; asm volatile("" : "+v"(t2_)); PG8_VOFF(t2_); }
        if constexpr (ALIGN_EPI) { if (wr == 1) PG8_BAR; }
        PG_SEG(3);
#if PROBE_G
        if constexpr ((PROBE_G >> Epi::PID) & 1) { const unsigned long long t1_ = __builtin_amdgcn_s_memrealtime(), d_ = gacc_ * 2; while (__builtin_amdgcn_s_memrealtime() - t1_ < d_) __builtin_amdgcn_s_sleep(4); }
#endif
#undef PG_SEG
    }
    PG8_WAIT_V(0);
    if constexpr (!ALIGN_EPI) { if (wr == 0) PG8_BAR; }
    PG8_BAR;
    if constexpr (Epi::AFTER_DRAIN) { E.fused(acc, cur, wr, wc, fr, fq, lds, wid, lane); S.done(cur); }
#undef PG8_VOFF
#undef PG8_SA
#undef PG8_SB
#undef PG8_STAGE
#undef PG8_LDA
#undef PG8_LDB
#undef PG8_MMA
#undef PG8_WAIT_V
#undef PG8_WAIT_L
#undef PG8_BAR
#undef PG8_SCHED
}
}
namespace att {
constexpr int D = 128, NW = 8, QBLK = 32, KVBLK = 64;
constexpr float SCALE = 0.088388347648318440f;
constexpr float THR = 8.f;
constexpr size_t SHM_V = KVBLK * D * 2, SHM_K = KVBLK * D * 2, SHM_ATTN = 2 * SHM_V + 2 * SHM_K + NW * 64 * 4;
constexpr size_t SHM_RPB = SHM_ATTN;
#define KSWZ(row, colB) ((row) * 256 + ((colB) ^ (((row) & 7) << 4)))
#define SBAR() __builtin_amdgcn_sched_barrier(0)
DI int crow(int r, int hi) { return (r & 3) + 8 * (r >> 2) + 4 * hi; }
DI unsigned cvtpk(float lo, float hi) { unsigned r; asm volatile("v_cvt_pk_bf16_f32 %0, %1, %2" : "=v"(r) : "v"(lo), "v"(hi)); return r; }

struct NaCtx { int jlo; int dr0; int cq; int cs; const float* rpb; };

template <bool NA> DI void mask_bias(f32x16& p0, f32x16& p1, int j, const NaCtx& c, int hi) {
  if constexpr (NA) {
    const bool tv = (unsigned)(j - c.jlo) < 8u;
    int ri = c.dr0 + j + 7; ri = ri < 0 ? 0 : (ri > 14 ? 14 : ri);
    int boff = ri * 32 + 15 - c.cq + 4 * hi, t = 4 * hi - c.cs;
    asm volatile("" : "+v"(boff), "+v"(t));
    const float* bp = c.rpb + boff;
#pragma unroll
    for (int q4 = 0; q4 < 4; ++q4) {
#pragma unroll
      for (int rr = 0; rr < 4; ++rr) { const int r = 4 * q4 + rr;
        const int k0 = (r & 3) + 8 * (r >> 2);
        const bool ok0 = tv && ((unsigned)(t + k0) < 16u), ok1 = tv && ((unsigned)(t + k0 + 32) < 16u);
        const float b0 = bp[k0], b1 = bp[k0 + 32];
        p0[r] = ok0 ? p0[r] + b0 : -INFINITY; p1[r] = ok1 ? p1[r] + b1 : -INFINITY; }
      __builtin_amdgcn_sched_barrier(0);
    }
  }
}
DI void partialSM(f32x16& p0, f32x16& p1, float& m_reg, float& mn, float& alpha) {
  constexpr float C = SCALE * 1.4426950408889634f;
  float pmax = p0[0];
#pragma unroll
  for (int r = 1; r < 16; ++r) pmax = fmaxf(pmax, p0[r]);
#pragma unroll
  for (int r = 0; r < 16; ++r) pmax = fmaxf(pmax, p1[r]);
  { auto rr = __builtin_amdgcn_permlane32_swap(__float_as_uint(pmax), __float_as_uint(pmax), false, false);
    pmax = fmaxf(__uint_as_float(rr[0]), __uint_as_float(rr[1])); }
  if (__builtin_expect(__all(pmax - m_reg <= THR / SCALE), 1)) { mn = m_reg; alpha = 1.f; }
  else { mn = fmaxf(m_reg, pmax); alpha = __builtin_amdgcn_exp2f((m_reg - mn) * C); m_reg = mn; }
  float mnC = -mn * C;
#pragma unroll
  for (int r = 0; r < 16; ++r) p0[r] = fmaf(p0[r], C, mnC);
#pragma unroll
  for (int r = 0; r < 16; ++r) p1[r] = fmaf(p1[r], C, mnC);
#pragma unroll
  for (int r = 0; r < 16; ++r) p0[r] = __builtin_amdgcn_exp2f(p0[r]);
}
DI void finishSM(f32x16& p0, f32x16& p1, float alpha, float& l_reg, bf16x8& pa0, bf16x8& pa1, bf16x8& pa2, bf16x8& pa3) {
#pragma unroll
  for (int r = 0; r < 16; ++r) p1[r] = __builtin_amdgcn_exp2f(p1[r]);
  float ps = 0;
#pragma unroll
  for (int r = 0; r < 16; ++r) ps += p0[r];
#pragma unroll
  for (int r = 0; r < 16; ++r) ps += p1[r];
  { auto rr = __builtin_amdgcn_permlane32_swap(__float_as_uint(ps), __float_as_uint(ps), false, false);
    ps = __uint_as_float(rr[0]) + __uint_as_float(rr[1]); }
  l_reg = l_reg * alpha + ps;
#define PK4(P, BASE, OUT) do { unsigned a0 = cvtpk(P[BASE + 0], P[BASE + 1]), a1 = cvtpk(P[BASE + 2], P[BASE + 3]);   \
    unsigned b0 = cvtpk(P[BASE + 4], P[BASE + 5]), b1 = cvtpk(P[BASE + 6], P[BASE + 7]);                              \
    auto r0 = __builtin_amdgcn_permlane32_swap(a0, b0, false, false); auto r1 = __builtin_amdgcn_permlane32_swap(a1, b1, false, false); \
    v4u w = {r0[0], r1[0], r0[1], r1[1]}; OUT = *reinterpret_cast<bf16x8*>(&w); } while (0)
  PK4(p0, 0, pa0); PK4(p0, 8, pa1); PK4(p1, 0, pa2); PK4(p1, 8, pa3);
#undef PK4
}
DI void qkt(f32x16& p0, f32x16& p1, const bf16* Ks, const bf16x8* qr, int r32, int hi) {
  p0 = f32x16{}; p1 = f32x16{};
#pragma unroll
  for (int d0 = 0; d0 < 8; ++d0) { int cb = (d0 * 16 + hi * 8) * 2;
    bf16x8 b0 = *reinterpret_cast<const bf16x8*>((const char*)Ks + KSWZ(r32, cb));
    bf16x8 b1 = *reinterpret_cast<const bf16x8*>((const char*)Ks + KSWZ(32 + r32, cb));
    p0 = __builtin_amdgcn_mfma_f32_32x32x16_bf16(b0, qr[d0], p0, 0, 0, 0);
    p1 = __builtin_amdgcn_mfma_f32_32x32x16_bf16(b1, qr[d0], p1, 0, 0, 0); }
}
DI int v_st(int k, int c) { const int kk = (k & ~0xC) | ((k & 4) << 1) | ((k & 8) >> 1); return ((kk >> 3) * 4 + (c >> 5)) * 512 + ((kk & 7) * 32 + (c & 31)) * 2; }
DI int v_rd_base(int lane) { return ((lane & 3) << 3) | (((lane >> 2) & 3) << 6) | (((lane >> 4) & 1) << 5) | (((lane >> 5) & 1) << 8); }
constexpr int v_rd_off(int d0, int ks, int half) { return d0 * 512 + ks * 4096 + half * 2048; }
template <int OFF> DI s16x4 tr_read(int vb) { s16x4 r; asm volatile("ds_read_b64_tr_b16 %0, %1 offset:%2" : "=&v"(r) : "v"(vb), "i"(OFF) : "memory"); return r; }
template <int D0> DI void pv_one(f32x16& od, int vb, bf16x8 pa0, bf16x8 pa1, bf16x8 pa2, bf16x8 pa3) {
  const s16x4 l0 = tr_read<v_rd_off(D0, 0, 0)>(vb), h0 = tr_read<v_rd_off(D0, 0, 1)>(vb), l1 = tr_read<v_rd_off(D0, 1, 0)>(vb), h1 = tr_read<v_rd_off(D0, 1, 1)>(vb);
  const s16x4 l2 = tr_read<v_rd_off(D0, 2, 0)>(vb), h2 = tr_read<v_rd_off(D0, 2, 1)>(vb), l3 = tr_read<v_rd_off(D0, 3, 0)>(vb), h3 = tr_read<v_rd_off(D0, 3, 1)>(vb);
  asm volatile("s_waitcnt lgkmcnt(0)" ::: "memory"); SBAR();
#define PK(L, H) (bf16x8){L[0], L[1], L[2], L[3], H[0], H[1], H[2], H[3]}
  od = __builtin_amdgcn_mfma_f32_32x32x16_bf16(pa0, PK(l0, h0), od, 0, 0, 0);
  od = __builtin_amdgcn_mfma_f32_32x32x16_bf16(pa1, PK(l1, h1), od, 0, 0, 0);
  od = __builtin_amdgcn_mfma_f32_32x32x16_bf16(pa2, PK(l2, h2), od, 0, 0, 0);
  od = __builtin_amdgcn_mfma_f32_32x32x16_bf16(pa3, PK(l3, h3), od, 0, 0, 0);
#undef PK
}
DI void pv_d0(f32x16* o, int vb, bf16x8 pa0, bf16x8 pa1, bf16x8 pa2, bf16x8 pa3) {
  pv_one<0>(o[0], vb, pa0, pa1, pa2, pa3); pv_one<1>(o[1], vb, pa0, pa1, pa2, pa3); pv_one<2>(o[2], vb, pa0, pa1, pa2, pa3); pv_one<3>(o[3], vb, pa0, pa1, pa2, pa3);
}
template <int LDQ, int LDK, int LDO, bool NA, int SDEPTH>
DI void attn_body(const bf16* __restrict__ Qb, const bf16* __restrict__ Kh, const bf16* __restrict__ Vh, bf16* __restrict__ Ob, int NT, char* lds, const NaCtx& nc, int wave_) {
  const int tid_ = tid_of(wave_);
  const int tid = tid_, wid = tid >> 6, lane = tid & 63, r32 = lane & 31, hi = lane >> 5;
  bf16* V_lds = (bf16*)lds; bf16* K_lds = (bf16*)(lds + 2 * SHM_V);
  float* ws = (float*)(lds + 2 * SHM_V + 2 * SHM_K) + wid * 64; float* li_l = ws; float* al_l = ws + 32;
  float m_reg = -1e30f, l_reg = 0; f32x16 o[4] = {}; bf16x8 qr[8];
  const bf16* Qw = Qb + (long)(wid * QBLK + r32) * LDQ + hi * 8;
#pragma unroll
  for (int d0 = 0; d0 < 8; ++d0) qr[d0] = *reinterpret_cast<const bf16x8*>(Qw + d0 * 16);
  const int sr = tid >> 4, sc = (tid & 15) * 8, vst0 = v_st(sr, sc), vst1 = v_st(32 + sr, sc);
  const int vb0 = (int)(uintptr_t)V_lds + v_rd_base(lane);
  struct { bf16x8 vs0, vs1, ks0, ks1; } sr_[SDEPTH];
#define SLOAD(i, k0) do { sr_[i].vs0 = *reinterpret_cast<const bf16x8*>(&Vh[(long)((k0) + sr) * LDK + sc]); sr_[i].vs1 = *reinterpret_cast<const bf16x8*>(&Vh[(long)((k0) + 32 + sr) * LDK + sc]); \
    sr_[i].ks0 = *reinterpret_cast<const bf16x8*>(&Kh[(long)((k0) + sr) * LDK + sc]); sr_[i].ks1 = *reinterpret_cast<const bf16x8*>(&Kh[(long)((k0) + 32 + sr) * LDK + sc]); } while (0)
#define SWRITE(b, i) do { *(bf16x8*)((char*)V_lds + (b) * SHM_V + vst0) = sr_[i].vs0;          \
    *(bf16x8*)((char*)V_lds + (b) * SHM_V + vst1) = sr_[i].vs1; int kc = sc * 2;               \
    *(bf16x8*)((char*)K_lds + (b) * SHM_K + KSWZ(sr, kc)) = sr_[i].ks0;                       \
    *(bf16x8*)((char*)K_lds + (b) * SHM_K + KSWZ(32 + sr, kc)) = sr_[i].ks1; } while (0)
#define SWAIT() do { if constexpr (SDEPTH == 2) asm volatile("s_waitcnt vmcnt(4)" ::: "memory"); else asm volatile("s_waitcnt vmcnt(0)" ::: "memory"); } while (0)
#define RESC(a) do { if (__any((a) < 1.f)) { if (hi == 0) al_l[r32] = (a); asm volatile("s_waitcnt lgkmcnt(0)" ::: "memory"); \
    _Pragma("unroll") for (int d = 0; d < 4; ++d) _Pragma("unroll") for (int r = 0; r < 16; ++r) o[d][r] *= al_l[crow(r, hi)]; } } while (0)
  f32x16 pA0, pA1, pB0, pB1; float mnA, mnB, alA, alB; bf16x8 pa0, pa1, pa2, pa3;
  constexpr int SE = 0, SO = SDEPTH - 1;
  SLOAD(SE, 0); asm volatile("s_waitcnt vmcnt(0)" ::: "memory"); SWRITE(0, SE); __syncthreads();
#define ACT(jj) (!NA || (unsigned)((jj) - nc.jlo) < 8u)
  if (ACT(0)) { qkt(pA0, pA1, K_lds, qr, r32, hi); mask_bias<NA>(pA0, pA1, 0, nc, hi); partialSM(pA0, pA1, m_reg, mnA, alA); } else { alA = 1.f; }
  SLOAD(SO, KVBLK); if constexpr (SDEPTH == 2) { if (2 < NT) SLOAD(SE, 2 * KVBLK); }
  SWAIT(); SWRITE(1, SO); __syncthreads();
  if (wave_ >= 4) __builtin_amdgcn_s_setprio(1);
  for (int j = 1; j + 1 < NT; j += 2) {
    SBAR(); if (ACT(j)) { qkt(pB0, pB1, (bf16*)((char*)K_lds + SHM_K), qr, r32, hi); mask_bias<NA>(pB0, pB1, j, nc, hi); }
    if (ACT(j - 1)) finishSM(pA0, pA1, alA, l_reg, pa0, pa1, pa2, pa3); SBAR();
    SLOAD(SO, (j + SDEPTH) * KVBLK); SBAR();
    if (ACT(j - 1)) pv_d0(o, vb0, pa0, pa1, pa2, pa3);
    if (ACT(j)) partialSM(pB0, pB1, m_reg, mnB, alB); else alB = 1.f;
    __syncthreads(); SWAIT(); SWRITE(0, SE);
    RESC(alB); __syncthreads();
    SBAR(); if (ACT(j + 1)) { qkt(pA0, pA1, K_lds, qr, r32, hi); mask_bias<NA>(pA0, pA1, j + 1, nc, hi); }
    if (ACT(j)) finishSM(pB0, pB1, alB, l_reg, pa0, pa1, pa2, pa3); SBAR();
    if (SDEPTH == 1 || j + 3 < NT) SLOAD(SE, (j + 1 + SDEPTH) * KVBLK); SBAR();
    if (ACT(j)) pv_d0(o, vb0 + (int)SHM_V, pa0, pa1, pa2, pa3);
    if (ACT(j + 1)) partialSM(pA0, pA1, m_reg, mnA, alA); else alA = 1.f;
    __syncthreads(); SWAIT(); SWRITE(1, SO);
    RESC(alA); __syncthreads();
  }
  SBAR(); if (ACT(NT - 1)) { qkt(pB0, pB1, (bf16*)((char*)K_lds + SHM_K), qr, r32, hi); mask_bias<NA>(pB0, pB1, NT - 1, nc, hi); }
  if (ACT(NT - 2)) finishSM(pA0, pA1, alA, l_reg, pa0, pa1, pa2, pa3); SBAR();
  if (ACT(NT - 2)) pv_d0(o, vb0, pa0, pa1, pa2, pa3);
  if (ACT(NT - 1)) partialSM(pB0, pB1, m_reg, mnB, alB); else alB = 1.f;
  __syncthreads(); RESC(alB);
  if (ACT(NT - 1)) { finishSM(pB0, pB1, alB, l_reg, pa0, pa1, pa2, pa3); SBAR();
    pv_d0(o, vb0 + (int)SHM_V, pa0, pa1, pa2, pa3); }
#undef ACT
  __builtin_amdgcn_s_setprio(0);
  if (hi == 0) li_l[r32] = l_reg; asm volatile("s_waitcnt lgkmcnt(0)" ::: "memory");
  float rli[16];
#pragma unroll
  for (int r = 0; r < 16; ++r) rli[r] = __builtin_amdgcn_rcpf(li_l[crow(r, hi)]);
  bf16* Ow = Ob + (long)(wid * QBLK) * LDO;
#pragma unroll
  for (int r = 0; r < 16; ++r) { int orow = crow(r, hi);
#pragma unroll
    for (int d0 = 0; d0 < 4; ++d0) Ow[(long)orow * LDO + d0 * 32 + r32] = f2bf(o[d0][r] * rli[r]); }
  __syncthreads();
#undef SLOAD
#undef SWRITE
#undef SWAIT
#undef RESC
}
#undef KSWZ
#undef SBAR
}
#define XB_TMO      128
#define XB_XCNT(j)  (256  + 64 * (j))
#define XB_XSUB(j)  (1280 + 64 * (j))
#define XB_XGEN(j)  (2304 + 64 * (j))
#define XB_TOP      3328
#define XB_TOPGEN   3392
#define XCD_BAR_WORDS 3456
#define XB_SPIN_CAP (1u << 18)

__device__ __forceinline__ unsigned xb_ld(unsigned* p)              { return __hip_atomic_load(p, __ATOMIC_RELAXED, __HIP_MEMORY_SCOPE_AGENT); }
__device__ __forceinline__ unsigned xb_add(unsigned* p, unsigned v) { return __hip_atomic_fetch_add(p, v, __ATOMIC_RELAXED, __HIP_MEMORY_SCOPE_AGENT); }
__device__ __forceinline__ unsigned xb_xcc_id() { return (unsigned)__builtin_amdgcn_s_getreg((3 << 11) | 20) & 0xFu; }
#define XB_SPIN(cond, bar) do { unsigned _sp = 0; while (cond) { __builtin_amdgcn_s_sleep(1); \
    if ((++_sp & 255u) == 0u) { if (xb_ld(&(bar)[XB_TMO])) break; if (_sp > XB_SPIN_CAP) { atomicAdd(&(bar)[XB_TMO], 1u); break; } } } } while (0)

struct XcdBarrier {
    unsigned* bar; unsigned x; int wave;
    volatile LAS unsigned* st;
};

__device__ __forceinline__ XcdBarrier xcd_barrier_post(unsigned* bar, volatile LAS unsigned* st, int wave) {
    XcdBarrier b; b.bar = bar; b.x = xb_xcc_id(); b.st = st; b.wave = wave;
    if (wave == 0 && lane_id() == 0) (void)xb_add(&bar[XB_XCNT(b.x)], 1u);
    return b;
}
__device__ __forceinline__ void xcd_barrier_complete(unsigned* bar, unsigned x, unsigned& nloc, unsigned& nx) {
    const unsigned G = gridDim.x * gridDim.y * gridDim.z;
    unsigned sum, cnt, mine, sp = 0u;
    for (;;) {
        sum = 0u; cnt = 0u; mine = 0u;
#pragma unroll
        for (unsigned j = 0; j < 16; ++j) { const unsigned c = xb_ld(&bar[XB_XCNT(j)]); sum += c; cnt += (c > 0u) ? 1u : 0u; mine = (j == x) ? c : mine; }
        if (sum == G) break;
        __builtin_amdgcn_s_sleep(1);
        if ((++sp & 255u) == 0u) { if (xb_ld(&bar[XB_TMO])) break; if (sp > XB_SPIN_CAP) { atomicAdd(&bar[XB_TMO], 1u); break; } }
    }
    nloc = mine > 0u ? mine : 1u; nx = cnt > 0u ? cnt : 1u;
}

__device__ __forceinline__ void xcd_barrier(const XcdBarrier& b) {
    asm volatile("s_waitcnt vmcnt(0)" ::: "memory");
    __syncthreads();
    if (b.wave == 0 && tid_of(0) == 0) {
        unsigned* bar = b.bar;
        __builtin_amdgcn_s_waitcnt(0);
        unsigned nloc = b.st[0], nx = b.st[1];
        if (nloc == 0u) { xcd_barrier_complete(bar, b.x, nloc, nx); b.st[0] = nloc; b.st[1] = nx; }
        const unsigned old = xb_add(&bar[XB_XSUB(b.x)], 1u);
        const unsigned gen = old / nloc;
        if (old + 1u == (gen + 1u) * nloc) {
            __builtin_amdgcn_fence(__ATOMIC_RELEASE, "agent");
            asm volatile("s_waitcnt vmcnt(0)" ::: "memory");
            const unsigned og = xb_add(&bar[XB_TOP], 1u);
            const unsigned tg = og / nx;
            if (og + 1u == (tg + 1u) * nx) xb_add(&bar[XB_TOPGEN], 1u);
            else XB_SPIN(xb_ld(&bar[XB_TOPGEN]) == tg, bar);
            __builtin_amdgcn_fence(__ATOMIC_ACQUIRE, "agent");
            xb_add(&bar[XB_XGEN(b.x)], 1u);
            asm volatile("s_waitcnt vmcnt(0)" ::: "memory");
        } else {
            XB_SPIN(xb_ld(&bar[XB_XGEN(b.x)]) == gen, bar);
            __builtin_amdgcn_fence(__ATOMIC_ACQUIRE, "agent");
            asm volatile("s_waitcnt vmcnt(0)" ::: "memory");
        }
    }
    __syncthreads();
}
struct Ctx { int tid, lane, wave, G, blk; int gw, ngw; };

DI void tr_item(const float* __restrict__ W, int ldw, int K, bf16* __restrict__ WT, int k0, int n0, int drow0, const float* __restrict__ nw, LAS float* scr, int lane) {
    float tv[32];
#pragma unroll
    for (int i = 0; i < 32; ++i) tv[i] = W[(size_t)(k0 + 2 * i + (lane >> 5)) * ldw + n0 + (lane & 31)];
    if (nw) {
#pragma unroll
        for (int i = 0; i < 32; ++i) tv[i] *= nw[k0 + 2 * i + (lane >> 5)]; }
#pragma unroll
    for (int i = 0; i < 32; ++i) scr[(2 * i + (lane >> 5)) * 33 + (lane & 31)] = tv[i];
    LDS_WAIT(); asm volatile("" ::: "memory");
    const int c = lane & 7;
#pragma unroll
    for (int j = 0; j < 4; ++j) { const int n = (lane >> 3) + 8 * j; const LAS float* s = scr + (8 * c) * 33 + n;
        v4u o; o.x = pk2(s[0 * 33], s[1 * 33]); o.y = pk2(s[2 * 33], s[3 * 33]); o.z = pk2(s[4 * 33], s[5 * 33]); o.w = pk2(s[6 * 33], s[7 * 33]);
        *(v4u*)(WT + (size_t)(drow0 + n) * K + k0 + 8 * c) = o; }
    LDS_WAIT(); asm volatile("" ::: "memory");
}
struct WPtrs { const float *w_in, *w_br, *w_out, *w_up, *w_dn, *n1, *n2, *nssd; bf16 *t_in, *t_br, *t_out, *t_up, *t_dn; const float *cw, *cb; float* t_cw; };
DI void convert_weights(const Ctx& F, const WPtrs& P, LAS unsigned char* lds) {
    LAS float* scr = (LAS float*)(lds + F.wave * 8704);
    constexpr int I_IN = 32 * (NIN / 32), I_BR = 32 * 64, I_OUT = 32 * 64, I_UP = 32 * (NUP / 32), I_DN = (DFF / 64) * 64;
    constexpr int NITEMS = I_IN + I_BR + I_OUT + I_UP + I_DN;
    for (int it = F.gw; it < NITEMS; it += F.ngw) {
        int r = it;
        if (r < I_IN) { const int nblk = NIN / 32, kb = r / nblk, nb = r % nblk, n0 = nb * 32; tr_item(P.w_in, NIN, DM, P.t_in, kb * 64, n0, n0 < GATE_SRC0 ? n0 : n0 + (GATE_DST0 - GATE_SRC0), P.n1, scr, F.lane); continue; } r -= I_IN;
        if (r < I_BR) { const int kb = r / 64, nb = r % 64; tr_item(P.w_br, DM, DM, P.t_br, kb * 64, nb * 32, nb * 32, (kb >= 8 && kb < 24) ? P.nssd - 512 : nullptr, scr, F.lane); continue; } r -= I_BR;
        if (r < I_OUT) { const int kb = r / 64, nb = r % 64; tr_item(P.w_out, DM, DM, P.t_out, kb * 64, nb * 32, nb * 32, nullptr, scr, F.lane); continue; } r -= I_OUT;
        if (r < I_UP) { const int nblk = NUP / 32, kb = r / nblk, nb = r % nblk, n0 = nb * 32, isv = n0 >= DFF, nn = n0 - isv * DFF;
            tr_item(P.w_up, NUP, DM, P.t_up, kb * 64, n0, 256 * (nn >> 7) + 128 * isv + (nn & 127), P.n2, scr, F.lane); continue; } r -= I_UP;
        { const int kb = r / 64, nb = r % 64; tr_item(P.w_dn, DM, DFF, P.t_dn, kb * 64, nb * 32, nb * 32, nullptr, scr, F.lane); }
    }
    for (int i = F.gw * 64 + F.lane; i < 4 * DFF; i += F.ngw * 64) { const int blk = i >> 7, arr = (i >> 5) & 3, c = blk * 32 + (i & 31); P.t_cw[i] = arr < 3 ? P.cw[arr * DFF + c] : P.cb[c]; }
}
DI void xw_init(const Ctx& F, const float* __restrict__ xp, const float* __restrict__ xs, bf16* __restrict__ xw, float* __restrict__ rstd) {
    for (int m0 = 2 * F.gw; m0 < MTOT; m0 += 2 * F.ngw) {
        float s[2];
#pragma unroll
        for (int q = 0; q < 2; ++q) { const int m = m0 + q; const f32x4* xr = (const f32x4*)(m < LP ? xp + (size_t)m * DM : xs + (size_t)(m - LP) * DM) + F.lane;
            v2u* o8 = (v2u*)(xw + (size_t)m * DM) + F.lane; s[q] = 0.f;
#pragma unroll
            for (int j = 0; j < 8; ++j) { const f32x4 v = xr[64 * j]; s[q] += (v.x * v.x + v.y * v.y) + (v.z * v.z + v.w * v.w); v2u o; o.x = pk2(v.x, v.y); o.y = pk2(v.z, v.w); o8[64 * j] = o; } }
#pragma unroll
        for (int q = 0; q < 2; ++q) { const float t = wave_sum(s[q]); if (F.lane == 0) rstd[m0 + q] = 1.f / sqrtf(t * (1.f / DM) + EPSN); }
    }
}
struct PrepPtrs { bf16 *qna, *kna, *gq, *gk; const float *nq_na, *nk_na, *nq_g, *nk_g; };
DI void prep_qk(const Ctx& F, const PrepPtrs& P, int grp) {
    const int sub = F.lane >> 4, j = F.lane & 15;
    const int a = j >> 3, b = (j >> 2) & 1, f0 = (j & 3) * 8;
    float wq_na[8], wk_na[8], wq_g[8], wk_g[8], invf[8];
#pragma unroll
    for (int e = 0; e < 8; ++e) { wq_na[e] = P.nq_na[j * 8 + e]; wk_na[e] = P.nk_na[j * 8 + e]; wq_g[e] = P.nq_g[j * 8 + e]; wk_g[e] = P.nk_g[j * 8 + e];
        invf[e] = exp2f(-(float)(f0 + e) * (13.287712379549449f / 32.f)); }
    for (int tok = F.gw * 4 + sub; tok < MG; tok += F.ngw * 4) {
        const int t = tok - seq_start(grp, tok); const float pos = (float)(a ? (t & 63) : (t >> 6));
        float cs[8], sn[8];
#pragma unroll
        for (int e = 0; e < 8; ++e) { float rev = pos * invf[e] * 0.15915494309189535f; rev -= floorf(rev); sn[e] = __builtin_amdgcn_sinf(rev); cs[e] = __builtin_amdgcn_cosf(rev); }
        v4u raw[14];
#pragma unroll
        for (int v = 0; v < 14; ++v) { const bf16* p = v < 4 ? P.qna + (size_t)tok * 512 + v * 128 : (v < 8 ? P.kna + (size_t)tok * 512 + (v - 4) * 128 : (v < 12 ? P.gq + (size_t)tok * 512 + (v - 8) * 128 : P.gk + (size_t)tok * 256 + (v - 12) * 128));
            raw[v] = *(const v4u*)(p + j * 8); }
#pragma unroll
        for (int v = 0; v < 14; ++v) {
            bf16* p; const float* w; bool rope;
            if (v < 4)       { p = P.qna + (size_t)tok * 512 + v * 128;        w = wq_na; rope = false; }
            else if (v < 8)  { p = P.kna + (size_t)tok * 512 + (v - 4) * 128;  w = wk_na; rope = false; }
            else if (v < 12) { p = P.gq + (size_t)tok * 512 + (v - 8) * 128;   w = wq_g;  rope = true; }
            else             { p = P.gk + (size_t)tok * 256 + (v - 12) * 128;  w = wk_g;  rope = true; }
            p += j * 8;
            float x[8]; unpack8(raw[v], x);
            float ss = 0.f;
#pragma unroll
            for (int e = 0; e < 8; ++e) ss += x[e] * x[e];
            ss += xor_lane<1>(ss); ss += xor_lane<2>(ss); ss += xor_lane<4>(ss); ss += xor_lane<8>(ss);
            const float rstd = 1.f / sqrtf(ss * (1.f / 128.f) + EPSN);
            float y[8];
#pragma unroll
            for (int e = 0; e < 8; ++e) y[e] = x[e] * rstd * w[e];
            if (rope) {
#pragma unroll
                for (int e = 0; e < 8; ++e) { const float pr = xor_lane<4>(y[e]); y[e] = b ? (pr * sn[e] + y[e] * cs[e]) : (y[e] * cs[e] - pr * sn[e]); }
            }
            *(v4u*)p = pack8(y);
        }
    }
}
DI void prep_xbc(const Ctx& F, const bf16* __restrict__ src, bf16* __restrict__ dst, const float* __restrict__ cw, const float* __restrict__ cb, int grp) {
    constexpr int NIT = (MG / 16) * 3;
    for (int it = F.gw; it < NIT; it += F.ngw) {
        const int tb = it / 3, cs = it % 3, c0 = cs * 512 + F.lane * 8, tok0 = tb * 16, slo = seq_start(grp, tok0), shi = slo + seq_len(grp, tok0);
        float w[5][8], bias[8];
#pragma unroll
        for (int i = 0; i < 5; ++i) { const f32x4 a = *(const f32x4*)(cw + i * 1536 + c0), bq = *(const f32x4*)(cw + i * 1536 + c0 + 4);
            w[i][0] = a.x; w[i][1] = a.y; w[i][2] = a.z; w[i][3] = a.w; w[i][4] = bq.x; w[i][5] = bq.y; w[i][6] = bq.z; w[i][7] = bq.w; }
        { const f32x4 a = *(const f32x4*)(cb + c0), bq = *(const f32x4*)(cb + c0 + 4); bias[0] = a.x; bias[1] = a.y; bias[2] = a.z; bias[3] = a.w; bias[4] = bq.x; bias[5] = bq.y; bias[6] = bq.z; bias[7] = bq.w; }
        v4u rw[20];
#pragma unroll
        for (int k = 0; k < 20; ++k) { const int t_ = tok0 - 2 + k; rw[k] = (t_ >= slo && t_ < shi) ? *(const v4u*)(src + (size_t)t_ * 1536 + c0) : (v4u){0u, 0u, 0u, 0u}; }
        float r[5][8];
        unpack8(rw[0], r[0]); unpack8(rw[1], r[1]); unpack8(rw[2], r[2]); unpack8(rw[3], r[3]);
#pragma unroll
        for (int k = 0; k < 16; ++k) {
            unpack8(rw[k + 4], r[4]);
            float y[8];
#pragma unroll
            for (int e = 0; e < 8; ++e) { float s = bias[e] + r[0][e] * w[0][e] + r[1][e] * w[1][e] + r[2][e] * w[2][e] + r[3][e] * w[3][e] + r[4][e] * w[4][e]; y[e] = siluf_(s); }
            *(v4u*)(dst + (size_t)(tok0 + k) * 1536 + c0) = pack8(y);
#pragma unroll
            for (int e = 0; e < 8; ++e) { r[0][e] = r[1][e]; r[1][e] = r[2][e]; r[2][e] = r[3][e]; r[3][e] = r[4][e]; }
        }
    }
}
DI void ffn_fix(const Ctx& F, const float* __restrict__ side, bf16* __restrict__ act, const float* __restrict__ cw) {
    constexpr int NB = MTOT / 256 - 1, NIT = NB * DFF;
    for (int it = F.blk * 512 + F.tid; it < NIT; it += F.G * 512) {
        const int pmb = it / DFF + 1, c = it % DFF;
        if (pmb * 256 >= LP && ((pmb * 256) & (LS - 1)) == 0) continue;
        const float* sb = side + (((size_t)(pmb - 1) * 2 + 1) * DFF + c) * 3; const float* st = side + (((size_t)pmb * 2 + 0) * DFF + c) * 3;
        const float s_bot = sb[0], v_bot = sb[1], a_bot = sb[2], s_top = st[0], v_top = st[1], a_top = st[2];
        act[(size_t)(pmb * 256 - 1) * DFF + c] = f2bf(siluf_(s_bot + cw[2 * DFF + c] * a_top) * v_bot);
        act[(size_t)(pmb * 256) * DFF + c] = f2bf(siluf_(s_top + cw[c] * a_bot) * v_top);
    }
}
namespace ssd {
constexpr int IMG = 32768;
DI unsigned off_b(unsigned row, unsigned ch) { return 256u * row + 16u * (ch ^ (((row & 3) << 2) | ((row >> 2) & 3))); }
DI bf16x8 row_read(const LAS unsigned char* img, unsigned lane, unsigned rowbase, unsigned s) {
    return *(const LAS bf16x8*)(img + off_b(rowbase + (lane & 31), 2 * s + (lane >> 5)));
}
DI s16x4 tr_read4(const LAS unsigned char* img, unsigned lane, unsigned r0, unsigned c) {
    const unsigned blk = (lane >> 4) & 1, q = (lane & 15) >> 2, p = lane & 3;
    const LAS unsigned char* a = img + off_b(r0 + q, 4 * c + 2 * blk + (p >> 1)) + 8 * (p & 1);
    return __builtin_bit_cast(s16x4, __builtin_amdgcn_ds_read_tr16_b64_v4i16((LAS s16x4*)a));
}
DI bf16x8 cat8(s16x4 lo, s16x4 hi) { return (bf16x8){lo[0], lo[1], lo[2], lo[3], hi[0], hi[1], hi[2], hi[3]}; }
DI int crow(int r, int hi) { return (r & 3) + 8 * (r >> 2) + 4 * hi; }
DI void stage_img(LAS unsigned char* img, const bf16* __restrict__ src, int ld, int tid) {
#pragma unroll
    for (int i = 0; i < 4; ++i) { const int id = tid + 512 * i, row = id >> 4, ch = id & 15;
        const v4u v = *(const v4u*)(src + (size_t)row * ld + ch * 8);
        *(LAS v4u*)(img + off_b(row, ch)) = v; }
}
DI float softplusf_(float x) { return x > 20.f ? x : log1pf(__expf(x)); }
DI void dt_cum(const float* __restrict__ DT, int rowbase, int h, int dir, float bias, float a, int lane, float& dt0, float& dt1, float& c0, float& c1, float& tot) {
    const float r0 = DT[(size_t)(rowbase + 2 * lane) * 32 + dir * 16 + h], r1 = DT[(size_t)(rowbase + 2 * lane + 1) * 32 + dir * 16 + h];
    dt0 = softplusf_(r0 + bias); dt1 = softplusf_(r1 + bias);
    const float d0 = dt0 * a, d1 = dt1 * a;
    const float sc = wave_scan_incl(d0 + d1);
    tot = __int_as_float(__builtin_amdgcn_readlane(__float_as_int(sc), 63));
    if (dir == 0) { c1 = sc; c0 = sc - d1; }
    else { c1 = tot - sc + d1; c0 = tot - sc + d1 + d0; }
}
struct Ptrs {
    const bf16* xbca;
    const float* dt;
    const bf16* z;
    bf16* states;
    float* dec;
    bf16* o;
    float* rss;
    const float *dt_bias, *a_log, *dskip;
};
constexpr int L_B = 0, L_C = IMG, L_X0 = 2 * IMG, L_X1 = 3 * IMG, L_ARR = 4 * IMG, L_SSQ = 4 * IMG + 8192;

DI void s1_unit(const Ptrs& P, LAS unsigned char* lds, int c, int g, int tid) {
    const int lane = tid & 63, w = __builtin_amdgcn_readfirstlane(tid >> 6), hl = w >> 1, nh = w & 1, hh = lane >> 5, r = lane & 31;
    const int rowbase = c * 128;
    __syncthreads();
    stage_img(lds + L_B, P.xbca + (size_t)rowbase * 1536 + 1024 + g * 128, 1536, tid);
#pragma unroll 1
    for (int quad = 0; quad < 2; ++quad) {
        const int hq = 8 * g + 4 * quad;
        if (quad) __syncthreads();
        stage_img(lds + L_X0, P.xbca + (size_t)rowbase * 1536 + hq * 64, 1536, tid);
        stage_img(lds + L_X1, P.xbca + (size_t)rowbase * 1536 + hq * 64 + 128, 1536, tid);
        {
            const int h = hq + hl, dir = nh; float dt0, dt1, c0, c1, tot;
            dt_cum(P.dt, rowbase, h, dir, P.dt_bias[dir * 16 + h], -__expf(P.a_log[dir * 16 + h]), lane, dt0, dt1, c0, c1, tot);
            LAS float* wg = (LAS float*)(lds + L_ARR) + (hl * 2 + dir) * 128;
            wg[2 * lane] = dt0 * __expf(tot - c0); wg[2 * lane + 1] = dt1 * __expf(tot - c1);
            if (lane == 0) P.dec[(size_t)(c * 2 + dir) * 16 + h] = __expf(tot);
        }
        __syncthreads();
        const LAS unsigned char* ximg = lds + (hl >> 1 ? L_X1 : L_X0);
        const int h = hq + hl;
#pragma unroll 1
        for (int dir = 0; dir < 2; ++dir) {
            const LAS float* wg = (const LAS float*)(lds + L_ARR) + (hl * 2 + dir) * 128;
            f32x16 acc[2][2];
#pragma unroll
            for (int i = 0; i < 2; ++i)
#pragma unroll
                for (int k = 0; k < 2; ++k) acc[i][k] = f32x16{};
#pragma unroll 2
            for (int ks = 0; ks < 8; ++ks) {
                bf16x8 af[2], bfr[2];
#pragma unroll
                for (int nb = 0; nb < 2; ++nb) af[nb] = cat8(tr_read4(lds + L_B, lane, 16 * ks + 8 * hh, 2 * nh + nb), tr_read4(lds + L_B, lane, 16 * ks + 8 * hh + 4, 2 * nh + nb));
                const f32x4 w0 = *(const LAS f32x4*)(wg + 16 * ks + 8 * hh), w1 = *(const LAS f32x4*)(wg + 16 * ks + 8 * hh + 4);
#pragma unroll
                for (int pb = 0; pb < 2; ++pb) {
                    const s16x4 lo = tr_read4(ximg, lane, 16 * ks + 8 * hh, 2 * (hl & 1) + pb), hi4 = tr_read4(ximg, lane, 16 * ks + 8 * hh + 4, 2 * (hl & 1) + pb);
                    v4u pk; pk.x = pk2(bf2f((unsigned short)lo[0]) * w0.x, bf2f((unsigned short)lo[1]) * w0.y); pk.y = pk2(bf2f((unsigned short)lo[2]) * w0.z, bf2f((unsigned short)lo[3]) * w0.w);
                    pk.z = pk2(bf2f((unsigned short)hi4[0]) * w1.x, bf2f((unsigned short)hi4[1]) * w1.y); pk.w = pk2(bf2f((unsigned short)hi4[2]) * w1.z, bf2f((unsigned short)hi4[3]) * w1.w);
                    bfr[pb] = __builtin_bit_cast(bf16x8, pk);
                }
#pragma unroll
                for (int nb = 0; nb < 2; ++nb)
#pragma unroll
                    for (int pb = 0; pb < 2; ++pb) acc[nb][pb] = __builtin_amdgcn_mfma_f32_32x32x16_bf16(af[nb], bfr[pb], acc[nb][pb], 0, 0, 0);
            }
            bf16* sp = P.states + ((size_t)(c * 2 + dir) * 16 + h) * 8192;
#pragma unroll
            for (int nb = 0; nb < 2; ++nb)
#pragma unroll
                for (int pb = 0; pb < 2; ++pb)
#pragma unroll
                    for (int i4 = 0; i4 < 4; ++i4) {
                        v2u o; o.x = pk2(acc[nb][pb][4 * i4], acc[nb][pb][4 * i4 + 1]); o.y = pk2(acc[nb][pb][4 * i4 + 2], acc[nb][pb][4 * i4 + 3]);
                        *(v2u*)(sp + ((((4 * nh + 2 * nb + (i4 >> 1)) * 2 + pb) * 64 + r + 32 * (i4 & 1)) * 8 + 4 * hh)) = o; }
        }
    }
}
template <int BATCH>
DI void scan_states(const Ctx& F, bf16* __restrict__ states, const float* __restrict__ dec, int grp) {
    const int nseq = grp == 0 ? 5 : 12, ntask = nseq * 65536, nthr = F.G * 512;
    for (int task = F.blk * 512 + F.tid; task < ntask; task += nthr) {
        const int n4 = task & 31, p = (task >> 5) & 63, h = (task >> 11) & 15, dir = (task >> 15) & 1, s = task >> 16;
        const int ncs = (grp == 0 && s == 0) ? LP / 128 : LS / 128, cbase = grp == 0 ? (s == 0 ? 0 : LP / 128 + (s - 1) * (LS / 128)) : s * (LS / 128);
        float run[4] = {0.f, 0.f, 0.f, 0.f};
#pragma unroll 1
        for (int k0 = 0; k0 < ncs; k0 += BATCH) {
            v2u v[BATCH]; float dc[BATCH];
#pragma unroll
            for (int k = 0; k < BATCH; ++k) { const int cc = cbase + (dir ? ncs - 1 - (k0 + k) : (k0 + k));
                v[k] = *(const v2u*)(states + (((size_t)(cc * 2 + dir) * 16 + h) * 64 + p) * 128 + n4 * 4); dc[k] = dec[(size_t)(cc * 2 + dir) * 16 + h]; }
#pragma unroll
            for (int k = 0; k < BATCH; ++k) { const int cc = cbase + (dir ? ncs - 1 - (k0 + k) : (k0 + k));
                v2u o; o.x = pk2(run[0], run[1]); o.y = pk2(run[2], run[3]);
                *(v2u*)(states + (((size_t)(cc * 2 + dir) * 16 + h) * 64 + p) * 128 + n4 * 4) = o;
                run[0] = run[0] * dc[k] + bflo(v[k].x); run[1] = run[1] * dc[k] + bfhi(v[k].x); run[2] = run[2] * dc[k] + bflo(v[k].y); run[3] = run[3] * dc[k] + bfhi(v[k].y); }
        }
    }
}
#ifndef PROBE_S3
#define PROBE_S3 0
#endif
#define S3_T0() unsigned long long st0_ = 0; if (PROBE_S3) st0_ = __builtin_amdgcn_s_memrealtime()
#define S3_T1(id) do { if (PROBE_S3 == (id)) { const unsigned long long t1_ = __builtin_amdgcn_s_memrealtime(), d_ = (t1_ - st0_) * 2; while (__builtin_amdgcn_s_memrealtime() - t1_ < d_) __builtin_amdgcn_s_sleep(8); } if (PROBE_S3) st0_ = __builtin_amdgcn_s_memrealtime(); } while (0)
template <int QUAD>
DI void s3_pass(const Ptrs& P, LAS unsigned char* lds, int c, int g, int tid) {
    const int lane_o = tid & 63, w = __builtin_amdgcn_readfirstlane(tid >> 6), hl = w >> 1, lh = w & 1;
    const int rowbase = c * 128, hq = 8 * g + 4 * QUAD, h = hq + hl;
    S3_T0();
    if (QUAD) __syncthreads();
    stage_img(lds + L_X0, P.xbca + (size_t)rowbase * 1536 + hq * 64, 1536, tid);
    stage_img(lds + L_X1, P.xbca + (size_t)rowbase * 1536 + hq * 64 + 128, 1536, tid);
    LAS float* arr = (LAS float*)(lds + L_ARR);
    {   const int dir = lh, lane = lane_o; float dt0, dt1, c0, c1, tot;
        dt_cum(P.dt, rowbase, h, dir, P.dt_bias[dir * 16 + h], -__expf(P.a_log[dir * 16 + h]), lane, dt0, dt1, c0, c1, tot);
        LAS float* a = arr + hl * 512;
        a[dir * 128 + 2 * lane] = dt0; a[dir * 128 + 2 * lane + 1] = dt1; a[(2 + dir) * 128 + 2 * lane] = c0; a[(2 + dir) * 128 + 2 * lane + 1] = c1; }
    __syncthreads();
    S3_T1(2);
    const LAS float* aD0 = arr + hl * 512, *aD1 = aD0 + 128, *aCF = aD0 + 256, *aCR = aD0 + 384;
    const LAS unsigned char* ximg = lds + (hl >> 1 ? L_X1 : L_X0);
    const bf16* pf = P.states + ((size_t)(c * 2 + 0) * 16 + h) * 8192, *pb_ = P.states + ((size_t)(c * 2 + 1) * 16 + h) * 8192;
    const float dsk = P.dskip[h];
    LAS float* ssq = (LAS float*)(lds + L_SSQ);
#pragma unroll 1
    for (int lb = 0; lb < 2; ++lb) {
        f32x16 acc[2];
        acc[0] = f32x16{}; acc[1] = f32x16{};
        int ln_ = lane_o; asm volatile("" : "+v"(ln_)); const int lane = ln_, hh = lane >> 5, r = lane & 31;
        const int l0 = 64 * lh + 32 * lb, l = l0 + r; const float cf_l = aCF[l], cr_l = aCR[l];
#pragma unroll 1
        for (int sb = 0; sb < 4; ++sb) {
            const int s0 = 32 * sb;
            f32x16 X = f32x16{};
            {   bf16x8 bq[8];
#pragma unroll
                for (int ks = 0; ks < 8; ++ks) bq[ks] = row_read(lds + L_B, lane, s0, ks);
                __builtin_amdgcn_sched_barrier(0);
#pragma unroll
                for (int ks = 0; ks < 8; ++ks) X = __builtin_amdgcn_mfma_f32_32x32x16_bf16(bq[ks], row_read(lds + L_C, lane, l0, ks), X, 0, 0, 0); }
            {   const bool needf = s0 <= l0 + 31, needb = s0 + 31 >= l0; const int sb4 = s0 + 4 * hh;
                f32x4 fac[4];
#pragma unroll
                for (int q = 0; q < 4; ++q) fac[q] = (f32x4){0.f, 0.f, 0.f, 0.f};
                if (needf) { f32x4 cs[4], ds[4];
#pragma unroll
                    for (int q = 0; q < 4; ++q) { cs[q] = *(const LAS f32x4*)(aCF + sb4 + 8 * q); ds[q] = *(const LAS f32x4*)(aD0 + sb4 + 8 * q); }
#pragma unroll
                    for (int q = 0; q < 4; ++q)
#pragma unroll
                        for (int e = 0; e < 4; ++e) { const float t = __expf(fminf(cf_l - cs[q][e], 0.f)) * ds[q][e]; fac[q][e] += (sb4 + 8 * q + e <= l) ? t : 0.f; } }
                if (needb) { f32x4 cs[4], ds[4];
#pragma unroll
                    for (int q = 0; q < 4; ++q) { cs[q] = *(const LAS f32x4*)(aCR + sb4 + 8 * q); ds[q] = *(const LAS f32x4*)(aD1 + sb4 + 8 * q); }
#pragma unroll
                    for (int q = 0; q < 4; ++q)
#pragma unroll
                        for (int e = 0; e < 4; ++e) { const float t = __expf(fminf(cr_l - cs[q][e], 0.f)) * ds[q][e]; fac[q][e] += (sb4 + 8 * q + e >= l) ? t : 0.f; } }
#pragma unroll
                for (int q = 0; q < 4; ++q)
#pragma unroll
                    for (int e = 0; e < 4; ++e) X[4 * q + e] *= fac[q][e];
            }
            {   bf16x8 xf[2][2];
#pragma unroll
                for (int sp = 0; sp < 2; ++sp)
#pragma unroll
                    for (int pb = 0; pb < 2; ++pb) xf[sp][pb] = cat8(tr_read4(ximg, lane, s0 + 16 * sp + 4 * hh, 2 * (hl & 1) + pb), tr_read4(ximg, lane, s0 + 16 * sp + 8 + 4 * hh, 2 * (hl & 1) + pb));
                __builtin_amdgcn_sched_barrier(0);
#pragma unroll
                for (int sp = 0; sp < 2; ++sp) {
                    v4u pk; pk.x = pk2(X[8 * sp], X[8 * sp + 1]); pk.y = pk2(X[8 * sp + 2], X[8 * sp + 3]); pk.z = pk2(X[8 * sp + 4], X[8 * sp + 5]); pk.w = pk2(X[8 * sp + 6], X[8 * sp + 7]);
                    const bf16x8 af = __builtin_bit_cast(bf16x8, pk);
#pragma unroll
                    for (int pb = 0; pb < 2; ++pb) acc[pb] = __builtin_amdgcn_mfma_f32_32x32x16_bf16(af, xf[sp][pb], acc[pb], 0, 0, 0);
                } }
        }
        S3_T1(3);
        {
            const float ef = __expf(cf_l), eb = __expf(cr_l);
            int r2 = r; asm volatile("" : "+v"(r2));
            bf16x8 sF[4][2], sB[4][2];
#define S3_LD(ks_, sl_) do { _Pragma("unroll") for (int pb = 0; pb < 2; ++pb) { sF[sl_][pb] = *(const bf16x8*)(pf + (((ks_) * 2 + pb) * 64 + r2 + 32 * hh) * 8); sB[sl_][pb] = *(const bf16x8*)(pb_ + (((ks_) * 2 + pb) * 64 + r2 + 32 * hh) * 8); } } while (0)
            S3_LD(0, 0); S3_LD(1, 1); S3_LD(2, 2); S3_LD(3, 3);
#pragma unroll
            for (int ks = 0; ks < 8; ++ks) {
                const bf16x8 cfr = row_read(lds + L_C, lane, l0, ks);
                float x[8]; unpack8(__builtin_bit_cast(v4u, cfr), x);
                float xf[8], xb[8];
#pragma unroll
                for (int e = 0; e < 8; ++e) { xf[e] = x[e] * ef; xb[e] = x[e] * eb; }
                const bf16x8 aF = __builtin_bit_cast(bf16x8, pack8(xf)), aB = __builtin_bit_cast(bf16x8, pack8(xb));
#pragma unroll
                for (int pb = 0; pb < 2; ++pb) { acc[pb] = __builtin_amdgcn_mfma_f32_32x32x16_bf16(aF, sF[ks & 3][pb], acc[pb], 0, 0, 0);
                    acc[pb] = __builtin_amdgcn_mfma_f32_32x32x16_bf16(aB, sB[ks & 3][pb], acc[pb], 0, 0, 0); }
                if (ks + 4 < 8) S3_LD(ks + 4, ks & 3);
            }
#undef S3_LD
        }
        S3_T1(4);
        {
            unsigned short zr[2][16]; int r3 = r; asm volatile("" : "+v"(r3));
#pragma unroll
            for (int i = 0; i < 16; ++i)
#pragma unroll
                for (int pb = 0; pb < 2; ++pb) zr[pb][i] = P.z[(size_t)(rowbase + l0 + crow(i, hh)) * 1024 + h * 64 + 32 * pb + r3];
            float sqv[16];
#pragma unroll
            for (int i = 0; i < 16; ++i) {
                const int li = l0 + crow(i, hh);
                float sq = 0.f;
#pragma unroll
                for (int pb = 0; pb < 2; ++pb) {
                    const int p = 32 * pb + r3, col = (hl & 1) * 64 + p;
                    const float xs = bf2f(*(const LAS unsigned short*)(ximg + off_b(li, col >> 3) + 2 * (col & 7)));
                    const float y = (acc[pb][i] + dsk * xs) * siluf_(bf2f(zr[pb][i]));
                    P.o[(size_t)(rowbase + li) * 2048 + 512 + h * 64 + p] = f2bf(y); sq += y * y;
                }
                sqv[i] = sq;
            }
            {   const bool c8 = (r3 & 8) != 0, c4 = (r3 & 4) != 0, c2 = (r3 & 2) != 0, c1 = (r3 & 1) != 0;
                float a8[8], a4[4], a2[2];
#pragma unroll
                for (int k = 0; k < 8; ++k) a8[k] = (c8 ? sqv[k + 8] : sqv[k]) + dppx<0x140>(c8 ? sqv[k] : sqv[k + 8]);
#pragma unroll
                for (int k = 0; k < 4; ++k) a4[k] = (c4 ? a8[k + 4] : a8[k]) + dppx<0x141>(c4 ? a8[k] : a8[k + 4]);
#pragma unroll
                for (int k = 0; k < 2; ++k) a2[k] = (c2 ? a4[k + 2] : a4[k]) + dppx<0x1b>(c2 ? a4[k] : a4[k + 2]);
                float tot = (c1 ? a2[1] : a2[0]) + dppx<0xb1>(c1 ? a2[0] : a2[1]);
                tot += xor_lane<16>(tot);
                if (r3 < 16) ssq[(QUAD * 4 + hl) * 128 + l0 + crow(r3, hh)] = tot;
            }
        }
        S3_T1(5);
    }
}
DI void s3_rstd(const Ptrs& P, LAS unsigned char* lds, int c, int g, int tid) {
    if (tid < 128) { const LAS float* ssq = (const LAS float*)(lds + L_SSQ);
        float tot = 0.f;
#pragma unroll
        for (int k = 0; k < 8; ++k) tot += ssq[k * 128 + tid];
        P.rss[(size_t)(c * 128 + tid) * 2 + g] = 1.f / sqrtf(tot * (1.f / 512.f) + EPSN); }
}
DI void s3_unit(const Ptrs& P, LAS unsigned char* lds, int c, int g, int tid) {
    const int rowbase = c * 128;
    S3_T0();
    __syncthreads();
    stage_img(lds + L_B, P.xbca + (size_t)rowbase * 1536 + 1024 + g * 128, 1536, tid);
    stage_img(lds + L_C, P.xbca + (size_t)rowbase * 1536 + 1280 + g * 128, 1536, tid);
    S3_T1(1);
    s3_pass<0>(P, lds, c, g, tid);
    s3_pass<1>(P, lds, c, g, tid);
    __syncthreads();
    if (PROBE_S3) st0_ = __builtin_amdgcn_s_memrealtime();
    s3_rstd(P, lds, c, g, tid);
    S3_T1(6);
}
}
constexpr size_t MiB = 1u << 20;
constexpr size_t WS_CTL = 0, CTL_ZERO_BYTES = 1 * MiB, WS_CW = 1 * MiB, CW_LAYER = 128 * 1024;
constexpr size_t WS_W = 2 * MiB, W_LAYER = 127 * MiB;
constexpr size_t W_TIN = 0, W_TBR = 45 * MiB, W_TOUT = 53 * MiB, W_TUP = 61 * MiB, W_TDN = 105 * MiB;
static_assert(W_TIN + (size_t)NINP * DM * 2 <= W_TBR && W_TUP + (size_t)NUP * DM * 2 <= W_TDN && W_TDN + (size_t)DM * DFF * 2 <= W_LAYER, "weights map");
constexpr size_t WS_R1 = 256 * MiB;
constexpr size_t R_QNA = 0, R_KNA = 24 * MiB, R_VNA = 48 * MiB, R_GQ = 72 * MiB, R_GK = 96 * MiB, R_GV = 108 * MiB, R_Z = 120 * MiB, R_XBC = 168 * MiB, R_DT = 240 * MiB, R_GATE = 243 * MiB;
constexpr size_t WS_XBCA = 643 * MiB, WS_ST = 715 * MiB, WS_O = 811 * MiB, WS_TMPF = 907 * MiB, WS_MRG = 907 * MiB, WS_DEC = 1003 * MiB, WS_SIDE = 1004 * MiB, WS_XW = 1030 * MiB, WS_STAT = 1222 * MiB, WS_END = 1226 * MiB;
constexpr size_t ST_SSQ = 0, ST_RSS = 1536 * 1024, ST_RSTD1 = 2 * MiB, ST_RSTD2 = 3 * MiB;
constexpr size_t WS_ACT = 256 * MiB;
static_assert(WS_W + 2 * W_LAYER <= WS_R1 && WS_R1 + R_GATE + (size_t)MG * 6144 <= WS_XBCA && R_DT + (size_t)MG * 32 * 4 <= R_GATE && WS_XBCA + (size_t)MG * 1536 * 2 <= WS_ST && WS_ST + (size_t)(MG / 128) * 2 * 16 * 8192 * 2 <= WS_O
              && WS_O + (size_t)MG * DM * 2 <= WS_TMPF && WS_TMPF + (size_t)MG * 1024 * 4 <= WS_DEC && WS_MRG + (size_t)MG * DM * 2 <= WS_DEC && WS_SIDE + (size_t)(MTOT / 256) * 6 * DFF * 4 <= WS_XW
              && WS_XW + (size_t)MTOT * DM * 2 <= WS_STAT && WS_ACT + (size_t)MTOT * DFF * 2 <= WS_DEC && ST_SSQ + (size_t)MTOT * 8 * 4 <= ST_RSS && ST_RSS + (size_t)MG * 8 <= ST_RSTD1 && WS_STAT + 4 * MiB <= WS_END, "activation map");
constexpr int CW_BAR = 4096;
constexpr int CW_CNT = 8192, CNT_USE = (MTOT / 256) * 16;
static_assert((CW_CNT + 2 * DEPTH * CNT_USE) * 4 <= (int)CTL_ZERO_BYTES, "counters inside the per-launch memset");

constexpr int LDS_BYTES = 147456, MISC_OFF = LDS_BYTES - 256, EX_OFF = 131072;

#ifndef PROBE_MASK
#define PROBE_MASK 0
#endif
#define PROBE_K 2
#define PROBE_T0() unsigned long long pt0_ = 0; if (PROBE_MASK) pt0_ = __builtin_amdgcn_s_memrealtime()
#define PROBE_T1(id) do { if ((PROBE_MASK >> (id)) & 1) { const unsigned long long t1_ = __builtin_amdgcn_s_memrealtime(), d_ = (t1_ - pt0_) * PROBE_K; \
    while (__builtin_amdgcn_s_memrealtime() - t1_ < d_) __builtin_amdgcn_s_sleep(32); GRID_BAR(); } if (PROBE_MASK) pt0_ = __builtin_amdgcn_s_memrealtime(); } while (0)
struct Args { const float* in[22]; float* out; unsigned char* ws; };

#define REFRESH() do { const int tv_ = tid_of(F.wave); F.tid = tv_; F.lane = tv_ & 63; } while (0)
#define GRID_BAR() do { XcdBarrier b_ = bar; asm volatile("" : "+s"(b_.bar)); b_.bar = (unsigned*)(GAS unsigned*)b_.bar; b_.x = xb_xcc_id(); xcd_barrier(b_); REFRESH(); } while (0)
#define W_PTRS(l)   \
    unsigned char* WL = ws + WS_W + (size_t)((l) & 1) * W_LAYER; \
    bf16* T_IN = (bf16*)(WL + W_TIN); bf16* T_BR = (bf16*)(WL + W_TBR); bf16* T_OUT = (bf16*)(WL + W_TOUT); bf16* T_UP = (bf16*)(WL + W_TUP); bf16* T_DN = (bf16*)(WL + W_TDN);
#define MK_WP(l) WPtrs WP{GIN(3) + (size_t)(l) * DM * NIN, GIN(15) + (size_t)(l) * DM * DM, GIN(16) + (size_t)(l) * DM * DM, GIN(18) + (size_t)(l) * DM * NUP, GIN(21) + (size_t)(l) * DFF * DM, \
    GIN(2) + (l) * DM, GIN(17) + (l) * DM, GIN(12) + (l) * 1024, T_IN, T_BR, T_OUT, T_UP, T_DN, GIN(19) + (size_t)(l) * 3 * DFF, GIN(20) + (size_t)(l) * DFF, (float*)(ws + WS_CW + (size_t)((l) & 1) * CW_LAYER)}
#define OPQ_PTRS() \
    unsigned char* R1 = ws + WS_R1; \
    bf16* QNA = (bf16*)(R1 + R_QNA); bf16* KNA = (bf16*)(R1 + R_KNA); bf16* VNA = (bf16*)(R1 + R_VNA); bf16* GQ = (bf16*)(R1 + R_GQ); bf16* GK = (bf16*)(R1 + R_GK); bf16* GV = (bf16*)(R1 + R_GV); \
    bf16* Z = (bf16*)(R1 + R_Z); bf16* XBC = (bf16*)(R1 + R_XBC); float* DT = (float*)(R1 + R_DT); unsigned char* GATE = (unsigned char*)(R1 + R_GATE); \
    bf16* XBCA = (bf16*)(ws + WS_XBCA); bf16* ST = (bf16*)(ws + WS_ST); bf16* O = (bf16*)(ws + WS_O); float* TMPF = (float*)(ws + WS_TMPF); bf16* MRG = (bf16*)(ws + WS_MRG); \
    float* DEC = (float*)(ws + WS_DEC); bf16* ACT = (bf16*)(ws + WS_ACT); float* SIDE = (float*)(ws + WS_SIDE); bf16* XWA = (bf16*)(ws + WS_XW); \
    float* SSQ = (float*)(ws + WS_STAT + ST_SSQ); float* RSS = (float*)(ws + WS_STAT + ST_RSS); float* RSTD1 = (float*)(ws + WS_STAT + ST_RSTD1); float* RSTD2 = (float*)(ws + WS_STAT + ST_RSTD2); unsigned* CNT = (unsigned*)(ws + WS_CTL) + CW_CNT;
#define NA_UNIT(u) do {   \
    const int b = (u) >> 2, h = (u) & 3, row0 = b * 256, L = seq_len(grp, row0), seq0 = seq_start(grp, row0), rows = L / 64, r0 = (row0 - seq0) >> 6; \
    int rs0 = r0 - 4; rs0 = rs0 < 0 ? 0 : (rs0 > rows - 8 ? rows - 8 : rs0); \
    const int NT = (r0 == 0 || r0 == rows - 4) ? 8 : 12; \
    __syncthreads(); \
    {   LAS float* rp = (LAS float*)(lds + att::SHM_RPB); const float* src = GIN(6) + ((size_t)layer * 4 + h) * 15 * 31; \
        for (int i = tid_of(F.wave); i < 15 * 31; i += 512) rp[(i / 31) * 32 + (i % 31)] = src[i] * (1.f / att::SCALE); } \
    const int r = r0 + (F.wave >> 1); int rs = r - 4; rs = rs < 0 ? 0 : (rs > rows - 8 ? rows - 8 : rs); \
    const int cq = 32 * (F.wave & 1) + (tid_of(F.wave) & 31); int cs = cq - 8; cs = cs < 0 ? 0 : (cs > 48 ? 48 : cs); \
    att::NaCtx nc{__builtin_amdgcn_readfirstlane(rs - rs0), __builtin_amdgcn_readfirstlane(rs0 - r), cq, cs, (const float*)(lds_raw + att::SHM_RPB)}; \
    att::attn_body<512, 512, 2048, true, 1>(QNA + (size_t)row0 * 512 + h * 128, KNA + (size_t)(seq0 + rs0 * 64) * 512 + h * 128, VNA + (size_t)(seq0 + rs0 * 64) * 512 + h * 128, \
                                         O + (size_t)row0 * 2048 + h * 128, NT, (char*)lds_raw, nc, F.wave); } while (0)
__global__ void __launch_bounds__(512, 2) fwd_kernel(Args args) {
    extern __shared__ __attribute__((aligned(16))) unsigned char lds_raw[];
    LAS unsigned char* lds = (LAS unsigned char*)lds_raw;
    Ctx F; F.tid = threadIdx.x; F.lane = F.tid & 63; F.wave = __builtin_amdgcn_readfirstlane(F.tid >> 6); F.G = gridDim.x; F.blk = blockIdx.x;
    F.gw = F.blk * 8 + F.wave; F.ngw = F.G * 8;
    typedef const __attribute__((address_space(4))) Args* KArgs;
    const KArgs kp0 = (KArgs)__builtin_amdgcn_kernarg_segment_ptr();
#define KP() ({ KArgs k_ = kp0; asm volatile("" : "+s"(k_)); k_; })
#define GIN(i) ((const float*)(const GAS float*)(KP()->in[i]))
#define GOUT() ((float*)(GAS float*)(KP()->out))
#define GWS() ((unsigned char*)(GAS unsigned char*)(KP()->ws))
    unsigned char* ws = GWS();
    if (F.tid < 64) ((LAS unsigned*)(lds + MISC_OFF))[F.tid] = 0u;
    __syncthreads();
    XcdBarrier bar = xcd_barrier_post((unsigned*)(ws + WS_CTL) + CW_BAR, (volatile LAS unsigned*)(lds + MISC_OFF), F.wave);

    {   REFRESH(); ws = GWS();
        { W_PTRS(0); MK_WP(0); convert_weights(F, WP, lds); }
        REFRESH();
        xw_init(F, GIN(0), GIN(1), (bf16*)(ws + WS_XW), (float*)(ws + WS_STAT + ST_RSTD1)); }
    GRID_BAR();
#pragma unroll 1
    for (int layer = 0; layer < DEPTH; ++layer) {
#pragma unroll 1
        for (int grp = 0; grp < NGRP; ++grp) {
            REFRESH();
            PROBE_T0();
            ws = GWS();
            OPQ_PTRS();
            W_PTRS(layer);
            bf16* XW = XWA + (size_t)grp * MG * DM;
            {   pg8::Gemm g{XW, T_IN, MG, NINP, DM, DM, DM}; pg8::StaticOrder S; S.init(MG, NINP, F.G, F.blk);
                pg8::EpiInProj E{R1, R_QNA, R_KNA, R_VNA, R_GQ, R_GK, R_GV, R_Z, R_XBC, R_DT, R_GATE, RSTD1 + (size_t)grp * MG, (LAS float*)(lds + EX_OFF + 4096)};
                pg8::gemm_phase<pg8::EpiInProj, pg8::StaticOrder, true, true>(lds, g, S, E, F.wave); }
            GRID_BAR();
            PROBE_T1(2);
            {   PrepPtrs PP{QNA, KNA, GQ, GK, GIN(4) + layer * 128, GIN(5) + layer * 128, GIN(13) + layer * 128, GIN(14) + layer * 128};
                prep_qk(F, PP, grp);
                REFRESH();
                prep_xbc(F, XBC, XBCA, GIN(7) + (size_t)layer * 5 * 1536, GIN(8) + (size_t)layer * 1536, grp); }
            GRID_BAR();
            PROBE_T1(3);
            ssd::Ptrs SP{XBCA, DT, Z, ST, DEC, O, RSS, GIN(9) + layer * 32, GIN(10) + layer * 32, GIN(11) + layer * 16};
            {
                constexpr int NU = (MG / 256) * 4;
                const bool rot = (F.G == 256);
                if (rot) { if (F.blk >= 128) NA_UNIT(F.blk - 128); }
                else for (int u = F.blk; u < NU; u += F.G) NA_UNIT(u);
                REFRESH();
                for (int u = F.blk; u < NU; u += F.G) {
                    int seq0, L, h, qb;
                    if (grp == 0 && u < 256) { seq0 = 0; L = LP; h = u >> 6; qb = u & 63; }
                    else { const int v = grp == 0 ? u - 256 : u; seq0 = (grp == 0 ? LP : 0) + (v >> 5) * LS; L = LS; h = (v >> 3) & 3; qb = v & 7; }
                    att::NaCtx nc{0, 0, 0, 0, nullptr};
                    att::attn_body<512, 256, 2048, false, 2>(GQ + (size_t)(seq0 + qb * 256) * 512 + h * 128, GK + (size_t)seq0 * 256 + (h >> 1) * 128, GV + (size_t)seq0 * 256 + (h >> 1) * 128,
                                                          O + (size_t)(seq0 + qb * 256) * 2048 + 1536 + h * 128, L / 64, (char*)lds_raw, nc, F.wave);
                }
                REFRESH();
                for (int u0 = F.blk; u0 < (rot ? 512 : NU); u0 += F.G) { const int u = (rot && u0 >= 256) ? 256 + ((u0 + 128) & 255) : u0; if (u >= NU) continue; ssd::s1_unit(SP, lds, u >> 1, u & 1, F.tid); }
            }
            GRID_BAR();
            PROBE_T1(4);
            ssd::scan_states<16>(F, ST, DEC, grp);
            GRID_BAR();
            PROBE_T1(5);
            for (int u = F.blk; u < (MG / 128) * 2; u += F.G) ssd::s3_unit(SP, lds, u >> 1, u & 1, F.tid);
            if (F.G == 256 && F.blk >= 128) { REFRESH(); NA_UNIT(128 + 2 * (F.blk - 128)); REFRESH(); NA_UNIT(129 + 2 * (F.blk - 128)); }
            GRID_BAR();
            PROBE_T1(6);
            {   pg8::Gemm g{O, T_BR, MG, DM, DM, DM, DM}; pg8::StaticOrder S; S.init(MG, DM, F.G, F.blk);
                pg8::EpiMerge E{GATE, MRG, RSS};
                pg8::gemm_phase<pg8::EpiMerge, pg8::StaticOrder, true, true>(lds, g, S, E, F.wave); }
            GRID_BAR();
            PROBE_T1(7);
            {   pg8::Gemm g{MRG, T_OUT, MG, DM, DM, DM, DM}; pg8::StaticOrder S; S.init(MG, DM, F.G, F.blk);
                pg8::EpiResid E{XW, nullptr, 0, SSQ + (size_t)grp * MG * 8, RSTD2 + (size_t)grp * MG, CNT + (2 * layer + 0) * CNT_USE + grp * (MG / 256) * 16, (LAS float*)(lds + EX_OFF)};
                pg8::gemm_phase<pg8::EpiResid, pg8::StaticOrder, true, true>(lds, g, S, E, F.wave); }
            GRID_BAR();
            PROBE_T1(8);
        }
        {
            REFRESH();
            PROBE_T0();
            ws = GWS();
            OPQ_PTRS();
            W_PTRS(layer);
            {   pg8::Gemm g{XWA, T_UP, MTOT, NUP, DM, DM, DM}; pg8::StaticOrder S; S.init(MTOT, NUP, F.G, F.blk);
                pg8::EpiFfnAct E{ACT, (const float*)(ws + WS_CW + (size_t)(layer & 1) * CW_LAYER), SIDE, (LAS float*)(lds + EX_OFF), RSTD2, (LAS float*)(lds + EX_OFF + 4096), (LAS float*)(lds + EX_OFF + 8192)};
                pg8::gemm_phase<pg8::EpiFfnAct, pg8::StaticOrder, true, true>(lds, g, S, E, F.wave); }
            GRID_BAR();
            PROBE_T1(10);
            ffn_fix(F, SIDE, ACT, GIN(19) + (size_t)layer * 3 * DFF);
            if (layer + 1 < DEPTH) { REFRESH(); unsigned char* WLn = ws + WS_W + (size_t)((layer + 1) & 1) * W_LAYER;
                WPtrs WP{GIN(3) + (size_t)(layer + 1) * DM * NIN, GIN(15) + (size_t)(layer + 1) * DM * DM, GIN(16) + (size_t)(layer + 1) * DM * DM, GIN(18) + (size_t)(layer + 1) * DM * NUP, GIN(21) + (size_t)(layer + 1) * DFF * DM,
                         GIN(2) + (layer + 1) * DM, GIN(17) + (layer + 1) * DM, GIN(12) + (layer + 1) * 1024, (bf16*)(WLn + W_TIN), (bf16*)(WLn + W_TBR), (bf16*)(WLn + W_TOUT), (bf16*)(WLn + W_TUP), (bf16*)(WLn + W_TDN), GIN(19) + (size_t)(layer + 1) * 3 * DFF, GIN(20) + (size_t)(layer + 1) * DFF, (float*)(ws + WS_CW + (size_t)((layer + 1) & 1) * CW_LAYER)};
                convert_weights(F, WP, lds); }
            GRID_BAR();
            PROBE_T1(11);
            {   pg8::Gemm g{ACT, T_DN, MTOT, DM, DFF, DFF, DFF}; pg8::StaticOrder S; S.init(MTOT, DM, F.G, F.blk);
                pg8::EpiResid E{XWA, GOUT(), layer == DEPTH - 1, SSQ, RSTD1, CNT + (2 * layer + 1) * CNT_USE, (LAS float*)(lds + EX_OFF)};
                pg8::gemm_phase<pg8::EpiResid, pg8::StaticOrder, true, true>(lds, g, S, E, F.wave); }
            GRID_BAR();
            PROBE_T1(12);
        }
    }
}

extern "C" void kernel_launch(void* const* d_in, const int* in_sizes, int n_in, void* d_out, int out_size, void* d_ws, size_t ws_size, hipStream_t stream) {
    static int grid = 0;
    if (grid == 0) {
        if (n_in != 22 || out_size != MTOT * DM || ws_size < WS_END) { fprintf(stderr, "kernel_launch: unexpected shapes n_in %d out %d ws %zu (need %zu)\n", n_in, out_size, ws_size, (size_t)WS_END); grid = -1; return; }
        int dev = 0, cus = 0, per_cu = 0;
        if (hipGetDevice(&dev) != hipSuccess || hipDeviceGetAttribute(&cus, hipDeviceAttributeMultiprocessorCount, dev) != hipSuccess) { grid = -1; return; }
        if (hipFuncSetAttribute((const void*)fwd_kernel, hipFuncAttributeMaxDynamicSharedMemorySize, LDS_BYTES) != hipSuccess) { fprintf(stderr, "kernel_launch: hipFuncSetAttribute failed\n"); grid = -1; return; }
        if (hipOccupancyMaxActiveBlocksPerMultiprocessor(&per_cu, (const void*)fwd_kernel, 512, LDS_BYTES) != hipSuccess || per_cu < 1) { fprintf(stderr, "kernel_launch: occupancy query says %d blocks per CU\n", per_cu); (void)hipGetLastError(); grid = -1; return; }
        grid = cus;
    }
    if (grid < 0) return;
    if (hipMemsetAsync((char*)d_ws + WS_CTL, 0, CTL_ZERO_BYTES, stream) != hipSuccess) return;
    Args a{};
    for (int i = 0; i < 22; ++i) a.in[i] = (const float*)d_in[i];
    a.out = (float*)d_out; a.ws = (unsigned char*)d_ws;
    hipLaunchKernelGGL(fwd_kernel, dim3(grid), dim3(512), LDS_BYTES, stream, a);
    const hipError_t le = hipPeekAtLastError();
    if (le != hipSuccess) fprintf(stderr, "kernel_launch: launch failed: %s\n", hipGetErrorName(le));
}
```

```cpp
#ifndef PROBE_G
#define PROBE_G 0
#endif
#ifndef PROBE_GS
#define PROBE_GS 0
#endif
#include <hip/hip_runtime.h>
#include <cstdio>
#include <cstdint>
#include <cmath>

#define GAS __attribute__((address_space(1)))
#define LAS __attribute__((address_space(3)))
typedef unsigned short bf16;
typedef unsigned v4u __attribute__((ext_vector_type(4)));
typedef unsigned v2u __attribute__((ext_vector_type(2)));
typedef float f32x4 __attribute__((ext_vector_type(4)));
typedef float f32x2 __attribute__((ext_vector_type(2)));
typedef float f32x16 __attribute__((ext_vector_type(16)));
typedef short bf16x8 __attribute__((ext_vector_type(8)));
typedef short s16x4 __attribute__((ext_vector_type(4)));
typedef __bf16 bf16x2_t __attribute__((ext_vector_type(2)));
#define DI __device__ __forceinline__

DI unsigned pk2(float lo, float hi) { f32x2 v = {lo, hi}; bf16x2_t b = __builtin_convertvector(v, bf16x2_t); return __builtin_bit_cast(unsigned, b); }
DI unsigned short f2bf(float f) { return (unsigned short)(pk2(f, 0.f) & 0xffffu); }
DI float bflo(unsigned u) { return __uint_as_float(u << 16); }
DI float bfhi(unsigned u) { return __uint_as_float(u & 0xffff0000u); }
DI float bf2f(unsigned short h) { return __uint_as_float((unsigned)h << 16); }
DI void unpack8(v4u v, float (&x)[8]) { x[0] = bflo(v.x); x[1] = bfhi(v.x); x[2] = bflo(v.y); x[3] = bfhi(v.y); x[4] = bflo(v.z); x[5] = bfhi(v.z); x[6] = bflo(v.w); x[7] = bfhi(v.w); }
DI v4u pack8(const float (&x)[8]) { v4u v; v.x = pk2(x[0], x[1]); v.y = pk2(x[2], x[3]); v.z = pk2(x[4], x[5]); v.w = pk2(x[6], x[7]); return v; }
DI float sigmoidf_(float x) { return __builtin_amdgcn_rcpf(1.f + __expf(-x)); }
DI float siluf_(float x) { return x * sigmoidf_(x); }

template <int K> DI float xor_lane(float v) {
    if constexpr (K == 32) { auto rr = __builtin_amdgcn_permlane32_swap(__float_as_uint(v), __float_as_uint(v), false, false); return __uint_as_float((__builtin_amdgcn_mbcnt_hi(~0u, __builtin_amdgcn_mbcnt_lo(~0u, 0u)) & 32u) ? rr[0] : rr[1]); }
    else return __int_as_float(__builtin_amdgcn_ds_swizzle(__float_as_int(v), (K << 10) | 0x1f));
}
DI float wave_sum(float v) {
    v += xor_lane<1>(v); v += xor_lane<2>(v); v += xor_lane<4>(v); v += xor_lane<8>(v); v += xor_lane<16>(v);
    { auto rr = __builtin_amdgcn_permlane32_swap(__float_as_uint(v), __float_as_uint(v), false, false); v = __uint_as_float(rr[0]) + __uint_as_float(rr[1]); }
    return v;
}
template <int CTRL> DI float dppx(float v) { return __int_as_float(__builtin_amdgcn_mov_dpp(__float_as_int(v), CTRL, 0xf, 0xf, true)); }
template <int CTRL, int RMASK> DI float dpp0(float v) { return __int_as_float(__builtin_amdgcn_update_dpp(0, __float_as_int(v), CTRL, RMASK, 0xf, false)); }
DI float wave_scan_incl(float v) {
    v += dpp0<0x111, 0xf>(v); v += dpp0<0x112, 0xf>(v); v += dpp0<0x114, 0xf>(v); v += dpp0<0x118, 0xf>(v);
    v += dpp0<0x142, 0xa>(v); v += dpp0<0x143, 0xc>(v);
    return v;
}
DI int lane_id() { return (int)__builtin_amdgcn_mbcnt_hi(~0u, __builtin_amdgcn_mbcnt_lo(~0u, 0u)); }
DI int tid_of(int wave) { unsigned z = 0u; asm volatile("" : "+v"(z));
    int t = wave * 64 + (int)__builtin_amdgcn_mbcnt_hi(~0u, __builtin_amdgcn_mbcnt_lo(~0u, z)); asm volatile("" : "+v"(t)); return t; }
#define LDS_WAIT() asm volatile("s_waitcnt lgkmcnt(0)" ::: "memory")
#define VM_WAIT() asm volatile("s_waitcnt vmcnt(0)" ::: "memory")

constexpr int DM = 2048, DEPTH = 4, MTOT = 49152, MG = 24576, NGRP = 2, LP = 16384, LS = 2048;
DI int seq_len(int grp, int tok) { return (grp == 0 && tok < LP) ? LP : LS; }
DI int seq_start(int grp, int tok) { return (grp == 0 && tok < LP) ? 0 : (tok & ~(LS - 1)); }
constexpr int NIN = 11296, NINP = 11520, DFF = 5632, NUP = 11264, GATE_SRC0 = 5152, GATE_DST0 = 5376;
constexpr float EPSN = 1e-6f;
namespace pg8 {
#define PG8_LAS __attribute__((address_space(3)))
typedef unsigned short bf16_t;
typedef short bf16x8 __attribute__((ext_vector_type(8)));
typedef float f32x4 __attribute__((ext_vector_type(4)));
typedef unsigned u32x4 __attribute__((ext_vector_type(4)));
constexpr int BM = 256, BK = 64, HALF = 128, HTB = HALF * BK * 2  , STAGE_BYTES = 8 * HTB, NXCD = 8, WGM = 8;

__host__ __device__ __forceinline__ int lds_byte(int r, int c) { const int st = (r >> 4) * 2 + (c >> 5), rr = r & 15, cc = c & 31, ob = rr * 64 + cc * 2; return st * 1024 + (ob ^ (((ob >> 9) & 1) << 5)); }
__host__ __device__ __forceinline__ void stage_rc(int b, int& R, int& C) { const int st = b / 1024, sb = b % 1024, swz = sb ^ (((sb >> 9) & 1) << 5); R = (st >> 1) * 16 + swz / 64; C = (st & 1) * 32 + (swz % 64) / 2; }
__host__ __device__ __forceinline__ int perm32(int rho) { const int n = rho >> 4, i = rho & 15; return 8 * (i >> 2) + 4 * n + (i & 3); }

struct Unit { int pm, pn; };
struct Gemm { const bf16_t* A; const bf16_t* Bt; int M, N, K, lda, ldb; };

struct StaticOrder {
    int nM, nN, nwg, G, c;
    __host__ __device__ void init(int M, int N, int G_, int c_) { nM = M / BM; nN = N / BM; nwg = nM * nN; G = G_; c = c_; }
    __host__ __device__ bool next(int i, Unit& u) const {
        const long L = (long)i * G + c; if (L >= nwg) return false;
        int wgid = (int)L; { const int q = nwg / NXCD, r = nwg % NXCD, xcd = wgid % NXCD, off = wgid / NXCD; wgid = (xcd < r ? xcd * (q + 1) : r * (q + 1) + (xcd - r) * q) + off; }
        const int nig = WGM * nN, gid = wgid / nig, fm = gid * WGM, gsz = (nM - fm) < WGM ? (nM - fm) : WGM;
        u.pm = fm + ((wgid % nig) % gsz); u.pn = (wgid % nig) / gsz; return true;
    }
    __device__ __forceinline__ void a_ready(const Unit&) const {}
    __device__ __forceinline__ void done(const Unit&) const {}
};

__device__ __forceinline__ void row_rstd(const float* rstd, int row0, float (&rs)[2][4]) {
#pragma unroll
    for (int ai = 0; ai < 2; ++ai)
#pragma unroll
        for (int m = 0; m < 4; ++m) rs[ai][m] = rstd[row0 + ai * HALF + m * 16];
}
struct EpiInProj {
    static constexpr bool APERM = false; static constexpr int PID = 0; static constexpr bool PERM = true, AFTER_DRAIN = false, KHOOK = false, KSTATE = true;
    unsigned char* r1;
    size_t oQNA, oKNA, oVNA, oGQ, oGK, oGV, oZ, oXBC, oDT, oGATE;
    const float* rstd; PG8_LAS float* rl;
    __device__ __forceinline__ void kpre(const Unit& u, int wr, int wc, int fr, int fq) const {
        int fr_ = fr, fq_ = fq; asm volatile("" : "+v"(fr_), "+v"(fq_)); const int lane = fq_ * 16 + fr_, wid = wr * 4 + wc;
#pragma unroll
        for (int k = 0; k < 2; ++k) __builtin_amdgcn_global_load_lds((const unsigned*)(rstd + u.pm * BM + k * HALF + wr * 64 + lane), (PG8_LAS unsigned*)(rl + wid * 128 + k * 64), 4, 0, 0);
    }
    __device__ __forceinline__ void operator()(const f32x4 (&acc)[2][2][4][2], const Unit& u, int wr, int wc, int fr, int fq) const {
        const int pn = u.pn; const int row0 = u.pm * BM + wr * 64 + fr;
        size_t off; int ld, colb, mode = 0;
        if (pn < 2)       { off = oQNA; ld = 512;  colb = pn * 256; }
        else if (pn < 4)  { off = oKNA; ld = 512;  colb = (pn - 2) * 256; }
        else if (pn < 6)  { off = oVNA; ld = 512;  colb = (pn - 4) * 256; }
        else if (pn < 8)  { off = oGQ;  ld = 512;  colb = (pn - 6) * 256; }
        else if (pn == 8) { off = oGK;  ld = 256;  colb = 0; }
        else if (pn == 9) { off = oGV;  ld = 256;  colb = 0; }
        else if (pn < 14) { off = oZ;   ld = 1024; colb = (pn - 10) * 256; }
        else if (pn < 20) { off = oXBC; ld = 1536; colb = (pn - 14) * 256; }
        else if (pn == 20){ off = oDT;  ld = 32;   colb = 0; mode = 1; }
        else              { off = oGATE; ld = 6144; colb = (pn - 21) * 256; mode = 2; }
        const int col0 = colb + wc * 32 + 8 * fq;
        float rs[2][4];
#pragma unroll
        for (int i = 0; i < 8; ++i) rs[i >> 2][i & 3] = rl[(wr * 4 + wc) * 128 + (i >> 2) * 64 + (i & 3) * 16 + fr];
        if (mode == 1) {
            if (wc == 0) {
                float* base = (float*)(r1 + off);
#pragma unroll
                for (int ai = 0; ai < 2; ++ai)
#pragma unroll
                    for (int m = 0; m < 4; ++m) { float* rowp = base + (size_t)(row0 + ai * HALF + m * 16) * 32 + 8 * fq;
                        *(f32x4*)(rowp) = acc[ai][0][m][0] * rs[ai][m]; *(f32x4*)(rowp + 4) = acc[ai][0][m][1] * rs[ai][m]; }
            }
            return;
        }
        if (mode == 2) {
            const int gt = pn - 21; int fr_ = fr, fq_ = fq; asm volatile("" : "+v"(fr_), "+v"(fq_));
            unsigned char* tb = (unsigned char*)(r1 + off) + ((size_t)((u.pm * 3 + (gt >> 3)) * 8 + (gt & 7)) * 8 + (wr * 4 + wc)) * 8192 + (fq_ * 16 + fr_) * 16;
#pragma unroll
            for (int ai = 0; ai < 2; ++ai)
#pragma unroll
                for (int m = 0; m < 4; ++m) { u32x4 w;
#pragma unroll
                    for (int bj = 0; bj < 2; ++bj) { const f32x4 v0 = acc[ai][bj][m][0] * rs[ai][m], v1 = acc[ai][bj][m][1] * rs[ai][m]; unsigned q[8];
#pragma unroll
                        for (int e = 0; e < 4; ++e) { q[e] = (unsigned)fmaxf(sigmoidf_(v0[e]) * 255.f + 0.5f, 1.f); q[4 + e] = (unsigned)fmaxf(sigmoidf_(v1[e]) * 255.f + 0.5f, 1.f); }
                        const unsigned lo = q[0] | (q[1] << 8) | (q[2] << 16) | (q[3] << 24), hi = q[4] | (q[5] << 8) | (q[6] << 16) | (q[7] << 24);
                        if (bj == 0) { w.x = lo; w.y = hi; } else { w.z = lo; w.w = hi; } }
                    *(u32x4*)(tb + (ai * 4 + m) * 1024) = w; }
            return;
        }
        bf16_t* base = (bf16_t*)(r1 + off);
#pragma unroll
        for (int ai = 0; ai < 2; ++ai)
#pragma unroll
            for (int m = 0; m < 4; ++m) { bf16_t* rowp = base + (size_t)(row0 + ai * HALF + m * 16) * ld + col0;
#pragma unroll
                for (int bj = 0; bj < 2; ++bj) { const f32x4 v0 = acc[ai][bj][m][0] * rs[ai][m], v1 = acc[ai][bj][m][1] * rs[ai][m];
                    u32x4 w; w.x = pk2(v0[0], v0[1]); w.y = pk2(v0[2], v0[3]); w.z = pk2(v1[0], v1[1]); w.w = pk2(v1[2], v1[3]);
                    *(u32x4*)(rowp + bj * HALF) = w; } }
    }
};
struct EpiBf16Plain {
    static constexpr bool APERM = false; static constexpr int PID = 1; static constexpr bool PERM = true, AFTER_DRAIN = false, KHOOK = false, KSTATE = false;
    bf16_t* O; int ldc;
    __device__ __forceinline__ void operator()(const f32x4 (&acc)[2][2][4][2], const Unit& u, int wr, int wc, int fr, int fq) const {
        const int row0 = u.pm * BM + wr * 64 + fr, col0 = u.pn * BM + wc * 32 + 8 * fq;
#pragma unroll
        for (int ai = 0; ai < 2; ++ai)
#pragma unroll
            for (int m = 0; m < 4; ++m) { bf16_t* rowp = O + (size_t)(row0 + ai * HALF + m * 16) * ldc + col0;
#pragma unroll
                for (int bj = 0; bj < 2; ++bj) { const f32x4 v0 = acc[ai][bj][m][0], v1 = acc[ai][bj][m][1];
                    u32x4 w; w.x = pk2(v0[0], v0[1]); w.y = pk2(v0[2], v0[3]); w.z = pk2(v1[0], v1[1]); w.w = pk2(v1[2], v1[3]);
                    *(u32x4*)(rowp + bj * HALF) = w; } }
    }
};
struct EpiMerge {
    static constexpr bool APERM = false; static constexpr int PID = 2; static constexpr bool PERM = true, AFTER_DRAIN = false, KHOOK = true, KSTATE = false;
    const unsigned char* gates; bf16_t* merged; const float* rss;
    typedef unsigned u32x2 __attribute__((ext_vector_type(2)));
    typedef float f32x2_ __attribute__((ext_vector_type(2)));
    static __device__ __forceinline__ void unq(u32x2 w, float (&g)[8]) {
        g[0] = (float)(w.x & 255u); g[1] = (float)((w.x >> 8) & 255u); g[2] = (float)((w.x >> 16) & 255u); g[3] = (float)(w.x >> 24);
        g[4] = (float)(w.y & 255u); g[5] = (float)((w.y >> 8) & 255u); g[6] = (float)((w.y >> 16) & 255u); g[7] = (float)(w.y >> 24); }
    __device__ __forceinline__ void khook(f32x4 (&acc)[2][2][4][2], const Unit& u, int t, int wr, int wc, int fr, int fq) const {
        if (t != 8 && t != 16 && t != 24) return;
        int fr_ = fr, fq_ = fq; asm volatile("" : "+v"(fr_), "+v"(fq_));
        const int row0 = u.pm * BM + wr * 64 + fr_;
        const int ja = t == 8 ? 0 : 1, jb = t == 24 ? 2 : 1;
        const float w8 = t == 8 ? 1.f : 0.f, w16 = t == 16 ? 1.f : 0.f, w24 = t == 24 ? 1.f : 0.f;
        const unsigned char* ta = gblob(u, ja, wr, wc, fr_, fq_); const unsigned char* tbp = gblob(u, jb, wr, wc, fr_, fq_);
        f32x2_ rr[2][4]; u32x4 qa[2][4], qb[2][4];
#pragma unroll
        for (int ai = 0; ai < 2; ++ai)
#pragma unroll
            for (int m = 0; m < 4; ++m) { rr[ai][m] = *(const f32x2_*)(rss + (size_t)(row0 + ai * HALF + m * 16) * 2);
                qa[ai][m] = *(const u32x4*)(ta + (ai * 4 + m) * 1024); qb[ai][m] = *(const u32x4*)(tbp + (ai * 4 + m) * 1024); }
#pragma unroll
        for (int ai = 0; ai < 2; ++ai)
#pragma unroll
            for (int m = 0; m < 4; ++m) { const float f = (w8 + w16 * rr[ai][m].x + w24 * rr[ai][m].y) * __builtin_amdgcn_rcpf(w8 * rr[ai][m].x + w16 * rr[ai][m].y + w24);
#pragma unroll
                for (int bj = 0; bj < 2; ++bj) {
                    float ga[8], gb[8]; unq(bj ? (u32x2){qa[ai][m].z, qa[ai][m].w} : (u32x2){qa[ai][m].x, qa[ai][m].y}, ga); unq(bj ? (u32x2){qb[ai][m].z, qb[ai][m].w} : (u32x2){qb[ai][m].x, qb[ai][m].y}, gb);
#pragma unroll
                    for (int e = 0; e < 4; ++e) { acc[ai][bj][m][0][e] *= ga[e] * f * __builtin_amdgcn_rcpf(gb[e]); acc[ai][bj][m][1][e] *= ga[4 + e] * f * __builtin_amdgcn_rcpf(gb[4 + e]); } } }
    }
    __device__ __forceinline__ const unsigned char* gblob(const Unit& u, int br, int wr, int wc, int fr, int fq) const {
        return gates + ((size_t)((u.pm * 3 + br) * 8 + u.pn) * 8 + (wr * 4 + wc)) * 8192 + (fq * 16 + fr) * 16; }
    __device__ __forceinline__ void operator()(const f32x4 (&acc)[2][2][4][2], const Unit& u, int wr, int wc, int fr, int fq) const {
        const int row0 = u.pm * BM + wr * 64 + fr, col0 = u.pn * BM + wc * 32 + 8 * fq;
        const unsigned char* tg = gblob(u, 2, wr, wc, fr, fq);
#pragma unroll
        for (int ai = 0; ai < 2; ++ai) { u32x4 gr[4];
#pragma unroll
            for (int m = 0; m < 4; ++m) gr[m] = *(const u32x4*)(tg + (ai * 4 + m) * 1024);
#pragma unroll
            for (int m = 0; m < 4; ++m) { const size_t row = (size_t)(row0 + ai * HALF + m * 16);
#pragma unroll
                for (int bj = 0; bj < 2; ++bj) { const int col = col0 + bj * HALF;
                    float g[8]; unq(bj ? (u32x2){gr[m].z, gr[m].w} : (u32x2){gr[m].x, gr[m].y}, g);
                    const f32x4 v0 = acc[ai][bj][m][0] * (1.f / 255.f), v1 = acc[ai][bj][m][1] * (1.f / 255.f);
                    u32x4 w; w.x = pk2(v0[0] * g[0], v0[1] * g[1]); w.y = pk2(v0[2] * g[2], v0[3] * g[3]); w.z = pk2(v1[0] * g[4], v1[1] * g[5]); w.w = pk2(v1[2] * g[6], v1[3] * g[7]);
                    *(u32x4*)(merged + row * 2048 + col) = w; } } }
    }
};
template <int CTRL> __device__ __forceinline__ float dpp_rot(float v) { return __int_as_float(__builtin_amdgcn_mov_dpp(__float_as_int(v), CTRL, 0xf, 0xf, true)); }
struct EpiFfnAct {
    static constexpr bool APERM = true; static constexpr int PID = 3; static constexpr bool PERM = true, AFTER_DRAIN = false, KHOOK = false, KSTATE = true;
    bf16_t* act; const float* cwp; float* side; PG8_LAS float* ex;
    const float* rstd; PG8_LAS float* rl;
    PG8_LAS float* wl;
    __device__ __forceinline__ void kpre(const Unit& u, int wr, int wc, int fr, int fq) const {
        int fr_ = fr, fq_ = fq; asm volatile("" : "+v"(fr_), "+v"(fq_)); const unsigned lo = (unsigned)(fq_ * 16 + fr_) * 4u; const int wid = wr * 4 + wc;
        const char* b0 = (const char*)(rstd + u.pm * BM + wr * 64); const char* b1 = (const char*)(cwp + (u.pn * 4 + wc) * 128);
        __builtin_amdgcn_global_load_lds((const unsigned*)(b0 + lo), (PG8_LAS unsigned*)(rl + wid * 128), 4, 0, 0);
        __builtin_amdgcn_global_load_lds((const unsigned*)(b0 + HALF * 4 + lo), (PG8_LAS unsigned*)(rl + wid * 128 + 64), 4, 0, 0);
        __builtin_amdgcn_global_load_lds((const unsigned*)(b1 + lo), (PG8_LAS unsigned*)(wl + wid * 128), 4, 0, 0);
        __builtin_amdgcn_global_load_lds((const unsigned*)(b1 + 256 + lo), (PG8_LAS unsigned*)(wl + wid * 128 + 64), 4, 0, 0);
    }
    __device__ __forceinline__ void operator()(const f32x4 (&acc)[2][2][4][2], const Unit& u, int wr, int wc, int fr_in, int fq_in) const {
        int fr = fr_in, fq = fq_in; asm volatile("" : "+v"(fr), "+v"(fq));
        const int gc = u.pn * 128 + wc * 32 + 8 * fq, lc = wc * 32 + 8 * fq;
        const int row0 = u.pm * BM + wr * 64 + 4 * fr;
        f32x4 rs[2];
#pragma unroll
        for (int ai = 0; ai < 2; ++ai) rs[ai] = *(const PG8_LAS f32x4*)(rl + (wr * 4 + wc) * 128 + ai * 64 + 4 * fr);
        f32x4 w0[2], w1[2], w2[2], bb[2];
        {   const PG8_LAS float* wp = wl + (wr * 4 + wc) * 128 + 8 * fq;
#pragma unroll
            for (int n = 0; n < 2; ++n) { w0[n] = *(const PG8_LAS f32x4*)(wp + 4 * n); w1[n] = *(const PG8_LAS f32x4*)(wp + 32 + 4 * n); w2[n] = *(const PG8_LAS f32x4*)(wp + 64 + 4 * n); bb[n] = *(const PG8_LAS f32x4*)(wp + 96 + 4 * n); } }
#pragma unroll
        for (int ai = 0; ai < 2; ++ai) { const int b = 2 * ai + wr;
            if (fr == 0)  { *(PG8_LAS f32x4*)(ex + (b * 2 + 0) * 128 + lc) = acc[ai][0][0][0] * rs[ai][0]; *(PG8_LAS f32x4*)(ex + (b * 2 + 0) * 128 + lc + 4) = acc[ai][0][0][1] * rs[ai][0]; }
            if (fr == 15) { *(PG8_LAS f32x4*)(ex + (b * 2 + 1) * 128 + lc) = acc[ai][0][3][0] * rs[ai][3]; *(PG8_LAS f32x4*)(ex + (b * 2 + 1) * 128 + lc + 4) = acc[ai][0][3][1] * rs[ai][3]; } }
        asm volatile("s_waitcnt lgkmcnt(0)" ::: "memory"); __builtin_amdgcn_s_barrier(); asm volatile("" ::: "memory");
        const bool f0 = fr == 0, f15 = fr == 15;
#pragma unroll
        for (int ai = 0; ai < 2; ++ai) { const int b = 2 * ai + wr;
            f32x4 hu[2], hd[2];
#pragma unroll
            for (int n = 0; n < 2; ++n) { hu[n] = b > 0 ? *(const PG8_LAS f32x4*)(ex + ((b - 1) * 2 + 1) * 128 + lc + 4 * n) : (f32x4){0.f, 0.f, 0.f, 0.f};
                                          hd[n] = b < 3 ? *(const PG8_LAS f32x4*)(ex + ((b + 1) * 2 + 0) * 128 + lc + 4 * n) : (f32x4){0.f, 0.f, 0.f, 0.f}; }
            f32x4 o[4][2];
            const bool sidew = ai == 0 ? (wr == 0 && f0) : (wr == 1 && f15);
#pragma unroll
            for (int n = 0; n < 2; ++n) { f32x4 sedge;
#pragma unroll
                for (int e = 0; e < 4; ++e) { float g[4];
#pragma unroll
                    for (int m = 0; m < 4; ++m) g[m] = acc[ai][0][m][n][e] * rs[ai][m];
                    float up = dpp_rot<0x121>(g[3]); up = f0 ? hu[n][e] : up;
                    float dn = dpp_rot<0x12f>(g[0]); dn = f15 ? hd[n][e] : dn;
#pragma unroll
                    for (int m = 0; m < 4; ++m) { const float gu = m == 0 ? up : g[m > 0 ? m - 1 : 0], gd = m == 3 ? dn : g[m < 3 ? m + 1 : 3];
                        const float s = bb[n][e] + w0[n][e] * gu + w1[n][e] * g[m] + w2[n][e] * gd;
                        o[m][n][e] = siluf_(s) * (acc[ai][1][m][n][e] * rs[ai][m]);
                        if ((ai == 0 && m == 0) || (ai == 1 && m == 3)) sedge[e] = s; } }
                if (sidew) { const int m = ai == 0 ? 0 : 3;
                    const f32x4 gg = acc[ai][0][m][n] * rs[ai][m], vg = acc[ai][1][m][n] * rs[ai][m];
                    f32x4* sp = (f32x4*)(side + (((size_t)u.pm * 2 + ai) * 5632 + gc + 4 * n) * 3);
                    sp[0] = (f32x4){sedge[0], vg[0], gg[0], sedge[1]}; sp[1] = (f32x4){vg[1], gg[1], sedge[2], vg[2]}; sp[2] = (f32x4){gg[2], sedge[3], vg[3], gg[3]}; } }
#pragma unroll
            for (int m = 0; m < 4; ++m) { u32x4 w; w.x = pk2(o[m][0][0], o[m][0][1]); w.y = pk2(o[m][0][2], o[m][0][3]); w.z = pk2(o[m][1][0], o[m][1][1]); w.w = pk2(o[m][1][2], o[m][1][3]);
                *(u32x4*)(act + (size_t)(row0 + ai * HALF + m) * 5632 + gc) = w; } }
    }
};
struct EpiResid {
    static constexpr bool APERM = false; static constexpr int PID = 4; static constexpr bool PERM = true, AFTER_DRAIN = false, KHOOK = false, KSTATE = false;
    bf16_t* xw; float* fout; int out_f32; float* ssq; float* rstd; unsigned* cnt; PG8_LAS float* part;
    __device__ __forceinline__ void operator()(const f32x4 (&acc)[2][2][4][2], const Unit& u, int wr, int wc, int fr, int fq) const {
        const int row0 = u.pm * BM + wr * 64 + fr, col0 = u.pn * BM + wc * 32 + 8 * fq;
#pragma unroll
        for (int ai = 0; ai < 2; ++ai) { u32x4 xr[4][2];
#pragma unroll
            for (int m = 0; m < 4; ++m)
#pragma unroll
                for (int bj = 0; bj < 2; ++bj) xr[m][bj] = *(const u32x4*)(xw + (size_t)(row0 + ai * HALF + m * 16) * 2048 + col0 + bj * HALF);
#pragma unroll
            for (int m = 0; m < 4; ++m) { const size_t off = (size_t)(row0 + ai * HALF + m * 16) * 2048 + col0; float sq = 0.f;
#pragma unroll
                for (int bj = 0; bj < 2; ++bj) { float t[8]; unpack8(xr[m][bj], t);
                    const f32x4 v0 = (f32x4){t[0], t[1], t[2], t[3]} + acc[ai][bj][m][0], v1 = (f32x4){t[4], t[5], t[6], t[7]} + acc[ai][bj][m][1];
                    sq += ((v0[0] * v0[0] + v0[1] * v0[1]) + (v0[2] * v0[2] + v0[3] * v0[3])) + ((v1[0] * v1[0] + v1[1] * v1[1]) + (v1[2] * v1[2] + v1[3] * v1[3]));
                    if (out_f32) { *(f32x4*)(fout + off + bj * HALF) = v0; *(f32x4*)(fout + off + bj * HALF + 4) = v1; }
                    else { u32x4 w; w.x = pk2(v0[0], v0[1]); w.y = pk2(v0[2], v0[3]); w.z = pk2(v1[0], v1[1]); w.w = pk2(v1[2], v1[3]); *(u32x4*)(xw + off + bj * HALF) = w; } }
                if (!out_f32) { sq += xor_lane<16>(sq);
                    { auto rr = __builtin_amdgcn_permlane32_swap(__float_as_uint(sq), __float_as_uint(sq), false, false); sq = __uint_as_float(rr[0]) + __uint_as_float(rr[1]); }
                    if (fq == 0) part[(ai * HALF + wr * 64 + m * 16 + fr) * 4 + wc] = sq; } } }
        if (out_f32) return;
        asm volatile("s_waitcnt lgkmcnt(0)" ::: "memory"); __builtin_amdgcn_s_barrier(); asm volatile("" ::: "memory");
        if (wr == 0) {
            const int lane = fq * 16 + fr, t = wc * 64 + lane;
            const f32x4 q = *(const PG8_LAS f32x4*)(part + t * 4);
            __hip_atomic_store(ssq + (size_t)(u.pm * BM + t) * 8 + u.pn, (q.x + q.y) + (q.z + q.w), __ATOMIC_RELAXED, __HIP_MEMORY_SCOPE_AGENT);
            asm volatile("s_waitcnt vmcnt(0)" ::: "memory");
            unsigned old = 0u; if (lane == 0) old = __hip_atomic_fetch_add(cnt + u.pm * 16, 1u, __ATOMIC_RELAXED, __HIP_MEMORY_SCOPE_AGENT);
            if ((unsigned)__builtin_amdgcn_readfirstlane(old) == 31u) {
                __builtin_amdgcn_fence(__ATOMIC_ACQUIRE, "agent");
#pragma unroll
                for (int k = 0; k < 4; ++k) { const int r = u.pm * BM + lane + 64 * k; float tot = 0.f;
#pragma unroll
                    for (int j = 0; j < 8; ++j) tot += __hip_atomic_load(ssq + (size_t)r * 8 + j, __ATOMIC_RELAXED, __HIP_MEMORY_SCOPE_AGENT);
                    rstd[r] = 1.f / sqrtf(tot * (1.f / 2048.f) + 1e-6f); } }
        }
    }
};

template <class Epi, class Sched, bool ALIGN_EPI = false, bool SP2 = false>
__device__ __forceinline__ void gemm_phase(PG8_LAS unsigned char* lds, const Gemm g, const Sched& S, const Epi& E, int wave_) {
    const int tid_ = tid_of(wave_);
    const int tid = tid_, wid = __builtin_amdgcn_readfirstlane(tid >> 6), lane = tid & 63, wr = wid >> 2, wc = wid & 3, fr = lane & 15, fq = lane >> 4;
    const int K = g.K, nt = K / BK;
    unsigned voffA[2], voffB[2];
#define PG8_VOFF(t_) do { _Pragma("unroll") for (int i = 0; i < 2; ++i) { int R, C; stage_rc((t_) * 16 + i * 8192, R, C); const int Rb = Epi::PERM ? ((R & ~31) + perm32(R & 31)) : R; \
        const int Ra = Epi::APERM ? ((R & ~63) + ((R & 15) * 4 + ((R >> 4) & 3))) : R; voffA[i] = (unsigned)(Ra * g.lda + C) * 2u; voffB[i] = (unsigned)(Rb * g.ldb + C) * 2u; } } while (0)
    PG8_VOFF(tid);
    const size_t kstep = (size_t)(BK * 2);
    const size_t hstepA = (size_t)HALF * g.lda * 2, hstepB = (size_t)HALF * g.ldb * 2;
    const size_t tstepA = 2 * hstepA, tstepB = 2 * hstepB;
    const unsigned ldsw = (unsigned)wid * 1024u;
    const int aoff = lds_byte(wr * 64 + fr, fq * 8), boff = lds_byte(wc * 32 + fr, fq * 8);
#define PG8_SA(b, h) (((b) * 2 + (h)) * HTB)
#define PG8_SB(b, h) ((4 + (b) * 2 + (h)) * HTB)
#define PG8_STAGE(bufoff, gbase, voff) do { _Pragma("unroll") for (int _i = 0; _i < 2; ++_i) \
        __builtin_amdgcn_global_load_lds((const unsigned*)((const char*)(gbase) + (voff)[_i]), (PG8_LAS unsigned*)(lds + (bufoff) + ldsw + _i * 8192), 16, 0, 0); } while (0)
#define PG8_LDA(dst, b, h) do { _Pragma("unroll") for (int m = 0; m < 4; ++m) _Pragma("unroll") for (int k = 0; k < 2; ++k) dst[m][k] = *(const PG8_LAS bf16x8*)(lds + PG8_SA(b, h) + aoff + m * 2048 + k * 1024); } while (0)
#define PG8_LDB(dst, b, h) do { _Pragma("unroll") for (int n = 0; n < 2; ++n) _Pragma("unroll") for (int k = 0; k < 2; ++k) dst[n][k] = *(const PG8_LAS bf16x8*)(lds + PG8_SB(b, h) + boff + n * 2048 + k * 1024); } while (0)
#define PG8_MMA(ai, bj, At, Bt) do { __builtin_amdgcn_s_setprio(1); _Pragma("unroll") for (int m = 0; m < 4; ++m) _Pragma("unroll") for (int n = 0; n < 2; ++n) _Pragma("unroll") for (int k = 0; k < 2; ++k) \
        acc[ai][bj][m][n] = __builtin_amdgcn_mfma_f32_16x16x32_bf16(Bt[n][k], At[m][k], acc[ai][bj][m][n], 0, 0, 0); __builtin_amdgcn_s_setprio(0); } while (0)
#define PG8_WAIT_V(n) asm volatile("s_waitcnt vmcnt(" #n ")" ::: "memory")
#define PG8_WAIT_L(n) asm volatile("s_waitcnt lgkmcnt(" #n ")" ::: "memory")
#define PG8_BAR __builtin_amdgcn_s_barrier()
#define PG8_SCHED __builtin_amdgcn_sched_barrier(0)
    Unit cur, nxt; int ui = 0;
    if (!S.next(0, cur)) return;
    f32x4 acc[2][2][4][2];
#pragma unroll
    for (int a = 0; a < 2; ++a)
#pragma unroll
        for (int b = 0; b < 2; ++b)
#pragma unroll
            for (int m = 0; m < 4; ++m)
#pragma unroll
                for (int n = 0; n < 2; ++n) acc[a][b][m][n] = (f32x4){0.f, 0.f, 0.f, 0.f};
    bf16x8 At[4][2], B0[2][2], B1[2][2];
    const char* cA = (const char*)g.A + (size_t)cur.pm * tstepA; const char* cB = (const char*)g.Bt + (size_t)cur.pn * tstepB;
    S.a_ready(cur);
    if constexpr (SP2) {
        PG8_STAGE(PG8_SB(0, 0), cB, voffB); PG8_STAGE(PG8_SB(0, 1), cB + hstepB, voffB); PG8_STAGE(PG8_SA(0, 0), cA, voffA); PG8_STAGE(PG8_SA(0, 1), cA + hstepA, voffA);
        if (wr == 1) PG8_BAR;
        PG8_WAIT_V(2); PG8_BAR;
        PG8_STAGE(PG8_SB(1, 0), cB + kstep, voffB); PG8_STAGE(PG8_SA(1, 0), cA + kstep, voffA); PG8_STAGE(PG8_SB(1, 1), cB + hstepB + kstep, voffB);
        PG8_WAIT_V(6); PG8_BAR;
    } else {
        PG8_STAGE(PG8_SB(0, 0), cB, voffB); PG8_STAGE(PG8_SA(0, 0), cA, voffA); PG8_STAGE(PG8_SB(0, 1), cB + hstepB, voffB); PG8_STAGE(PG8_SA(0, 1), cA + hstepA, voffA);
        if (wr == 1) PG8_BAR;
        PG8_WAIT_V(4); PG8_BAR;
        PG8_STAGE(PG8_SB(1, 0), cB + kstep, voffB); PG8_STAGE(PG8_SA(1, 0), cA + kstep, voffA); PG8_STAGE(PG8_SB(1, 1), cB + hstepB + kstep, voffB);
        PG8_WAIT_V(6); PG8_BAR;
    }
    for (;;) {
        const bool has_next = S.next(ui + 1, nxt);
        const char* nA = has_next ? (const char*)g.A + (size_t)nxt.pm * tstepA : cA; const char* nB = has_next ? (const char*)g.Bt + (size_t)nxt.pn * tstepB : cB;
        for (int t = 0; t < nt; t += 2) {
            if constexpr (Epi::KHOOK) E.khook(acc, cur, t, wr, wc, fr, fq);
            const bool last = (t == nt - 2);
            if constexpr (Epi::KSTATE) { if (last) E.kpre(cur, wr, wc, fr, fq); }
            const char* a1 = cA + (size_t)(t + 1) * kstep;
            const char* a2 = last ? nA : cA + (size_t)(t + 2) * kstep; const char* b2 = last ? nB : cB + (size_t)(t + 2) * kstep;
            const char* a3 = a2 + kstep; const char* b3 = b2 + kstep;
            if (last && has_next) S.a_ready(nxt);
            if constexpr (SP2) {
            PG8_LDB(B0, 0, 0); PG8_LDB(B1, 0, 1); PG8_SCHED; PG8_LDA(At, 0, 0); PG8_STAGE(PG8_SA(1, 1), a1 + hstepA, voffA);
            PG8_WAIT_V(8); PG8_WAIT_L(0); PG8_BAR; PG8_MMA(0, 0, At, B0); PG8_MMA(0, 1, At, B1); PG8_BAR; PG8_SCHED;
            PG8_LDA(At, 0, 1); PG8_STAGE(PG8_SB(0, 0), b2, voffB); PG8_STAGE(PG8_SB(0, 1), b2 + hstepB, voffB); PG8_STAGE(PG8_SA(0, 0), a2, voffA);
            PG8_WAIT_V(8); PG8_WAIT_L(0); PG8_BAR; PG8_MMA(1, 0, At, B0); PG8_MMA(1, 1, At, B1); PG8_BAR; PG8_SCHED;
            PG8_LDB(B0, 1, 0); PG8_LDB(B1, 1, 1); PG8_SCHED; PG8_LDA(At, 1, 0); PG8_STAGE(PG8_SA(0, 1), a2 + hstepA, voffA);
            PG8_WAIT_V(8); PG8_WAIT_L(0); PG8_BAR; PG8_MMA(0, 0, At, B0); PG8_MMA(0, 1, At, B1); PG8_BAR; PG8_SCHED;
            PG8_LDA(At, 1, 1); PG8_STAGE(PG8_SB(1, 0), b3, voffB); PG8_STAGE(PG8_SB(1, 1), b3 + hstepB, voffB); PG8_STAGE(PG8_SA(1, 0), a3, voffA);
            PG8_WAIT_V(8); PG8_WAIT_L(0); PG8_BAR; PG8_MMA(1, 0, At, B0); PG8_MMA(1, 1, At, B1); PG8_BAR; PG8_SCHED;
            } else {
            PG8_LDB(B0, 0, 0); PG8_SCHED; PG8_LDA(At, 0, 0); PG8_STAGE(PG8_SA(1, 1), a1 + hstepA, voffA);
            PG8_WAIT_L(8); PG8_BAR; PG8_WAIT_L(0); PG8_MMA(0, 0, At, B0); PG8_BAR; PG8_SCHED;
            PG8_LDB(B1, 0, 1); PG8_STAGE(PG8_SB(0, 0), b2, voffB);
            PG8_BAR; PG8_WAIT_L(0); PG8_MMA(0, 1, At, B1); PG8_BAR;
            PG8_LDA(At, 0, 1); PG8_STAGE(PG8_SA(0, 0), a2, voffA);
            PG8_BAR; PG8_WAIT_L(0); PG8_MMA(1, 0, At, B0); PG8_BAR; PG8_SCHED;
            PG8_STAGE(PG8_SB(0, 1), b2 + hstepB, voffB);
            PG8_WAIT_V(6); PG8_BAR; PG8_MMA(1, 1, At, B1); PG8_BAR;
            PG8_LDB(B0, 1, 0); PG8_SCHED; PG8_LDA(At, 1, 0); PG8_STAGE(PG8_SA(0, 1), a2 + hstepA, voffA);
            PG8_WAIT_L(8); PG8_BAR; PG8_WAIT_L(0); PG8_MMA(0, 0, At, B0); PG8_BAR; PG8_SCHED;
            PG8_LDB(B1, 1, 1); PG8_STAGE(PG8_SB(1, 0), b3, voffB);
            PG8_BAR; PG8_WAIT_L(0); PG8_MMA(0, 1, At, B1); PG8_BAR;
            PG8_LDA(At, 1, 1); PG8_STAGE(PG8_SA(1, 0), a3, voffA);
            PG8_BAR; PG8_WAIT_L(0); PG8_MMA(1, 0, At, B0); PG8_BAR; PG8_SCHED;
            PG8_STAGE(PG8_SB(1, 1), b3 + hstepB, voffB);
            PG8_WAIT_V(6); PG8_BAR; PG8_MMA(1, 1, At, B1); PG8_BAR;
            }
        }
#if PROBE_G
        unsigned long long gt0_ = 0, gacc_ = 0; if constexpr ((PROBE_G >> Epi::PID) & 1) gt0_ = __builtin_amdgcn_s_memrealtime();
#define PG_SEG(k) if constexpr ((PROBE_G >> Epi::PID) & 1) { const unsigned long long tt_ = __builtin_amdgcn_s_memrealtime(); if (PROBE_GS == 0 || PROBE_GS == (k)) gacc_ += tt_ - gt0_; gt0_ = tt_; }
#else
#define PG_SEG(k)
#endif
        if constexpr (ALIGN_EPI) { if (wr == 0) PG8_BAR; }
        PG_SEG(1);
        if constexpr (!Epi::AFTER_DRAIN) { E(acc, cur, wr, wc, fr, fq); S.done(cur); }
        PG_SEG(2);
        if (!has_next) break;
#pragma unroll
        for (int a = 0; a < 2; ++a)
#pragma unroll
            for (int b = 0; b < 2; ++b)
#pragma unroll
                for (int m = 0; m < 4; ++m)
#pragma unroll
                    for (int n = 0; n < 2; ++n) acc[a][b][m][n] = (f32x4){0.f, 0.f, 0.f, 0.f};
        cur = nxt; cA = nA; cB = nB; ++ui;
        { int t2_ = tid; asm volatile("" : "+v"(t2_)); PG8_VOFF(t2_); }
        if constexpr (ALIGN_EPI) { if (wr == 1) PG8_BAR; }
        PG_SEG(3);
#if PROBE_G
        if constexpr ((PROBE_G >> Epi::PID) & 1) { const unsigned long long t1_ = __builtin_amdgcn_s_memrealtime(), d_ = gacc_ * 2; while (__builtin_amdgcn_s_memrealtime() - t1_ < d_) __builtin_amdgcn_s_sleep(4); }
#endif
#undef PG_SEG
    }
    PG8_WAIT_V(0);
    if constexpr (!ALIGN_EPI) { if (wr == 0) PG8_BAR; }
    PG8_BAR;
    if constexpr (Epi::AFTER_DRAIN) { E.fused(acc, cur, wr, wc, fr, fq, lds, wid, lane); S.done(cur); }
#undef PG8_VOFF
#undef PG8_SA
#undef PG8_SB
#undef PG8_STAGE
#undef PG8_LDA
#undef PG8_LDB
#undef PG8_MMA
#undef PG8_WAIT_V
#undef PG8_WAIT_L
#undef PG8_BAR
#undef PG8_SCHED
}
}
namespace att {
constexpr int D = 128, NW = 8, QBLK = 32, KVBLK = 64;
constexpr float SCALE = 0.088388347648318440f;
constexpr float THR = 8.f;
constexpr size_t SHM_V = KVBLK * D * 2, SHM_K = KVBLK * D * 2, SHM_ATTN = 2 * SHM_V + 2 * SHM_K + NW * 64 * 4;
constexpr size_t SHM_RPB = SHM_ATTN;
#define KSWZ(row, colB) ((row) * 256 + ((colB) ^ (((row) & 7) << 4)))
#define SBAR() __builtin_amdgcn_sched_barrier(0)
DI int crow(int r, int hi) { return (r & 3) + 8 * (r >> 2) + 4 * hi; }
DI unsigned cvtpk(float lo, float hi) { unsigned r; asm volatile("v_cvt_pk_bf16_f32 %0, %1, %2" : "=v"(r) : "v"(lo), "v"(hi)); return r; }

struct NaCtx { int jlo; int dr0; int cq; int cs; const float* rpb; };

template <bool NA> DI void mask_bias(f32x16& p0, f32x16& p1, int j, const NaCtx& c, int hi) {
  if constexpr (NA) {
    const bool tv = (unsigned)(j - c.jlo) < 8u;
    int ri = c.dr0 + j + 7; ri = ri < 0 ? 0 : (ri > 14 ? 14 : ri);
    int boff = ri * 32 + 15 - c.cq + 4 * hi, t = 4 * hi - c.cs;
    asm volatile("" : "+v"(boff), "+v"(t));
    const float* bp = c.rpb + boff;
#pragma unroll
    for (int q4 = 0; q4 < 4; ++q4) {
#pragma unroll
      for (int rr = 0; rr < 4; ++rr) { const int r = 4 * q4 + rr;
        const int k0 = (r & 3) + 8 * (r >> 2);
        const bool ok0 = tv && ((unsigned)(t + k0) < 16u), ok1 = tv && ((unsigned)(t + k0 + 32) < 16u);
        const float b0 = bp[k0], b1 = bp[k0 + 32];
        p0[r] = ok0 ? p0[r] + b0 : -INFINITY; p1[r] = ok1 ? p1[r] + b1 : -INFINITY; }
      __builtin_amdgcn_sched_barrier(0);
    }
  }
}
DI void partialSM(f32x16& p0, f32x16& p1, float& m_reg, float& mn, float& alpha) {
  constexpr float C = SCALE * 1.4426950408889634f;
  float pmax = p0[0];
#pragma unroll
  for (int r = 1; r < 16; ++r) pmax = fmaxf(pmax, p0[r]);
#pragma unroll
  for (int r = 0; r < 16; ++r) pmax = fmaxf(pmax, p1[r]);
  { auto rr = __builtin_amdgcn_permlane32_swap(__float_as_uint(pmax), __float_as_uint(pmax), false, false);
    pmax = fmaxf(__uint_as_float(rr[0]), __uint_as_float(rr[1])); }
  if (__builtin_expect(__all(pmax - m_reg <= THR / SCALE), 1)) { mn = m_reg; alpha = 1.f; }
  else { mn = fmaxf(m_reg, pmax); alpha = __builtin_amdgcn_exp2f((m_reg - mn) * C); m_reg = mn; }
  float mnC = -mn * C;
#pragma unroll
  for (int r = 0; r < 16; ++r) p0[r] = fmaf(p0[r], C, mnC);
#pragma unroll
  for (int r = 0; r < 16; ++r) p1[r] = fmaf(p1[r], C, mnC);
#pragma unroll
  for (int r = 0; r < 16; ++r) p0[r] = __builtin_amdgcn_exp2f(p0[r]);
}
DI void finishSM(f32x16& p0, f32x16& p1, float alpha, float& l_reg, bf16x8& pa0, bf16x8& pa1, bf16x8& pa2, bf16x8& pa3) {
#pragma unroll
  for (int r = 0; r < 16; ++r) p1[r] = __builtin_amdgcn_exp2f(p1[r]);
  float ps = 0;
#pragma unroll
  for (int r = 0; r < 16; ++r) ps += p0[r];
#pragma unroll
  for (int r = 0; r < 16; ++r) ps += p1[r];
  { auto rr = __builtin_amdgcn_permlane32_swap(__float_as_uint(ps), __float_as_uint(ps), false, false);
    ps = __uint_as_float(rr[0]) + __uint_as_float(rr[1]); }
  l_reg = l_reg * alpha + ps;
#define PK4(P, BASE, OUT) do { unsigned a0 = cvtpk(P[BASE + 0], P[BASE + 1]), a1 = cvtpk(P[BASE + 2], P[BASE + 3]);   \
    unsigned b0 = cvtpk(P[BASE + 4], P[BASE + 5]), b1 = cvtpk(P[BASE + 6], P[BASE + 7]);                              \
    auto r0 = __builtin_amdgcn_permlane32_swap(a0, b0, false, false); auto r1 = __builtin_amdgcn_permlane32_swap(a1, b1, false, false); \
    v4u w = {r0[0], r1[0], r0[1], r1[1]}; OUT = *reinterpret_cast<bf16x8*>(&w); } while (0)
  PK4(p0, 0, pa0); PK4(p0, 8, pa1); PK4(p1, 0, pa2); PK4(p1, 8, pa3);
#undef PK4
}
DI void qkt(f32x16& p0, f32x16& p1, const bf16* Ks, const bf16x8* qr, int r32, int hi) {
  p0 = f32x16{}; p1 = f32x16{};
#pragma unroll
  for (int d0 = 0; d0 < 8; ++d0) { int cb = (d0 * 16 + hi * 8) * 2;
    bf16x8 b0 = *reinterpret_cast<const bf16x8*>((const char*)Ks + KSWZ(r32, cb));
    bf16x8 b1 = *reinterpret_cast<const bf16x8*>((const char*)Ks + KSWZ(32 + r32, cb));
    p0 = __builtin_amdgcn_mfma_f32_32x32x16_bf16(b0, qr[d0], p0, 0, 0, 0);
    p1 = __builtin_amdgcn_mfma_f32_32x32x16_bf16(b1, qr[d0], p1, 0, 0, 0); }
}
DI int v_st(int k, int c) { const int kk = (k & ~0xC) | ((k & 4) << 1) | ((k & 8) >> 1); return ((kk >> 3) * 4 + (c >> 5)) * 512 + ((kk & 7) * 32 + (c & 31)) * 2; }
DI int v_rd_base(int lane) { return ((lane & 3) << 3) | (((lane >> 2) & 3) << 6) | (((lane >> 4) & 1) << 5) | (((lane >> 5) & 1) << 8); }
constexpr int v_rd_off(int d0, int ks, int half) { return d0 * 512 + ks * 4096 + half * 2048; }
template <int OFF> DI s16x4 tr_read(int vb) { s16x4 r; asm volatile("ds_read_b64_tr_b16 %0, %1 offset:%2" : "=&v"(r) : "v"(vb), "i"(OFF) : "memory"); return r; }
template <int D0> DI void pv_one(f32x16& od, int vb, bf16x8 pa0, bf16x8 pa1, bf16x8 pa2, bf16x8 pa3) {
  const s16x4 l0 = tr_read<v_rd_off(D0, 0, 0)>(vb), h0 = tr_read<v_rd_off(D0, 0, 1)>(vb), l1 = tr_read<v_rd_off(D0, 1, 0)>(vb), h1 = tr_read<v_rd_off(D0, 1, 1)>(vb);
  const s16x4 l2 = tr_read<v_rd_off(D0, 2, 0)>(vb), h2 = tr_read<v_rd_off(D0, 2, 1)>(vb), l3 = tr_read<v_rd_off(D0, 3, 0)>(vb), h3 = tr_read<v_rd_off(D0, 3, 1)>(vb);
  asm volatile("s_waitcnt lgkmcnt(0)" ::: "memory"); SBAR();
#define PK(L, H) (bf16x8){L[0], L[1], L[2], L[3], H[0], H[1], H[2], H[3]}
  od = __builtin_amdgcn_mfma_f32_32x32x16_bf16(pa0, PK(l0, h0), od, 0, 0, 0);
  od = __builtin_amdgcn_mfma_f32_32x32x16_bf16(pa1, PK(l1, h1), od, 0, 0, 0);
  od = __builtin_amdgcn_mfma_f32_32x32x16_bf16(pa2, PK(l2, h2), od, 0, 0, 0);
  od = __builtin_amdgcn_mfma_f32_32x32x16_bf16(pa3, PK(l3, h3), od, 0, 0, 0);
#undef PK
}
DI void pv_d0(f32x16* o, int vb, bf16x8 pa0, bf16x8 pa1, bf16x8 pa2, bf16x8 pa3) {
  pv_one<0>(o[0], vb, pa0, pa1, pa2, pa3); pv_one<1>(o[1], vb, pa0, pa1, pa2, pa3); pv_one<2>(o[2], vb, pa0, pa1, pa2, pa3); pv_one<3>(o[3], vb, pa0, pa1, pa2, pa3);
}
template <int LDQ, int LDK, int LDO, bool NA, int SDEPTH>
DI void attn_body(const bf16* __restrict__ Qb, const bf16* __restrict__ Kh, const bf16* __restrict__ Vh, bf16* __restrict__ Ob, int NT, char* lds, const NaCtx& nc, int wave_) {
  const int tid_ = tid_of(wave_);
  const int tid = tid_, wid = tid >> 6, lane = tid & 63, r32 = lane & 31, hi = lane >> 5;
  bf16* V_lds = (bf16*)lds; bf16* K_lds = (bf16*)(lds + 2 * SHM_V);
  float* ws = (float*)(lds + 2 * SHM_V + 2 * SHM_K) + wid * 64; float* li_l = ws; float* al_l = ws + 32;
  float m_reg = -1e30f, l_reg = 0; f32x16 o[4] = {}; bf16x8 qr[8];
  const bf16* Qw = Qb + (long)(wid * QBLK + r32) * LDQ + hi * 8;
#pragma unroll
  for (int d0 = 0; d0 < 8; ++d0) qr[d0] = *reinterpret_cast<const bf16x8*>(Qw + d0 * 16);
  const int sr = tid >> 4, sc = (tid & 15) * 8, vst0 = v_st(sr, sc), vst1 = v_st(32 + sr, sc);
  const int vb0 = (int)(uintptr_t)V_lds + v_rd_base(lane);
  struct { bf16x8 vs0, vs1, ks0, ks1; } sr_[SDEPTH];
#define SLOAD(i, k0) do { sr_[i].vs0 = *reinterpret_cast<const bf16x8*>(&Vh[(long)((k0) + sr) * LDK + sc]); sr_[i].vs1 = *reinterpret_cast<const bf16x8*>(&Vh[(long)((k0) + 32 + sr) * LDK + sc]); \
    sr_[i].ks0 = *reinterpret_cast<const bf16x8*>(&Kh[(long)((k0) + sr) * LDK + sc]); sr_[i].ks1 = *reinterpret_cast<const bf16x8*>(&Kh[(long)((k0) + 32 + sr) * LDK + sc]); } while (0)
#define SWRITE(b, i) do { *(bf16x8*)((char*)V_lds + (b) * SHM_V + vst0) = sr_[i].vs0;          \
    *(bf16x8*)((char*)V_lds + (b) * SHM_V + vst1) = sr_[i].vs1; int kc = sc * 2;               \
    *(bf16x8*)((char*)K_lds + (b) * SHM_K + KSWZ(sr, kc)) = sr_[i].ks0;                       \
    *(bf16x8*)((char*)K_lds + (b) * SHM_K + KSWZ(32 + sr, kc)) = sr_[i].ks1; } while (0)
#define SWAIT() do { if constexpr (SDEPTH == 2) asm volatile("s_waitcnt vmcnt(4)" ::: "memory"); else asm volatile("s_waitcnt vmcnt(0)" ::: "memory"); } while (0)
#define RESC(a) do { if (__any((a) < 1.f)) { if (hi == 0) al_l[r32] = (a); asm volatile("s_waitcnt lgkmcnt(0)" ::: "memory"); \
    _Pragma("unroll") for (int d = 0; d < 4; ++d) _Pragma("unroll") for (int r = 0; r < 16; ++r) o[d][r] *= al_l[crow(r, hi)]; } } while (0)
  f32x16 pA0, pA1, pB0, pB1; float mnA, mnB, alA, alB; bf16x8 pa0, pa1, pa2, pa3;
  constexpr int SE = 0, SO = SDEPTH - 1;
  SLOAD(SE, 0); asm volatile("s_waitcnt vmcnt(0)" ::: "memory"); SWRITE(0, SE); __syncthreads();
#define ACT(jj) (!NA || (unsigned)((jj) - nc.jlo) < 8u)
  if (ACT(0)) { qkt(pA0, pA1, K_lds, qr, r32, hi); mask_bias<NA>(pA0, pA1, 0, nc, hi); partialSM(pA0, pA1, m_reg, mnA, alA); } else { alA = 1.f; }
  SLOAD(SO, KVBLK); if constexpr (SDEPTH == 2) { if (2 < NT) SLOAD(SE, 2 * KVBLK); }
  SWAIT(); SWRITE(1, SO); __syncthreads();
  if (wave_ >= 4) __builtin_amdgcn_s_setprio(1);
  for (int j = 1; j + 1 < NT; j += 2) {
    SBAR(); if (ACT(j)) { qkt(pB0, pB1, (bf16*)((char*)K_lds + SHM_K), qr, r32, hi); mask_bias<NA>(pB0, pB1, j, nc, hi); }
    if (ACT(j - 1)) finishSM(pA0, pA1, alA, l_reg, pa0, pa1, pa2, pa3); SBAR();
    SLOAD(SO, (j + SDEPTH) * KVBLK); SBAR();
    if (ACT(j - 1)) pv_d0(o, vb0, pa0, pa1, pa2, pa3);
    if (ACT(j)) partialSM(pB0, pB1, m_reg, mnB, alB); else alB = 1.f;
    __syncthreads(); SWAIT(); SWRITE(0, SE);
    RESC(alB); __syncthreads();
    SBAR(); if (ACT(j + 1)) { qkt(pA0, pA1, K_lds, qr, r32, hi); mask_bias<NA>(pA0, pA1, j + 1, nc, hi); }
    if (ACT(j)) finishSM(pB0, pB1, alB, l_reg, pa0, pa1, pa2, pa3); SBAR();
    if (SDEPTH == 1 || j + 3 < NT) SLOAD(SE, (j + 1 + SDEPTH) * KVBLK); SBAR();
    if (ACT(j)) pv_d0(o, vb0 + (int)SHM_V, pa0, pa1, pa2, pa3);
    if (ACT(j + 1)) partialSM(pA0, pA1, m_reg, mnA, alA); else alA = 1.f;
    __syncthreads(); SWAIT(); SWRITE(1, SO);
    RESC(alA); __syncthreads();
  }
  SBAR(); if (ACT(NT - 1)) { qkt(pB0, pB1, (bf16*)((char*)K_lds + SHM_K), qr, r32, hi); mask_bias<NA>(pB0, pB1, NT - 1, nc, hi); }
  if (ACT(NT - 2)) finishSM(pA0, pA1, alA, l_reg, pa0, pa1, pa2, pa3); SBAR();
  if (ACT(NT - 2)) pv_d0(o, vb0, pa0, pa1, pa2, pa3);
  if (ACT(NT - 1)) partialSM(pB0, pB1, m_reg, mnB, alB); else alB = 1.f;
  __syncthreads(); RESC(alB);
  if (ACT(NT - 1)) { finishSM(pB0, pB1, alB, l_reg, pa0, pa1, pa2, pa3); SBAR();
    pv_d0(o, vb0 + (int)SHM_V, pa0, pa1, pa2, pa3); }
#undef ACT
  __builtin_amdgcn_s_setprio(0);
  if (hi == 0) li_l[r32] = l_reg; asm volatile("s_waitcnt lgkmcnt(0)" ::: "memory");
  float rli[16];
#pragma unroll
  for (int r = 0; r < 16; ++r) rli[r] = __builtin_amdgcn_rcpf(li_l[crow(r, hi)]);
  bf16* Ow = Ob + (long)(wid * QBLK) * LDO;
#pragma unroll
  for (int r = 0; r < 16; ++r) { int orow = crow(r, hi);
#pragma unroll
    for (int d0 = 0; d0 < 4; ++d0) Ow[(long)orow * LDO + d0 * 32 + r32] = f2bf(o[d0][r] * rli[r]); }
  __syncthreads();
#undef SLOAD
#undef SWRITE
#undef SWAIT
#undef RESC
}
#undef KSWZ
#undef SBAR
}
#define XB_TMO      128
#define XB_XCNT(j)  (256  + 64 * (j))
#define XB_XSUB(j)  (1280 + 64 * (j))
#define XB_XGEN(j)  (2304 + 64 * (j))
#define XB_TOP      3328
#define XB_TOPGEN   3392
#define XCD_BAR_WORDS 3456
#define XB_SPIN_CAP (1u << 18)

__device__ __forceinline__ unsigned xb_ld(unsigned* p)              { return __hip_atomic_load(p, __ATOMIC_RELAXED, __HIP_MEMORY_SCOPE_AGENT); }
__device__ __forceinline__ unsigned xb_add(unsigned* p, unsigned v) { return __hip_atomic_fetch_add(p, v, __ATOMIC_RELAXED, __HIP_MEMORY_SCOPE_AGENT); }
__device__ __forceinline__ unsigned xb_xcc_id() { return (unsigned)__builtin_amdgcn_s_getreg((3 << 11) | 20) & 0xFu; }
#define XB_SPIN(cond, bar) do { unsigned _sp = 0; while (cond) { __builtin_amdgcn_s_sleep(1); \
    if ((++_sp & 255u) == 0u) { if (xb_ld(&(bar)[XB_TMO])) break; if (_sp > XB_SPIN_CAP) { atomicAdd(&(bar)[XB_TMO], 1u); break; } } } } while (0)

struct XcdBarrier {
    unsigned* bar; unsigned x; int wave;
    volatile LAS unsigned* st;
};

__device__ __forceinline__ XcdBarrier xcd_barrier_post(unsigned* bar, volatile LAS unsigned* st, int wave) {
    XcdBarrier b; b.bar = bar; b.x = xb_xcc_id(); b.st = st; b.wave = wave;
    if (wave == 0 && lane_id() == 0) (void)xb_add(&bar[XB_XCNT(b.x)], 1u);
    return b;
}
__device__ __forceinline__ void xcd_barrier_complete(unsigned* bar, unsigned x, unsigned& nloc, unsigned& nx) {
    const unsigned G = gridDim.x * gridDim.y * gridDim.z;
    unsigned sum, cnt, mine, sp = 0u;
    for (;;) {
        sum = 0u; cnt = 0u; mine = 0u;
#pragma unroll
        for (unsigned j = 0; j < 16; ++j) { const unsigned c = xb_ld(&bar[XB_XCNT(j)]); sum += c; cnt += (c > 0u) ? 1u : 0u; mine = (j == x) ? c : mine; }
        if (sum == G) break;
        __builtin_amdgcn_s_sleep(1);
        if ((++sp & 255u) == 0u) { if (xb_ld(&bar[XB_TMO])) break; if (sp > XB_SPIN_CAP) { atomicAdd(&bar[XB_TMO], 1u); break; } }
    }
    nloc = mine > 0u ? mine : 1u; nx = cnt > 0u ? cnt : 1u;
}

__device__ __forceinline__ void xcd_barrier(const XcdBarrier& b) {
    asm volatile("s_waitcnt vmcnt(0)" ::: "memory");
    __syncthreads();
    if (b.wave == 0 && tid_of(0) == 0) {
        unsigned* bar = b.bar;
        __builtin_amdgcn_s_waitcnt(0);
        unsigned nloc = b.st[0], nx = b.st[1];
        if (nloc == 0u) { xcd_barrier_complete(bar, b.x, nloc, nx); b.st[0] = nloc; b.st[1] = nx; }
        const unsigned old = xb_add(&bar[XB_XSUB(b.x)], 1u);
        const unsigned gen = old / nloc;
        if (old + 1u == (gen + 1u) * nloc) {
            __builtin_amdgcn_fence(__ATOMIC_RELEASE, "agent");
            asm volatile("s_waitcnt vmcnt(0)" ::: "memory");
            const unsigned og = xb_add(&bar[XB_TOP], 1u);
            const unsigned tg = og / nx;
            if (og + 1u == (tg + 1u) * nx) xb_add(&bar[XB_TOPGEN], 1u);
            else XB_SPIN(xb_ld(&bar[XB_TOPGEN]) == tg, bar);
            __builtin_amdgcn_fence(__ATOMIC_ACQUIRE, "agent");
            xb_add(&bar[XB_XGEN(b.x)], 1u);
            asm volatile("s_waitcnt vmcnt(0)" ::: "memory");
        } else {
            XB_SPIN(xb_ld(&bar[XB_XGEN(b.x)]) == gen, bar);
            __builtin_amdgcn_fence(__ATOMIC_ACQUIRE, "agent");
            asm volatile("s_waitcnt vmcnt(0)" ::: "memory");
        }
    }
    __syncthreads();
}
struct Ctx { int tid, lane, wave, G, blk; int gw, ngw; };

DI void tr_item(const float* __restrict__ W, int ldw, int K, bf16* __restrict__ WT, int k0, int n0, int drow0, const float* __restrict__ nw, LAS float* scr, int lane) {
    float tv[32];
#pragma unroll
    for (int i = 0; i < 32; ++i) tv[i] = W[(size_t)(k0 + 2 * i + (lane >> 5)) * ldw + n0 + (lane & 31)];
    if (nw) {
#pragma unroll
        for (int i = 0; i < 32; ++i) tv[i] *= nw[k0 + 2 * i + (lane >> 5)]; }
#pragma unroll
    for (int i = 0; i < 32; ++i) scr[(2 * i + (lane >> 5)) * 33 + (lane & 31)] = tv[i];
    LDS_WAIT(); asm volatile("" ::: "memory");
    const int c = lane & 7;
#pragma unroll
    for (int j = 0; j < 4; ++j) { const int n = (lane >> 3) + 8 * j; const LAS float* s = scr + (8 * c) * 33 + n;
        v4u o; o.x = pk2(s[0 * 33], s[1 * 33]); o.y = pk2(s[2 * 33], s[3 * 33]); o.z = pk2(s[4 * 33], s[5 * 33]); o.w = pk2(s[6 * 33], s[7 * 33]);
        *(v4u*)(WT + (size_t)(drow0 + n) * K + k0 + 8 * c) = o; }
    LDS_WAIT(); asm volatile("" ::: "memory");
}
struct WPtrs { const float *w_in, *w_br, *w_out, *w_up, *w_dn, *n1, *n2, *nssd; bf16 *t_in, *t_br, *t_out, *t_up, *t_dn; const float *cw, *cb; float* t_cw; };
DI void convert_weights(const Ctx& F, const WPtrs& P, LAS unsigned char* lds) {
    LAS float* scr = (LAS float*)(lds + F.wave * 8704);
    constexpr int I_IN = 32 * (NIN / 32), I_BR = 32 * 64, I_OUT = 32 * 64, I_UP = 32 * (NUP / 32), I_DN = (DFF / 64) * 64;
    constexpr int NITEMS = I_IN + I_BR + I_OUT + I_UP + I_DN;
    for (int it = F.gw; it < NITEMS; it += F.ngw) {
        int r = it;
        if (r < I_IN) { const int nblk = NIN / 32, kb = r / nblk, nb = r % nblk, n0 = nb * 32; tr_item(P.w_in, NIN, DM, P.t_in, kb * 64, n0, n0 < GATE_SRC0 ? n0 : n0 + (GATE_DST0 - GATE_SRC0), P.n1, scr, F.lane); continue; } r -= I_IN;
        if (r < I_BR) { const int kb = r / 64, nb = r % 64; tr_item(P.w_br, DM, DM, P.t_br, kb * 64, nb * 32, nb * 32, (kb >= 8 && kb < 24) ? P.nssd - 512 : nullptr, scr, F.lane); continue; } r -= I_BR;
        if (r < I_OUT) { const int kb = r / 64, nb = r % 64; tr_item(P.w_out, DM, DM, P.t_out, kb * 64, nb * 32, nb * 32, nullptr, scr, F.lane); continue; } r -= I_OUT;
        if (r < I_UP) { const int nblk = NUP / 32, kb = r / nblk, nb = r % nblk, n0 = nb * 32, isv = n0 >= DFF, nn = n0 - isv * DFF;
            tr_item(P.w_up, NUP, DM, P.t_up, kb * 64, n0, 256 * (nn >> 7) + 128 * isv + (nn & 127), P.n2, scr, F.lane); continue; } r -= I_UP;
        { const int kb = r / 64, nb = r % 64; tr_item(P.w_dn, DM, DFF, P.t_dn, kb * 64, nb * 32, nb * 32, nullptr, scr, F.lane); }
    }
    for (int i = F.gw * 64 + F.lane; i < 4 * DFF; i += F.ngw * 64) { const int blk = i >> 7, arr = (i >> 5) & 3, c = blk * 32 + (i & 31); P.t_cw[i] = arr < 3 ? P.cw[arr * DFF + c] : P.cb[c]; }
}
DI void xw_init(const Ctx& F, const float* __restrict__ xp, const float* __restrict__ xs, bf16* __restrict__ xw, float* __restrict__ rstd) {
    for (int m0 = 2 * F.gw; m0 < MTOT; m0 += 2 * F.ngw) {
        float s[2];
#pragma unroll
        for (int q = 0; q < 2; ++q) { const int m = m0 + q; const f32x4* xr = (const f32x4*)(m < LP ? xp + (size_t)m * DM : xs + (size_t)(m - LP) * DM) + F.lane;
            v2u* o8 = (v2u*)(xw + (size_t)m * DM) + F.lane; s[q] = 0.f;
#pragma unroll
            for (int j = 0; j < 8; ++j) { const f32x4 v = xr[64 * j]; s[q] += (v.x * v.x + v.y * v.y) + (v.z * v.z + v.w * v.w); v2u o; o.x = pk2(v.x, v.y); o.y = pk2(v.z, v.w); o8[64 * j] = o; } }
#pragma unroll
        for (int q = 0; q < 2; ++q) { const float t = wave_sum(s[q]); if (F.lane == 0) rstd[m0 + q] = 1.f / sqrtf(t * (1.f / DM) + EPSN); }
    }
}
struct PrepPtrs { bf16 *qna, *kna, *gq, *gk; const float *nq_na, *nk_na, *nq_g, *nk_g; };
DI void prep_qk(const Ctx& F, const PrepPtrs& P, int grp) {
    const int sub = F.lane >> 4, j = F.lane & 15;
    const int a = j >> 3, b = (j >> 2) & 1, f0 = (j & 3) * 8;
    float wq_na[8], wk_na[8], wq_g[8], wk_g[8], invf[8];
#pragma unroll
    for (int e = 0; e < 8; ++e) { wq_na[e] = P.nq_na[j * 8 + e]; wk_na[e] = P.nk_na[j * 8 + e]; wq_g[e] = P.nq_g[j * 8 + e]; wk_g[e] = P.nk_g[j * 8 + e];
        invf[e] = exp2f(-(float)(f0 + e) * (13.287712379549449f / 32.f)); }
    for (int tok = F.gw * 4 + sub; tok < MG; tok += F.ngw * 4) {
        const int t = tok - seq_start(grp, tok); const float pos = (float)(a ? (t & 63) : (t >> 6));
        float cs[8], sn[8];
#pragma unroll
        for (int e = 0; e < 8; ++e) { float rev = pos * invf[e] * 0.15915494309189535f; rev -= floorf(rev); sn[e] = __builtin_amdgcn_sinf(rev); cs[e] = __builtin_amdgcn_cosf(rev); }
        v4u raw[14];
#pragma unroll
        for (int v = 0; v < 14; ++v) { const bf16* p = v < 4 ? P.qna + (size_t)tok * 512 + v * 128 : (v < 8 ? P.kna + (size_t)tok * 512 + (v - 4) * 128 : (v < 12 ? P.gq + (size_t)tok * 512 + (v - 8) * 128 : P.gk + (size_t)tok * 256 + (v - 12) * 128));
            raw[v] = *(const v4u*)(p + j * 8); }
#pragma unroll
        for (int v = 0; v < 14; ++v) {
            bf16* p; const float* w; bool rope;
            if (v < 4)       { p = P.qna + (size_t)tok * 512 + v * 128;        w = wq_na; rope = false; }
            else if (v < 8)  { p = P.kna + (size_t)tok * 512 + (v - 4) * 128;  w = wk_na; rope = false; }
            else if (v < 12) { p = P.gq + (size_t)tok * 512 + (v - 8) * 128;   w = wq_g;  rope = true; }
            else             { p = P.gk + (size_t)tok * 256 + (v - 12) * 128;  w = wk_g;  rope = true; }
            p += j * 8;
            float x[8]; unpack8(raw[v], x);
            float ss = 0.f;
#pragma unroll
            for (int e = 0; e < 8; ++e) ss += x[e] * x[e];
            ss += xor_lane<1>(ss); ss += xor_lane<2>(ss); ss += xor_lane<4>(ss); ss += xor_lane<8>(ss);
            const float rstd = 1.f / sqrtf(ss * (1.f / 128.f) + EPSN);
            float y[8];
#pragma unroll
            for (int e = 0; e < 8; ++e) y[e] = x[e] * rstd * w[e];
            if (rope) {
#pragma unroll
                for (int e = 0; e < 8; ++e) { const float pr = xor_lane<4>(y[e]); y[e] = b ? (pr * sn[e] + y[e] * cs[e]) : (y[e] * cs[e] - pr * sn[e]); }
            }
            *(v4u*)p = pack8(y);
        }
    }
}
DI void prep_xbc(const Ctx& F, const bf16* __restrict__ src, bf16* __restrict__ dst, const float* __restrict__ cw, const float* __restrict__ cb, int grp) {
    constexpr int NIT = (MG / 16) * 3;
    for (int it = F.gw; it < NIT; it += F.ngw) {
        const int tb = it / 3, cs = it % 3, c0 = cs * 512 + F.lane * 8, tok0 = tb * 16, slo = seq_start(grp, tok0), shi = slo + seq_len(grp, tok0);
        float w[5][8], bias[8];
#pragma unroll
        for (int i = 0; i < 5; ++i) { const f32x4 a = *(const f32x4*)(cw + i * 1536 + c0), bq = *(const f32x4*)(cw + i * 1536 + c0 + 4);
            w[i][0] = a.x; w[i][1] = a.y; w[i][2] = a.z; w[i][3] = a.w; w[i][4] = bq.x; w[i][5] = bq.y; w[i][6] = bq.z; w[i][7] = bq.w; }
        { const f32x4 a = *(const f32x4*)(cb + c0), bq = *(const f32x4*)(cb + c0 + 4); bias[0] = a.x; bias[1] = a.y; bias[2] = a.z; bias[3] = a.w; bias[4] = bq.x; bias[5] = bq.y; bias[6] = bq.z; bias[7] = bq.w; }
        v4u rw[20];
#pragma unroll
        for (int k = 0; k < 20; ++k) { const int t_ = tok0 - 2 + k; rw[k] = (t_ >= slo && t_ < shi) ? *(const v4u*)(src + (size_t)t_ * 1536 + c0) : (v4u){0u, 0u, 0u, 0u}; }
        float r[5][8];
        unpack8(rw[0], r[0]); unpack8(rw[1], r[1]); unpack8(rw[2], r[2]); unpack8(rw[3], r[3]);
#pragma unroll
        for (int k = 0; k < 16; ++k) {
            unpack8(rw[k + 4], r[4]);
            float y[8];
#pragma unroll
            for (int e = 0; e < 8; ++e) { float s = bias[e] + r[0][e] * w[0][e] + r[1][e] * w[1][e] + r[2][e] * w[2][e] + r[3][e] * w[3][e] + r[4][e] * w[4][e]; y[e] = siluf_(s); }
            *(v4u*)(dst + (size_t)(tok0 + k) * 1536 + c0) = pack8(y);
#pragma unroll
            for (int e = 0; e < 8; ++e) { r[0][e] = r[1][e]; r[1][e] = r[2][e]; r[2][e] = r[3][e]; r[3][e] = r[4][e]; }
        }
    }
}
DI void ffn_fix(const Ctx& F, const float* __restrict__ side, bf16* __restrict__ act, const float* __restrict__ cw) {
    constexpr int NB = MTOT / 256 - 1, NIT = NB * DFF;
    for (int it = F.blk * 512 + F.tid; it < NIT; it += F.G * 512) {
        const int pmb = it / DFF + 1, c = it % DFF;
        if (pmb * 256 >= LP && ((pmb * 256) & (LS - 1)) == 0) continue;
        const float* sb = side + (((size_t)(pmb - 1) * 2 + 1) * DFF + c) * 3; const float* st = side + (((size_t)pmb * 2 + 0) * DFF + c) * 3;
        const float s_bot = sb[0], v_bot = sb[1], a_bot = sb[2], s_top = st[0], v_top = st[1], a_top = st[2];
        act[(size_t)(pmb * 256 - 1) * DFF + c] = f2bf(siluf_(s_bot + cw[2 * DFF + c] * a_top) * v_bot);
        act[(size_t)(pmb * 256) * DFF + c] = f2bf(siluf_(s_top + cw[c] * a_bot) * v_top);
    }
}
namespace ssd {
constexpr int IMG = 32768;
DI unsigned off_b(unsigned row, unsigned ch) { return 256u * row + 16u * (ch ^ (((row & 3) << 2) | ((row >> 2) & 3))); }
DI bf16x8 row_read(const LAS unsigned char* img, unsigned lane, unsigned rowbase, unsigned s) {
    return *(const LAS bf16x8*)(img + off_b(rowbase + (lane & 31), 2 * s + (lane >> 5)));
}
DI s16x4 tr_read4(const LAS unsigned char* img, unsigned lane, unsigned r0, unsigned c) {
    const unsigned blk = (lane >> 4) & 1, q = (lane & 15) >> 2, p = lane & 3;
    const LAS unsigned char* a = img + off_b(r0 + q, 4 * c + 2 * blk + (p >> 1)) + 8 * (p & 1);
    return __builtin_bit_cast(s16x4, __builtin_amdgcn_ds_read_tr16_b64_v4i16((LAS s16x4*)a));
}
DI bf16x8 cat8(s16x4 lo, s16x4 hi) { return (bf16x8){lo[0], lo[1], lo[2], lo[3], hi[0], hi[1], hi[2], hi[3]}; }
DI int crow(int r, int hi) { return (r & 3) + 8 * (r >> 2) + 4 * hi; }
DI void stage_img(LAS unsigned char* img, const bf16* __restrict__ src, int ld, int tid) {
#pragma unroll
    for (int i = 0; i < 4; ++i) { const int id = tid + 512 * i, row = id >> 4, ch = id & 15;
        const v4u v = *(const v4u*)(src + (size_t)row * ld + ch * 8);
        *(LAS v4u*)(img + off_b(row, ch)) = v; }
}
DI void stage_ld(v4u (&v)[4], const bf16* __restrict__ src, int ld, int tid) {
#pragma unroll
    for (int i = 0; i < 4; ++i) { const int id = tid + 512 * i, row = id >> 4, ch = id & 15; v[i] = *(const v4u*)(src + (size_t)row * ld + ch * 8); }
}
DI void stage_st(LAS unsigned char* img, const v4u (&v)[4], int tid) {
#pragma unroll
    for (int i = 0; i < 4; ++i) { const int id = tid + 512 * i, row = id >> 4, ch = id & 15; *(LAS v4u*)(img + off_b(row, ch)) = v[i]; }
}
DI float softplusf_(float x) { return x > 20.f ? x : log1pf(__expf(x)); }
DI void dt_cum(const float* __restrict__ DT, int rowbase, int h, int dir, float bias, float a, int lane, float& dt0, float& dt1, float& c0, float& c1, float& tot) {
    const float r0 = DT[(size_t)(rowbase + 2 * lane) * 32 + dir * 16 + h], r1 = DT[(size_t)(rowbase + 2 * lane + 1) * 32 + dir * 16 + h];
    dt0 = softplusf_(r0 + bias); dt1 = softplusf_(r1 + bias);
    const float d0 = dt0 * a, d1 = dt1 * a;
    const float sc = wave_scan_incl(d0 + d1);
    tot = __int_as_float(__builtin_amdgcn_readlane(__float_as_int(sc), 63));
    if (dir == 0) { c1 = sc; c0 = sc - d1; }
    else { c1 = tot - sc + d1; c0 = tot - sc + d1 + d0; }
}
struct Ptrs {
    const bf16* xbca;
    const float* dt;
    const bf16* z;
    bf16* states;
    float* dec;
    bf16* o;
    float* rss;
    const float *dt_bias, *a_log, *dskip;
};
constexpr int L_B = 0, L_C = IMG, L_X0 = 2 * IMG, L_X1 = 3 * IMG, L_ARR = 4 * IMG, L_SSQ = 4 * IMG + 8192;

DI void s1_unit(const Ptrs& P, LAS unsigned char* lds, int c, int g, int tid) {
    const int lane = tid & 63, w = __builtin_amdgcn_readfirstlane(tid >> 6), hl = w >> 1, nh = w & 1, hh = lane >> 5, r = lane & 31;
    const int rowbase = c * 128;
    __syncthreads();
    v4u xa[4], xb[4];
    stage_ld(xa, P.xbca + (size_t)rowbase * 1536 + 8 * g * 64, 1536, tid); stage_ld(xb, P.xbca + (size_t)rowbase * 1536 + 8 * g * 64 + 128, 1536, tid);
    stage_img(lds + L_B, P.xbca + (size_t)rowbase * 1536 + 1024 + g * 128, 1536, tid);
#pragma unroll 1
    for (int quad = 0; quad < 2; ++quad) {
        const int hq = 8 * g + 4 * quad;
        if (quad) __syncthreads();
        stage_st(lds + L_X0, xa, tid); stage_st(lds + L_X1, xb, tid);
        if (quad == 0) { stage_ld(xa, P.xbca + (size_t)rowbase * 1536 + (hq + 4) * 64, 1536, tid); stage_ld(xb, P.xbca + (size_t)rowbase * 1536 + (hq + 4) * 64 + 128, 1536, tid); }
        {
            const int h = hq + hl, dir = nh; float dt0, dt1, c0, c1, tot;
            dt_cum(P.dt, rowbase, h, dir, P.dt_bias[dir * 16 + h], -__expf(P.a_log[dir * 16 + h]), lane, dt0, dt1, c0, c1, tot);
            LAS float* wg = (LAS float*)(lds + L_ARR) + (hl * 2 + dir) * 128;
            wg[2 * lane] = dt0 * __expf(tot - c0); wg[2 * lane + 1] = dt1 * __expf(tot - c1);
            if (lane == 0) P.dec[(size_t)(c * 2 + dir) * 16 + h] = __expf(tot);
        }
        __syncthreads();
        const LAS unsigned char* ximg = lds + (hl >> 1 ? L_X1 : L_X0);
        const int h = hq + hl;
#pragma unroll 1
        for (int dir = 0; dir < 2; ++dir) {
            const LAS float* wg = (const LAS float*)(lds + L_ARR) + (hl * 2 + dir) * 128;
            f32x16 acc[2][2];
#pragma unroll
            for (int i = 0; i < 2; ++i)
#pragma unroll
                for (int k = 0; k < 2; ++k) acc[i][k] = f32x16{};
#pragma unroll 2
            for (int ks = 0; ks < 8; ++ks) {
                bf16x8 af[2], bfr[2];
#pragma unroll
                for (int nb = 0; nb < 2; ++nb) af[nb] = cat8(tr_read4(lds + L_B, lane, 16 * ks + 8 * hh, 2 * nh + nb), tr_read4(lds + L_B, lane, 16 * ks + 8 * hh + 4, 2 * nh + nb));
                const f32x4 w0 = *(const LAS f32x4*)(wg + 16 * ks + 8 * hh), w1 = *(const LAS f32x4*)(wg + 16 * ks + 8 * hh + 4);
#pragma unroll
                for (int pb = 0; pb < 2; ++pb) {
                    const s16x4 lo = tr_read4(ximg, lane, 16 * ks + 8 * hh, 2 * (hl & 1) + pb), hi4 = tr_read4(ximg, lane, 16 * ks + 8 * hh + 4, 2 * (hl & 1) + pb);
                    v4u pk; pk.x = pk2(bf2f((unsigned short)lo[0]) * w0.x, bf2f((unsigned short)lo[1]) * w0.y); pk.y = pk2(bf2f((unsigned short)lo[2]) * w0.z, bf2f((unsigned short)lo[3]) * w0.w);
                    pk.z = pk2(bf2f((unsigned short)hi4[0]) * w1.x, bf2f((unsigned short)hi4[1]) * w1.y); pk.w = pk2(bf2f((unsigned short)hi4[2]) * w1.z, bf2f((unsigned short)hi4[3]) * w1.w);
                    bfr[pb] = __builtin_bit_cast(bf16x8, pk);
                }
#pragma unroll
                for (int nb = 0; nb < 2; ++nb)
#pragma unroll
                    for (int pb = 0; pb < 2; ++pb) acc[nb][pb] = __builtin_amdgcn_mfma_f32_32x32x16_bf16(af[nb], bfr[pb], acc[nb][pb], 0, 0, 0);
            }
            bf16* sp = P.states + ((size_t)(c * 2 + dir) * 16 + h) * 8192;
#pragma unroll
            for (int nb = 0; nb < 2; ++nb)
#pragma unroll
                for (int pb = 0; pb < 2; ++pb)
#pragma unroll
                    for (int i4 = 0; i4 < 4; ++i4) {
                        v2u o; o.x = pk2(acc[nb][pb][4 * i4], acc[nb][pb][4 * i4 + 1]); o.y = pk2(acc[nb][pb][4 * i4 + 2], acc[nb][pb][4 * i4 + 3]);
                        *(v2u*)(sp + ((((4 * nh + 2 * nb + (i4 >> 1)) * 2 + pb) * 64 + r + 32 * (i4 & 1)) * 8 + 4 * hh)) = o; }
        }
    }
}
template <int BATCH>
DI void scan_states(const Ctx& F, bf16* __restrict__ states, const float* __restrict__ dec, int grp) {
    const int nseq = grp == 0 ? 5 : 12, ntask = nseq * 65536, nthr = F.G * 512;
    for (int task = F.blk * 512 + F.tid; task < ntask; task += nthr) {
        const int n4 = task & 31, p = (task >> 5) & 63, h = (task >> 11) & 15, dir = (task >> 15) & 1, s = task >> 16;
        const int ncs = (grp == 0 && s == 0) ? LP / 128 : LS / 128, cbase = grp == 0 ? (s == 0 ? 0 : LP / 128 + (s - 1) * (LS / 128)) : s * (LS / 128);
        float run[4] = {0.f, 0.f, 0.f, 0.f};
#pragma unroll 1
        for (int k0 = 0; k0 < ncs; k0 += BATCH) {
            v2u v[BATCH]; float dc[BATCH];
#pragma unroll
            for (int k = 0; k < BATCH; ++k) { const int cc = cbase + (dir ? ncs - 1 - (k0 + k) : (k0 + k));
                v[k] = *(const v2u*)(states + (((size_t)(cc * 2 + dir) * 16 + h) * 64 + p) * 128 + n4 * 4); dc[k] = dec[(size_t)(cc * 2 + dir) * 16 + h]; }
#pragma unroll
            for (int k = 0; k < BATCH; ++k) { const int cc = cbase + (dir ? ncs - 1 - (k0 + k) : (k0 + k));
                v2u o; o.x = pk2(run[0], run[1]); o.y = pk2(run[2], run[3]);
                *(v2u*)(states + (((size_t)(cc * 2 + dir) * 16 + h) * 64 + p) * 128 + n4 * 4) = o;
                run[0] = run[0] * dc[k] + bflo(v[k].x); run[1] = run[1] * dc[k] + bfhi(v[k].x); run[2] = run[2] * dc[k] + bflo(v[k].y); run[3] = run[3] * dc[k] + bfhi(v[k].y); }
        }
    }
}
#ifndef PROBE_S3
#define PROBE_S3 0
#endif
#define S3_T0() unsigned long long st0_ = 0; if (PROBE_S3) st0_ = __builtin_amdgcn_s_memrealtime()
#define S3_T1(id) do { if (PROBE_S3 == (id)) { const unsigned long long t1_ = __builtin_amdgcn_s_memrealtime(), d_ = (t1_ - st0_) * 2; while (__builtin_amdgcn_s_memrealtime() - t1_ < d_) __builtin_amdgcn_s_sleep(8); } if (PROBE_S3) st0_ = __builtin_amdgcn_s_memrealtime(); } while (0)
template <int QUAD>
DI void s3_pass(const Ptrs& P, LAS unsigned char* lds, int c, int g, int tid) {
    const int lane_o = tid & 63, w = __builtin_amdgcn_readfirstlane(tid >> 6), hl = w >> 1, lh = w & 1;
    const int rowbase = c * 128, hq = 8 * g + 4 * QUAD, h = hq + hl;
    S3_T0();
    if (QUAD) __syncthreads();
    stage_img(lds + L_X0, P.xbca + (size_t)rowbase * 1536 + hq * 64, 1536, tid);
    stage_img(lds + L_X1, P.xbca + (size_t)rowbase * 1536 + hq * 64 + 128, 1536, tid);
    LAS float* arr = (LAS float*)(lds + L_ARR);
    {   const int dir = lh, lane = lane_o; float dt0, dt1, c0, c1, tot;
        dt_cum(P.dt, rowbase, h, dir, P.dt_bias[dir * 16 + h], -__expf(P.a_log[dir * 16 + h]), lane, dt0, dt1, c0, c1, tot);
        LAS float* a = arr + hl * 512;
        a[dir * 128 + 2 * lane] = dt0; a[dir * 128 + 2 * lane + 1] = dt1; a[(2 + dir) * 128 + 2 * lane] = c0; a[(2 + dir) * 128 + 2 * lane + 1] = c1; }
    __syncthreads();
    S3_T1(2);
    const LAS float* aD0 = arr + hl * 512, *aD1 = aD0 + 128, *aCF = aD0 + 256, *aCR = aD0 + 384;
    const LAS unsigned char* ximg = lds + (hl >> 1 ? L_X1 : L_X0);
    const bf16* pf = P.states + ((size_t)(c * 2 + 0) * 16 + h) * 8192, *pb_ = P.states + ((size_t)(c * 2 + 1) * 16 + h) * 8192;
    const float dsk = P.dskip[h];
    LAS float* ssq = (LAS float*)(lds + L_SSQ);
#pragma unroll 1
    for (int lb = 0; lb < 2; ++lb) {
        f32x16 acc[2];
        acc[0] = f32x16{}; acc[1] = f32x16{};
        int ln_ = lane_o; asm volatile("" : "+v"(ln_)); const int lane = ln_, hh = lane >> 5, r = lane & 31;
        const int l0 = 64 * lh + 32 * lb, l = l0 + r; const float cf_l = aCF[l], cr_l = aCR[l];
#pragma unroll 1
        for (int sb = 0; sb < 4; ++sb) {
            const int s0 = 32 * sb;
            f32x16 X = f32x16{};
            {   bf16x8 bq[8];
#pragma unroll
                for (int ks = 0; ks < 8; ++ks) bq[ks] = row_read(lds + L_B, lane, s0, ks);
                __builtin_amdgcn_sched_barrier(0);
#pragma unroll
                for (int ks = 0; ks < 8; ++ks) X = __builtin_amdgcn_mfma_f32_32x32x16_bf16(bq[ks], row_read(lds + L_C, lane, l0, ks), X, 0, 0, 0); }
            {   const bool needf = s0 <= l0 + 31, needb = s0 + 31 >= l0; const int sb4 = s0 + 4 * hh;
                f32x4 fac[4];
#pragma unroll
                for (int q = 0; q < 4; ++q) fac[q] = (f32x4){0.f, 0.f, 0.f, 0.f};
                if (needf) { f32x4 cs[4], ds[4];
#pragma unroll
                    for (int q = 0; q < 4; ++q) { cs[q] = *(const LAS f32x4*)(aCF + sb4 + 8 * q); ds[q] = *(const LAS f32x4*)(aD0 + sb4 + 8 * q); }
#pragma unroll
                    for (int q = 0; q < 4; ++q)
#pragma unroll
                        for (int e = 0; e < 4; ++e) { const float t = __expf(fminf(cf_l - cs[q][e], 0.f)) * ds[q][e]; fac[q][e] += (sb4 + 8 * q + e <= l) ? t : 0.f; } }
                if (needb) { f32x4 cs[4], ds[4];
#pragma unroll
                    for (int q = 0; q < 4; ++q) { cs[q] = *(const LAS f32x4*)(aCR + sb4 + 8 * q); ds[q] = *(const LAS f32x4*)(aD1 + sb4 + 8 * q); }
#pragma unroll
                    for (int q = 0; q < 4; ++q)
#pragma unroll
                        for (int e = 0; e < 4; ++e) { const float t = __expf(fminf(cr_l - cs[q][e], 0.f)) * ds[q][e]; fac[q][e] += (sb4 + 8 * q + e >= l) ? t : 0.f; } }
#pragma unroll
                for (int q = 0; q < 4; ++q)
#pragma unroll
                    for (int e = 0; e < 4; ++e) X[4 * q + e] *= fac[q][e];
            }
            {   bf16x8 xf[2][2];
#pragma unroll
                for (int sp = 0; sp < 2; ++sp)
#pragma unroll
                    for (int pb = 0; pb < 2; ++pb) xf[sp][pb] = cat8(tr_read4(ximg, lane, s0 + 16 * sp + 4 * hh, 2 * (hl & 1) + pb), tr_read4(ximg, lane, s0 + 16 * sp + 8 + 4 * hh, 2 * (hl & 1) + pb));
                __builtin_amdgcn_sched_barrier(0);
#pragma unroll
                for (int sp = 0; sp < 2; ++sp) {
                    v4u pk; pk.x = pk2(X[8 * sp], X[8 * sp + 1]); pk.y = pk2(X[8 * sp + 2], X[8 * sp + 3]); pk.z = pk2(X[8 * sp + 4], X[8 * sp + 5]); pk.w = pk2(X[8 * sp + 6], X[8 * sp + 7]);
                    const bf16x8 af = __builtin_bit_cast(bf16x8, pk);
#pragma unroll
                    for (int pb = 0; pb < 2; ++pb) acc[pb] = __builtin_amdgcn_mfma_f32_32x32x16_bf16(af, xf[sp][pb], acc[pb], 0, 0, 0);
                } }
        }
        S3_T1(3);
        {
            const float ef = __expf(cf_l), eb = __expf(cr_l);
            int r2 = r; asm volatile("" : "+v"(r2));
            bf16x8 sF[4][2], sB[4][2];
#define S3_LD(ks_, sl_) do { _Pragma("unroll") for (int pb = 0; pb < 2; ++pb) { sF[sl_][pb] = *(const bf16x8*)(pf + (((ks_) * 2 + pb) * 64 + r2 + 32 * hh) * 8); sB[sl_][pb] = *(const bf16x8*)(pb_ + (((ks_) * 2 + pb) * 64 + r2 + 32 * hh) * 8); } } while (0)
            S3_LD(0, 0); S3_LD(1, 1); S3_LD(2, 2); S3_LD(3, 3);
#pragma unroll
            for (int ks = 0; ks < 8; ++ks) {
                const bf16x8 cfr = row_read(lds + L_C, lane, l0, ks);
                float x[8]; unpack8(__builtin_bit_cast(v4u, cfr), x);
                float xf[8], xb[8];
#pragma unroll
                for (int e = 0; e < 8; ++e) { xf[e] = x[e] * ef; xb[e] = x[e] * eb; }
                const bf16x8 aF = __builtin_bit_cast(bf16x8, pack8(xf)), aB = __builtin_bit_cast(bf16x8, pack8(xb));
#pragma unroll
                for (int pb = 0; pb < 2; ++pb) { acc[pb] = __builtin_amdgcn_mfma_f32_32x32x16_bf16(aF, sF[ks & 3][pb], acc[pb], 0, 0, 0);
                    acc[pb] = __builtin_amdgcn_mfma_f32_32x32x16_bf16(aB, sB[ks & 3][pb], acc[pb], 0, 0, 0); }
                if (ks + 4 < 8) S3_LD(ks + 4, ks & 3);
            }
#undef S3_LD
        }
        S3_T1(4);
        {
            unsigned short zr[2][16]; int r3 = r; asm volatile("" : "+v"(r3));
#pragma unroll
            for (int i = 0; i < 16; ++i)
#pragma unroll
                for (int pb = 0; pb < 2; ++pb) zr[pb][i] = P.z[(size_t)(rowbase + l0 + crow(i, hh)) * 1024 + h * 64 + 32 * pb + r3];
            float sqv[16];
#pragma unroll
            for (int i = 0; i < 16; ++i) {
                const int li = l0 + crow(i, hh);
                float sq = 0.f;
#pragma unroll
                for (int pb = 0; pb < 2; ++pb) {
                    const int p = 32 * pb + r3, col = (hl & 1) * 64 + p;
                    const float xs = bf2f(*(const LAS unsigned short*)(ximg + off_b(li, col >> 3) + 2 * (col & 7)));
                    const float y = (acc[pb][i] + dsk * xs) * siluf_(bf2f(zr[pb][i]));
                    P.o[(size_t)(rowbase + li) * 2048 + 512 + h * 64 + p] = f2bf(y); sq += y * y;
                }
                sqv[i] = sq;
            }
            {   const bool c8 = (r3 & 8) != 0, c4 = (r3 & 4) != 0, c2 = (r3 & 2) != 0, c1 = (r3 & 1) != 0;
                float a8[8], a4[4], a2[2];
#pragma unroll
                for (int k = 0; k < 8; ++k) a8[k] = (c8 ? sqv[k + 8] : sqv[k]) + dppx<0x140>(c8 ? sqv[k] : sqv[k + 8]);
#pragma unroll
                for (int k = 0; k < 4; ++k) a4[k] = (c4 ? a8[k + 4] : a8[k]) + dppx<0x141>(c4 ? a8[k] : a8[k + 4]);
#pragma unroll
                for (int k = 0; k < 2; ++k) a2[k] = (c2 ? a4[k + 2] : a4[k]) + dppx<0x1b>(c2 ? a4[k] : a4[k + 2]);
                float tot = (c1 ? a2[1] : a2[0]) + dppx<0xb1>(c1 ? a2[0] : a2[1]);
                tot += xor_lane<16>(tot);
                if (r3 < 16) ssq[(QUAD * 4 + hl) * 128 + l0 + crow(r3, hh)] = tot;
            }
        }
        S3_T1(5);
    }
}
DI void s3_rstd(const Ptrs& P, LAS unsigned char* lds, int c, int g, int tid) {
    if (tid < 128) { const LAS float* ssq = (const LAS float*)(lds + L_SSQ);
        float tot = 0.f;
#pragma unroll
        for (int k = 0; k < 8; ++k) tot += ssq[k * 128 + tid];
        P.rss[(size_t)(c * 128 + tid) * 2 + g] = 1.f / sqrtf(tot * (1.f / 512.f) + EPSN); }
}
DI void s3_unit(const Ptrs& P, LAS unsigned char* lds, int c, int g, int tid) {
    const int rowbase = c * 128;
    S3_T0();
    __syncthreads();
    stage_img(lds + L_B, P.xbca + (size_t)rowbase * 1536 + 1024 + g * 128, 1536, tid);
    stage_img(lds + L_C, P.xbca + (size_t)rowbase * 1536 + 1280 + g * 128, 1536, tid);
    S3_T1(1);
    s3_pass<0>(P, lds, c, g, tid);
    s3_pass<1>(P, lds, c, g, tid);
    __syncthreads();
    if (PROBE_S3) st0_ = __builtin_amdgcn_s_memrealtime();
    s3_rstd(P, lds, c, g, tid);
    S3_T1(6);
}
}
constexpr size_t MiB = 1u << 20;
constexpr size_t WS_CTL = 0, CTL_ZERO_BYTES = 1 * MiB, WS_CW = 1 * MiB, CW_LAYER = 128 * 1024;
constexpr size_t WS_W = 2 * MiB, W_LAYER = 127 * MiB;
constexpr size_t W_TIN = 0, W_TBR = 45 * MiB, W_TOUT = 53 * MiB, W_TUP = 61 * MiB, W_TDN = 105 * MiB;
static_assert(W_TIN + (size_t)NINP * DM * 2 <= W_TBR && W_TUP + (size_t)NUP * DM * 2 <= W_TDN && W_TDN + (size_t)DM * DFF * 2 <= W_LAYER, "weights map");
constexpr size_t WS_R1 = 256 * MiB;
constexpr size_t R_QNA = 0, R_KNA = 24 * MiB, R_VNA = 48 * MiB, R_GQ = 72 * MiB, R_GK = 96 * MiB, R_GV = 108 * MiB, R_Z = 120 * MiB, R_XBC = 168 * MiB, R_DT = 240 * MiB, R_GATE = 243 * MiB;
constexpr size_t WS_XBCA = 643 * MiB, WS_ST = 715 * MiB, WS_O = 811 * MiB, WS_TMPF = 907 * MiB, WS_MRG = 907 * MiB, WS_DEC = 1003 * MiB, WS_SIDE = 1004 * MiB, WS_XW = 1030 * MiB, WS_STAT = 1222 * MiB, WS_END = 1226 * MiB;
constexpr size_t ST_SSQ = 0, ST_RSS = 1536 * 1024, ST_RSTD1 = 2 * MiB, ST_RSTD2 = 3 * MiB;
constexpr size_t WS_ACT = 256 * MiB;
static_assert(WS_W + 2 * W_LAYER <= WS_R1 && WS_R1 + R_GATE + (size_t)MG * 6144 <= WS_XBCA && R_DT + (size_t)MG * 32 * 4 <= R_GATE && WS_XBCA + (size_t)MG * 1536 * 2 <= WS_ST && WS_ST + (size_t)(MG / 128) * 2 * 16 * 8192 * 2 <= WS_O
              && WS_O + (size_t)MG * DM * 2 <= WS_TMPF && WS_TMPF + (size_t)MG * 1024 * 4 <= WS_DEC && WS_MRG + (size_t)MG * DM * 2 <= WS_DEC && WS_SIDE + (size_t)(MTOT / 256) * 6 * DFF * 4 <= WS_XW
              && WS_XW + (size_t)MTOT * DM * 2 <= WS_STAT && WS_ACT + (size_t)MTOT * DFF * 2 <= WS_DEC && ST_SSQ + (size_t)MTOT * 8 * 4 <= ST_RSS && ST_RSS + (size_t)MG * 8 <= ST_RSTD1 && WS_STAT + 4 * MiB <= WS_END, "activation map");
constexpr int CW_BAR = 4096;
constexpr int CW_CNT = 8192, CNT_USE = (MTOT / 256) * 16;
static_assert((CW_CNT + 2 * DEPTH * CNT_USE) * 4 <= (int)CTL_ZERO_BYTES, "counters inside the per-launch memset");

constexpr int LDS_BYTES = 147456, MISC_OFF = LDS_BYTES - 256, EX_OFF = 131072;

#ifndef PROBE_MASK
#define PROBE_MASK 0
#endif
#define PROBE_K 2
#define PROBE_T0() unsigned long long pt0_ = 0; if (PROBE_MASK) pt0_ = __builtin_amdgcn_s_memrealtime()
#define PROBE_T1(id) do { if ((PROBE_MASK >> (id)) & 1) { const unsigned long long t1_ = __builtin_amdgcn_s_memrealtime(), d_ = (t1_ - pt0_) * PROBE_K; \
    while (__builtin_amdgcn_s_memrealtime() - t1_ < d_) __builtin_amdgcn_s_sleep(32); GRID_BAR(); } if (PROBE_MASK) pt0_ = __builtin_amdgcn_s_memrealtime(); } while (0)
struct Args { const float* in[22]; float* out; unsigned char* ws; };

#define REFRESH() do { const int tv_ = tid_of(F.wave); F.tid = tv_; F.lane = tv_ & 63; } while (0)
#define GRID_BAR() do { XcdBarrier b_ = bar; asm volatile("" : "+s"(b_.bar)); b_.bar = (unsigned*)(GAS unsigned*)b_.bar; b_.x = xb_xcc_id(); xcd_barrier(b_); REFRESH(); } while (0)
#define W_PTRS(l)   \
    unsigned char* WL = ws + WS_W + (size_t)((l) & 1) * W_LAYER; \
    bf16* T_IN = (bf16*)(WL + W_TIN); bf16* T_BR = (bf16*)(WL + W_TBR); bf16* T_OUT = (bf16*)(WL + W_TOUT); bf16* T_UP = (bf16*)(WL + W_TUP); bf16* T_DN = (bf16*)(WL + W_TDN);
#define MK_WP(l) WPtrs WP{GIN(3) + (size_t)(l) * DM * NIN, GIN(15) + (size_t)(l) * DM * DM, GIN(16) + (size_t)(l) * DM * DM, GIN(18) + (size_t)(l) * DM * NUP, GIN(21) + (size_t)(l) * DFF * DM, \
    GIN(2) + (l) * DM, GIN(17) + (l) * DM, GIN(12) + (l) * 1024, T_IN, T_BR, T_OUT, T_UP, T_DN, GIN(19) + (size_t)(l) * 3 * DFF, GIN(20) + (size_t)(l) * DFF, (float*)(ws + WS_CW + (size_t)((l) & 1) * CW_LAYER)}
#define OPQ_PTRS() \
    unsigned char* R1 = ws + WS_R1; \
    bf16* QNA = (bf16*)(R1 + R_QNA); bf16* KNA = (bf16*)(R1 + R_KNA); bf16* VNA = (bf16*)(R1 + R_VNA); bf16* GQ = (bf16*)(R1 + R_GQ); bf16* GK = (bf16*)(R1 + R_GK); bf16* GV = (bf16*)(R1 + R_GV); \
    bf16* Z = (bf16*)(R1 + R_Z); bf16* XBC = (bf16*)(R1 + R_XBC); float* DT = (float*)(R1 + R_DT); unsigned char* GATE = (unsigned char*)(R1 + R_GATE); \
    bf16* XBCA = (bf16*)(ws + WS_XBCA); bf16* ST = (bf16*)(ws + WS_ST); bf16* O = (bf16*)(ws + WS_O); float* TMPF = (float*)(ws + WS_TMPF); bf16* MRG = (bf16*)(ws + WS_MRG); \
    float* DEC = (float*)(ws + WS_DEC); bf16* ACT = (bf16*)(ws + WS_ACT); float* SIDE = (float*)(ws + WS_SIDE); bf16* XWA = (bf16*)(ws + WS_XW); \
    float* SSQ = (float*)(ws + WS_STAT + ST_SSQ); float* RSS = (float*)(ws + WS_STAT + ST_RSS); float* RSTD1 = (float*)(ws + WS_STAT + ST_RSTD1); float* RSTD2 = (float*)(ws + WS_STAT + ST_RSTD2); unsigned* CNT = (unsigned*)(ws + WS_CTL) + CW_CNT;
#define NA_UNIT(u) do {   \
    const int b = (u) >> 2, h = (u) & 3, row0 = b * 256, L = seq_len(grp, row0), seq0 = seq_start(grp, row0), rows = L / 64, r0 = (row0 - seq0) >> 6; \
    int rs0 = r0 - 4; rs0 = rs0 < 0 ? 0 : (rs0 > rows - 8 ? rows - 8 : rs0); \
    const int NT = (r0 == 0 || r0 == rows - 4) ? 8 : 12; \
    __syncthreads(); \
    {   LAS float* rp = (LAS float*)(lds + att::SHM_RPB); const float* src = GIN(6) + ((size_t)layer * 4 + h) * 15 * 31; \
        for (int i = tid_of(F.wave); i < 15 * 31; i += 512) rp[(i / 31) * 32 + (i % 31)] = src[i] * (1.f / att::SCALE); } \
    const int r = r0 + (F.wave >> 1); int rs = r - 4; rs = rs < 0 ? 0 : (rs > rows - 8 ? rows - 8 : rs); \
    const int cq = 32 * (F.wave & 1) + (tid_of(F.wave) & 31); int cs = cq - 8; cs = cs < 0 ? 0 : (cs > 48 ? 48 : cs); \
    att::NaCtx nc{__builtin_amdgcn_readfirstlane(rs - rs0), __builtin_amdgcn_readfirstlane(rs0 - r), cq, cs, (const float*)(lds_raw + att::SHM_RPB)}; \
    att::attn_body<512, 512, 2048, true, 1>(QNA + (size_t)row0 * 512 + h * 128, KNA + (size_t)(seq0 + rs0 * 64) * 512 + h * 128, VNA + (size_t)(seq0 + rs0 * 64) * 512 + h * 128, \
                                         O + (size_t)row0 * 2048 + h * 128, NT, (char*)lds_raw, nc, F.wave); } while (0)
__global__ void __launch_bounds__(512, 2) fwd_kernel(Args args) {
    extern __shared__ __attribute__((aligned(16))) unsigned char lds_raw[];
    LAS unsigned char* lds = (LAS unsigned char*)lds_raw;
    Ctx F; F.tid = threadIdx.x; F.lane = F.tid & 63; F.wave = __builtin_amdgcn_readfirstlane(F.tid >> 6); F.G = gridDim.x; F.blk = blockIdx.x;
    F.gw = F.blk * 8 + F.wave; F.ngw = F.G * 8;
    typedef const __attribute__((address_space(4))) Args* KArgs;
    const KArgs kp0 = (KArgs)__builtin_amdgcn_kernarg_segment_ptr();
#define KP() ({ KArgs k_ = kp0; asm volatile("" : "+s"(k_)); k_; })
#define GIN(i) ((const float*)(const GAS float*)(KP()->in[i]))
#define GOUT() ((float*)(GAS float*)(KP()->out))
#define GWS() ((unsigned char*)(GAS unsigned char*)(KP()->ws))
    unsigned char* ws = GWS();
    if (F.tid < 64) ((LAS unsigned*)(lds + MISC_OFF))[F.tid] = 0u;
    __syncthreads();
    XcdBarrier bar = xcd_barrier_post((unsigned*)(ws + WS_CTL) + CW_BAR, (volatile LAS unsigned*)(lds + MISC_OFF), F.wave);

    {   REFRESH(); ws = GWS();
        { W_PTRS(0); MK_WP(0); convert_weights(F, WP, lds); }
        REFRESH();
        xw_init(F, GIN(0), GIN(1), (bf16*)(ws + WS_XW), (float*)(ws + WS_STAT + ST_RSTD1)); }
    GRID_BAR();
#pragma unroll 1
    for (int layer = 0; layer < DEPTH; ++layer) {
#pragma unroll 1
        for (int grp = 0; grp < NGRP; ++grp) {
            REFRESH();
            PROBE_T0();
            ws = GWS();
            OPQ_PTRS();
            W_PTRS(layer);
            bf16* XW = XWA + (size_t)grp * MG * DM;
            {   pg8::Gemm g{XW, T_IN, MG, NINP, DM, DM, DM}; pg8::StaticOrder S; S.init(MG, NINP, F.G, F.blk);
                pg8::EpiInProj E{R1, R_QNA, R_KNA, R_VNA, R_GQ, R_GK, R_GV, R_Z, R_XBC, R_DT, R_GATE, RSTD1 + (size_t)grp * MG, (LAS float*)(lds + EX_OFF + 4096)};
                pg8::gemm_phase<pg8::EpiInProj, pg8::StaticOrder, true, true>(lds, g, S, E, F.wave); }
            GRID_BAR();
            PROBE_T1(2);
            {   PrepPtrs PP{QNA, KNA, GQ, GK, GIN(4) + layer * 128, GIN(5) + layer * 128, GIN(13) + layer * 128, GIN(14) + layer * 128};
                prep_qk(F, PP, grp);
                REFRESH();
                prep_xbc(F, XBC, XBCA, GIN(7) + (size_t)layer * 5 * 1536, GIN(8) + (size_t)layer * 1536, grp); }
            GRID_BAR();
            PROBE_T1(3);
            ssd::Ptrs SP{XBCA, DT, Z, ST, DEC, O, RSS, GIN(9) + layer * 32, GIN(10) + layer * 32, GIN(11) + layer * 16};
            {
                constexpr int NU = (MG / 256) * 4;
                const bool rot = (F.G == 256);
                if (rot) { if (F.blk >= 128) NA_UNIT(F.blk - 128); }
                else for (int u = F.blk; u < NU; u += F.G) NA_UNIT(u);
                REFRESH();
                for (int u = F.blk; u < NU; u += F.G) {
                    int seq0, L, h, qb;
                    if (grp == 0 && u < 256) { seq0 = 0; L = LP; h = u >> 6; qb = u & 63; }
                    else { const int v = grp == 0 ? u - 256 : u; seq0 = (grp == 0 ? LP : 0) + (v >> 5) * LS; L = LS; h = (v >> 3) & 3; qb = v & 7; }
                    att::NaCtx nc{0, 0, 0, 0, nullptr};
                    att::attn_body<512, 256, 2048, false, 2>(GQ + (size_t)(seq0 + qb * 256) * 512 + h * 128, GK + (size_t)seq0 * 256 + (h >> 1) * 128, GV + (size_t)seq0 * 256 + (h >> 1) * 128,
                                                          O + (size_t)(seq0 + qb * 256) * 2048 + 1536 + h * 128, L / 64, (char*)lds_raw, nc, F.wave);
                }
                REFRESH();
                for (int u0 = F.blk; u0 < (rot ? 512 : NU); u0 += F.G) { const int u = (rot && u0 >= 256) ? 256 + ((u0 + 128) & 255) : u0; if (u >= NU) continue; ssd::s1_unit(SP, lds, u >> 1, u & 1, F.tid); }
            }
            GRID_BAR();
            PROBE_T1(4);
            ssd::scan_states<16>(F, ST, DEC, grp);
            GRID_BAR();
            PROBE_T1(5);
            for (int u = F.blk; u < (MG / 128) * 2; u += F.G) ssd::s3_unit(SP, lds, u >> 1, u & 1, F.tid);
            if (F.G == 256 && F.blk >= 128) { REFRESH(); NA_UNIT(128 + 2 * (F.blk - 128)); REFRESH(); NA_UNIT(129 + 2 * (F.blk - 128)); }
            GRID_BAR();
            PROBE_T1(6);
            {   pg8::Gemm g{O, T_BR, MG, DM, DM, DM, DM}; pg8::StaticOrder S; S.init(MG, DM, F.G, F.blk);
                pg8::EpiMerge E{GATE, MRG, RSS};
                pg8::gemm_phase<pg8::EpiMerge, pg8::StaticOrder, true, true>(lds, g, S, E, F.wave); }
            GRID_BAR();
            PROBE_T1(7);
            {   pg8::Gemm g{MRG, T_OUT, MG, DM, DM, DM, DM}; pg8::StaticOrder S; S.init(MG, DM, F.G, F.blk);
                pg8::EpiResid E{XW, nullptr, 0, SSQ + (size_t)grp * MG * 8, RSTD2 + (size_t)grp * MG, CNT + (2 * layer + 0) * CNT_USE + grp * (MG / 256) * 16, (LAS float*)(lds + EX_OFF)};
                pg8::gemm_phase<pg8::EpiResid, pg8::StaticOrder, true, true>(lds, g, S, E, F.wave); }
            GRID_BAR();
            PROBE_T1(8);
        }
        {
            REFRESH();
            PROBE_T0();
            ws = GWS();
            OPQ_PTRS();
            W_PTRS(layer);
            {   pg8::Gemm g{XWA, T_UP, MTOT, NUP, DM, DM, DM}; pg8::StaticOrder S; S.init(MTOT, NUP, F.G, F.blk);
                pg8::EpiFfnAct E{ACT, (const float*)(ws + WS_CW + (size_t)(layer & 1) * CW_LAYER), SIDE, (LAS float*)(lds + EX_OFF), RSTD2, (LAS float*)(lds + EX_OFF + 4096), (LAS float*)(lds + EX_OFF + 8192)};
                pg8::gemm_phase<pg8::EpiFfnAct, pg8::StaticOrder, true, true>(lds, g, S, E, F.wave); }
            GRID_BAR();
            PROBE_T1(10);
            ffn_fix(F, SIDE, ACT, GIN(19) + (size_t)layer * 3 * DFF);
            if (layer + 1 < DEPTH) { REFRESH(); unsigned char* WLn = ws + WS_W + (size_t)((layer + 1) & 1) * W_LAYER;
                WPtrs WP{GIN(3) + (size_t)(layer + 1) * DM * NIN, GIN(15) + (size_t)(layer + 1) * DM * DM, GIN(16) + (size_t)(layer + 1) * DM * DM, GIN(18) + (size_t)(layer + 1) * DM * NUP, GIN(21) + (size_t)(layer + 1) * DFF * DM,
                         GIN(2) + (layer + 1) * DM, GIN(17) + (layer + 1) * DM, GIN(12) + (layer + 1) * 1024, (bf16*)(WLn + W_TIN), (bf16*)(WLn + W_TBR), (bf16*)(WLn + W_TOUT), (bf16*)(WLn + W_TUP), (bf16*)(WLn + W_TDN), GIN(19) + (size_t)(layer + 1) * 3 * DFF, GIN(20) + (size_t)(layer + 1) * DFF, (float*)(ws + WS_CW + (size_t)((layer + 1) & 1) * CW_LAYER)};
                convert_weights(F, WP, lds); }
            GRID_BAR();
            PROBE_T1(11);
            {   pg8::Gemm g{ACT, T_DN, MTOT, DM, DFF, DFF, DFF}; pg8::StaticOrder S; S.init(MTOT, DM, F.G, F.blk);
                pg8::EpiResid E{XWA, GOUT(), layer == DEPTH - 1, SSQ, RSTD1, CNT + (2 * layer + 1) * CNT_USE, (LAS float*)(lds + EX_OFF)};
                pg8::gemm_phase<pg8::EpiResid, pg8::StaticOrder, true, true>(lds, g, S, E, F.wave); }
            GRID_BAR();
            PROBE_T1(12);
        }
    }
}

extern "C" void kernel_launch(void* const* d_in, const int* in_sizes, int n_in, void* d_out, int out_size, void* d_ws, size_t ws_size, hipStream_t stream) {
    static int grid = 0;
    if (grid == 0) {
        if (n_in != 22 || out_size != MTOT * DM || ws_size < WS_END) { fprintf(stderr, "kernel_launch: unexpected shapes n_in %d out %d ws %zu (need %zu)\n", n_in, out_size, ws_size, (size_t)WS_END); grid = -1; return; }
        int dev = 0, cus = 0, per_cu = 0;
        if (hipGetDevice(&dev) != hipSuccess || hipDeviceGetAttribute(&cus, hipDeviceAttributeMultiprocessorCount, dev) != hipSuccess) { grid = -1; return; }
        if (hipFuncSetAttribute((const void*)fwd_kernel, hipFuncAttributeMaxDynamicSharedMemorySize, LDS_BYTES) != hipSuccess) { fprintf(stderr, "kernel_launch: hipFuncSetAttribute failed\n"); grid = -1; return; }
        if (hipOccupancyMaxActiveBlocksPerMultiprocessor(&per_cu, (const void*)fwd_kernel, 512, LDS_BYTES) != hipSuccess || per_cu < 1) { fprintf(stderr, "kernel_launch: occupancy query says %d blocks per CU\n", per_cu); (void)hipGetLastError(); grid = -1; return; }
        grid = cus;
    }
    if (grid < 0) return;
    if (hipMemsetAsync((char*)d_ws + WS_CTL, 0, CTL_ZERO_BYTES, stream) != hipSuccess) return;
    Args a{};
    for (int i = 0; i < 22; ++i) a.in[i] = (const float*)d_in[i];
    a.out = (float*)d_out; a.ws = (unsigned char*)d_ws;
    hipLaunchKernelGGL(fwd_kernel, dim3(grid), dim3(512), LDS_BYTES, stream, a);
    const hipError_t le = hipPeekAtLastError();
    if (le != hipSuccess) fprintf(stderr, "kernel_launch: launch failed: %s\n", hipGetErrorName(le));
}
```

```cpp
#ifndef PROBE_G
#define PROBE_G 0
#endif
#ifndef PROBE_GS
#define PROBE_GS 0
#endif
#include <hip/hip_runtime.h>
#include <cstdio>
#include <cstdint>
#include <cmath>

#define GAS __attribute__((address_space(1)))
#define LAS __attribute__((address_space(3)))
typedef unsigned short bf16;
typedef unsigned v4u __attribute__((ext_vector_type(4)));
typedef unsigned v2u __attribute__((ext_vector_type(2)));
typedef float f32x4 __attribute__((ext_vector_type(4)));
typedef float f32x2 __attribute__((ext_vector_type(2)));
typedef float f32x16 __attribute__((ext_vector_type(16)));
typedef short bf16x8 __attribute__((ext_vector_type(8)));
typedef short s16x4 __attribute__((ext_vector_type(4)));
typedef __bf16 bf16x2_t __attribute__((ext_vector_type(2)));
#define DI __device__ __forceinline__

DI unsigned pk2(float lo, float hi) { f32x2 v = {lo, hi}; bf16x2_t b = __builtin_convertvector(v, bf16x2_t); return __builtin_bit_cast(unsigned, b); }
DI unsigned short f2bf(float f) { return (unsigned short)(pk2(f, 0.f) & 0xffffu); }
DI float bflo(unsigned u) { return __uint_as_float(u << 16); }
DI float bfhi(unsigned u) { return __uint_as_float(u & 0xffff0000u); }
DI float bf2f(unsigned short h) { return __uint_as_float((unsigned)h << 16); }
DI void unpack8(v4u v, float (&x)[8]) { x[0] = bflo(v.x); x[1] = bfhi(v.x); x[2] = bflo(v.y); x[3] = bfhi(v.y); x[4] = bflo(v.z); x[5] = bfhi(v.z); x[6] = bflo(v.w); x[7] = bfhi(v.w); }
DI v4u pack8(const float (&x)[8]) { v4u v; v.x = pk2(x[0], x[1]); v.y = pk2(x[2], x[3]); v.z = pk2(x[4], x[5]); v.w = pk2(x[6], x[7]); return v; }
DI float sigmoidf_(float x) { return __builtin_amdgcn_rcpf(1.f + __expf(-x)); }
DI float siluf_(float x) { return x * sigmoidf_(x); }

template <int K> DI float xor_lane(float v) {
    if constexpr (K == 32) { auto rr = __builtin_amdgcn_permlane32_swap(__float_as_uint(v), __float_as_uint(v), false, false); return __uint_as_float((__builtin_amdgcn_mbcnt_hi(~0u, __builtin_amdgcn_mbcnt_lo(~0u, 0u)) & 32u) ? rr[0] : rr[1]); }
    else return __int_as_float(__builtin_amdgcn_ds_swizzle(__float_as_int(v), (K << 10) | 0x1f));
}
DI float wave_sum(float v) {
    v += xor_lane<1>(v); v += xor_lane<2>(v); v += xor_lane<4>(v); v += xor_lane<8>(v); v += xor_lane<16>(v);
    { auto rr = __builtin_amdgcn_permlane32_swap(__float_as_uint(v), __float_as_uint(v), false, false); v = __uint_as_float(rr[0]) + __uint_as_float(rr[1]); }
    return v;
}
template <int CTRL> DI float dppx(float v) { return __int_as_float(__builtin_amdgcn_mov_dpp(__float_as_int(v), CTRL, 0xf, 0xf, true)); }
template <int CTRL, int RMASK> DI float dpp0(float v) { return __int_as_float(__builtin_amdgcn_update_dpp(0, __float_as_int(v), CTRL, RMASK, 0xf, false)); }
DI float wave_scan_incl(float v) {
    v += dpp0<0x111, 0xf>(v); v += dpp0<0x112, 0xf>(v); v += dpp0<0x114, 0xf>(v); v += dpp0<0x118, 0xf>(v);
    v += dpp0<0x142, 0xa>(v); v += dpp0<0x143, 0xc>(v);
    return v;
}
DI int lane_id() { return (int)__builtin_amdgcn_mbcnt_hi(~0u, __builtin_amdgcn_mbcnt_lo(~0u, 0u)); }
DI int tid_of(int wave) { unsigned z = 0u; asm volatile("" : "+v"(z));
    int t = wave * 64 + (int)__builtin_amdgcn_mbcnt_hi(~0u, __builtin_amdgcn_mbcnt_lo(~0u, z)); asm volatile("" : "+v"(t)); return t; }
#define LDS_WAIT() asm volatile("s_waitcnt lgkmcnt(0)" ::: "memory")
#define VM_WAIT() asm volatile("s_waitcnt vmcnt(0)" ::: "memory")

constexpr int DM = 2048, DEPTH = 4, MTOT = 49152, MG = 24576, NGRP = 2, LP = 16384, LS = 2048;
DI int seq_len(int grp, int tok) { return (grp == 0 && tok < LP) ? LP : LS; }
DI int seq_start(int grp, int tok) { return (grp == 0 && tok < LP) ? 0 : (tok & ~(LS - 1)); }
constexpr int NIN = 11296, NINP = 11520, DFF = 5632, NUP = 11264, GATE_SRC0 = 5152, GATE_DST0 = 5376;
constexpr float EPSN = 1e-6f;
namespace pg8 {
#define PG8_LAS __attribute__((address_space(3)))
typedef unsigned short bf16_t;
typedef short bf16x8 __attribute__((ext_vector_type(8)));
typedef float f32x4 __attribute__((ext_vector_type(4)));
typedef unsigned u32x4 __attribute__((ext_vector_type(4)));
constexpr int BM = 256, BK = 64, HALF = 128, HTB = HALF * BK * 2  , STAGE_BYTES = 8 * HTB, NXCD = 8, WGM = 8;

__host__ __device__ __forceinline__ int lds_byte(int r, int c) { const int st = (r >> 4) * 2 + (c >> 5), rr = r & 15, cc = c & 31, ob = rr * 64 + cc * 2; return st * 1024 + (ob ^ (((ob >> 9) & 1) << 5)); }
__host__ __device__ __forceinline__ void stage_rc(int b, int& R, int& C) { const int st = b / 1024, sb = b % 1024, swz = sb ^ (((sb >> 9) & 1) << 5); R = (st >> 1) * 16 + swz / 64; C = (st & 1) * 32 + (swz % 64) / 2; }
__host__ __device__ __forceinline__ int perm32(int rho) { const int n = rho >> 4, i = rho & 15; return 8 * (i >> 2) + 4 * n + (i & 3); }

struct Unit { int pm, pn; };
struct Gemm { const bf16_t* A; const bf16_t* Bt; int M, N, K, lda, ldb; };

struct StaticOrder {
    int nM, nN, nwg, G, c;
    __host__ __device__ void init(int M, int N, int G_, int c_) { nM = M / BM; nN = N / BM; nwg = nM * nN; G = G_; c = c_; }
    __host__ __device__ bool next(int i, Unit& u) const {
        const long L = (long)i * G + c; if (L >= nwg) return false;
        int wgid = (int)L; { const int q = nwg / NXCD, r = nwg % NXCD, xcd = wgid % NXCD, off = wgid / NXCD; wgid = (xcd < r ? xcd * (q + 1) : r * (q + 1) + (xcd - r) * q) + off; }
        const int nig = WGM * nN, gid = wgid / nig, fm = gid * WGM, gsz = (nM - fm) < WGM ? (nM - fm) : WGM;
        u.pm = fm + ((wgid % nig) % gsz); u.pn = (wgid % nig) / gsz; return true;
    }
    __device__ __forceinline__ void a_ready(const Unit&) const {}
    __device__ __forceinline__ void done(const Unit&) const {}
};

__device__ __forceinline__ void row_rstd(const float* rstd, int row0, float (&rs)[2][4]) {
#pragma unroll
    for (int ai = 0; ai < 2; ++ai)
#pragma unroll
        for (int m = 0; m < 4; ++m) rs[ai][m] = rstd[row0 + ai * HALF + m * 16];
}
struct EpiInProj {
    static constexpr bool APERM = false; static constexpr int PID = 0; static constexpr bool PERM = true, AFTER_DRAIN = false, KHOOK = false, KSTATE = true;
    unsigned char* r1;
    size_t oQNA, oKNA, oVNA, oGQ, oGK, oGV, oZ, oXBC, oDT, oGATE;
    const float* rstd; PG8_LAS float* rl;
    __device__ __forceinline__ void kpre(const Unit& u, int wr, int wc, int fr, int fq) const {
        int fr_ = fr, fq_ = fq; asm volatile("" : "+v"(fr_), "+v"(fq_)); const int lane = fq_ * 16 + fr_, wid = wr * 4 + wc;
#pragma unroll
        for (int k = 0; k < 2; ++k) __builtin_amdgcn_global_load_lds((const unsigned*)(rstd + u.pm * BM + k * HALF + wr * 64 + lane), (PG8_LAS unsigned*)(rl + wid * 128 + k * 64), 4, 0, 0);
    }
    __device__ __forceinline__ void operator()(const f32x4 (&acc)[2][2][4][2], const Unit& u, int wr, int wc, int fr, int fq) const {
        const int pn = u.pn; const int row0 = u.pm * BM + wr * 64 + fr;
        size_t off; int ld, colb, mode = 0;
        if (pn < 2)       { off = oQNA; ld = 512;  colb = pn * 256; }
        else if (pn < 4)  { off = oKNA; ld = 512;  colb = (pn - 2) * 256; }
        else if (pn < 6)  { off = oVNA; ld = 512;  colb = (pn - 4) * 256; }
        else if (pn < 8)  { off = oGQ;  ld = 512;  colb = (pn - 6) * 256; }
        else if (pn == 8) { off = oGK;  ld = 256;  colb = 0; }
        else if (pn == 9) { off = oGV;  ld = 256;  colb = 0; }
        else if (pn < 14) { off = oZ;   ld = 1024; colb = (pn - 10) * 256; }
        else if (pn < 20) { off = oXBC; ld = 1536; colb = (pn - 14) * 256; }
        else if (pn == 20){ off = oDT;  ld = 32;   colb = 0; mode = 1; }
        else              { off = oGATE; ld = 6144; colb = (pn - 21) * 256; mode = 2; }
        const int col0 = colb + wc * 32 + 8 * fq;
        float rs[2][4];
#pragma unroll
        for (int i = 0; i < 8; ++i) rs[i >> 2][i & 3] = rl[(wr * 4 + wc) * 128 + (i >> 2) * 64 + (i & 3) * 16 + fr];
        if (mode == 1) {
            if (wc == 0) {
                float* base = (float*)(r1 + off);
#pragma unroll
                for (int ai = 0; ai < 2; ++ai)
#pragma unroll
                    for (int m = 0; m < 4; ++m) { float* rowp = base + (size_t)(row0 + ai * HALF + m * 16) * 32 + 8 * fq;
                        *(f32x4*)(rowp) = acc[ai][0][m][0] * rs[ai][m]; *(f32x4*)(rowp + 4) = acc[ai][0][m][1] * rs[ai][m]; }
            }
            return;
        }
        if (mode == 2) {
            const int gt = pn - 21; int fr_ = fr, fq_ = fq; asm volatile("" : "+v"(fr_), "+v"(fq_));
            unsigned char* tb = (unsigned char*)(r1 + off) + ((size_t)((u.pm * 3 + (gt >> 3)) * 8 + (gt & 7)) * 8 + (wr * 4 + wc)) * 8192 + (fq_ * 16 + fr_) * 16;
#pragma unroll
            for (int ai = 0; ai < 2; ++ai)
#pragma unroll
                for (int m = 0; m < 4; ++m) { u32x4 w;
#pragma unroll
                    for (int bj = 0; bj < 2; ++bj) { const f32x4 v0 = acc[ai][bj][m][0] * rs[ai][m], v1 = acc[ai][bj][m][1] * rs[ai][m]; unsigned q[8];
#pragma unroll
                        for (int e = 0; e < 4; ++e) { q[e] = (unsigned)fmaxf(sigmoidf_(v0[e]) * 255.f + 0.5f, 1.f); q[4 + e] = (unsigned)fmaxf(sigmoidf_(v1[e]) * 255.f + 0.5f, 1.f); }
                        const unsigned lo = q[0] | (q[1] << 8) | (q[2] << 16) | (q[3] << 24), hi = q[4] | (q[5] << 8) | (q[6] << 16) | (q[7] << 24);
                        if (bj == 0) { w.x = lo; w.y = hi; } else { w.z = lo; w.w = hi; } }
                    *(u32x4*)(tb + (ai * 4 + m) * 1024) = w; }
            return;
        }
        bf16_t* base = (bf16_t*)(r1 + off);
#pragma unroll
        for (int ai = 0; ai < 2; ++ai)
#pragma unroll
            for (int m = 0; m < 4; ++m) { bf16_t* rowp = base + (size_t)(row0 + ai * HALF + m * 16) * ld + col0;
#pragma unroll
                for (int bj = 0; bj < 2; ++bj) { const f32x4 v0 = acc[ai][bj][m][0] * rs[ai][m], v1 = acc[ai][bj][m][1] * rs[ai][m];
                    u32x4 w; w.x = pk2(v0[0], v0[1]); w.y = pk2(v0[2], v0[3]); w.z = pk2(v1[0], v1[1]); w.w = pk2(v1[2], v1[3]);
                    *(u32x4*)(rowp + bj * HALF) = w; } }
    }
};
struct EpiBf16Plain {
    static constexpr bool APERM = false; static constexpr int PID = 1; static constexpr bool PERM = true, AFTER_DRAIN = false, KHOOK = false, KSTATE = false;
    bf16_t* O; int ldc;
    __device__ __forceinline__ void operator()(const f32x4 (&acc)[2][2][4][2], const Unit& u, int wr, int wc, int fr, int fq) const {
        const int row0 = u.pm * BM + wr * 64 + fr, col0 = u.pn * BM + wc * 32 + 8 * fq;
#pragma unroll
        for (int ai = 0; ai < 2; ++ai)
#pragma unroll
            for (int m = 0; m < 4; ++m) { bf16_t* rowp = O + (size_t)(row0 + ai * HALF + m * 16) * ldc + col0;
#pragma unroll
                for (int bj = 0; bj < 2; ++bj) { const f32x4 v0 = acc[ai][bj][m][0], v1 = acc[ai][bj][m][1];
                    u32x4 w; w.x = pk2(v0[0], v0[1]); w.y = pk2(v0[2], v0[3]); w.z = pk2(v1[0], v1[1]); w.w = pk2(v1[2], v1[3]);
                    *(u32x4*)(rowp + bj * HALF) = w; } }
    }
};
struct EpiMerge {
    static constexpr bool APERM = false; static constexpr int PID = 2; static constexpr bool PERM = true, AFTER_DRAIN = false, KHOOK = true, KSTATE = false;
    const unsigned char* gates; bf16_t* merged; const float* rss;
    typedef unsigned u32x2 __attribute__((ext_vector_type(2)));
    typedef float f32x2_ __attribute__((ext_vector_type(2)));
    static __device__ __forceinline__ void unq(u32x2 w, float (&g)[8]) {
        g[0] = (float)(w.x & 255u); g[1] = (float)((w.x >> 8) & 255u); g[2] = (float)((w.x >> 16) & 255u); g[3] = (float)(w.x >> 24);
        g[4] = (float)(w.y & 255u); g[5] = (float)((w.y >> 8) & 255u); g[6] = (float)((w.y >> 16) & 255u); g[7] = (float)(w.y >> 24); }
    __device__ __forceinline__ void khook(f32x4 (&acc)[2][2][4][2], const Unit& u, int t, int wr, int wc, int fr, int fq) const {
        if (t != 8 && t != 16 && t != 24) return;
        int fr_ = fr, fq_ = fq; asm volatile("" : "+v"(fr_), "+v"(fq_));
        const int row0 = u.pm * BM + wr * 64 + fr_;
        const int ja = t == 8 ? 0 : 1, jb = t == 24 ? 2 : 1;
        const float w8 = t == 8 ? 1.f : 0.f, w16 = t == 16 ? 1.f : 0.f, w24 = t == 24 ? 1.f : 0.f;
        const unsigned char* ta = gblob(u, ja, wr, wc, fr_, fq_); const unsigned char* tbp = gblob(u, jb, wr, wc, fr_, fq_);
        f32x2_ rr[2][4]; u32x4 qa[2][4], qb[2][4];
#pragma unroll
        for (int ai = 0; ai < 2; ++ai)
#pragma unroll
            for (int m = 0; m < 4; ++m) { rr[ai][m] = *(const f32x2_*)(rss + (size_t)(row0 + ai * HALF + m * 16) * 2);
                qa[ai][m] = *(const u32x4*)(ta + (ai * 4 + m) * 1024); qb[ai][m] = *(const u32x4*)(tbp + (ai * 4 + m) * 1024); }
#pragma unroll
        for (int ai = 0; ai < 2; ++ai)
#pragma unroll
            for (int m = 0; m < 4; ++m) { const float f = (w8 + w16 * rr[ai][m].x + w24 * rr[ai][m].y) * __builtin_amdgcn_rcpf(w8 * rr[ai][m].x + w16 * rr[ai][m].y + w24);
#pragma unroll
                for (int bj = 0; bj < 2; ++bj) {
                    float ga[8], gb[8]; unq(bj ? (u32x2){qa[ai][m].z, qa[ai][m].w} : (u32x2){qa[ai][m].x, qa[ai][m].y}, ga); unq(bj ? (u32x2){qb[ai][m].z, qb[ai][m].w} : (u32x2){qb[ai][m].x, qb[ai][m].y}, gb);
#pragma unroll
                    for (int e = 0; e < 4; ++e) { acc[ai][bj][m][0][e] *= ga[e] * f * __builtin_amdgcn_rcpf(gb[e]); acc[ai][bj][m][1][e] *= ga[4 + e] * f * __builtin_amdgcn_rcpf(gb[4 + e]); } } }
    }
    __device__ __forceinline__ const unsigned char* gblob(const Unit& u, int br, int wr, int wc, int fr, int fq) const {
        return gates + ((size_t)((u.pm * 3 + br) * 8 + u.pn) * 8 + (wr * 4 + wc)) * 8192 + (fq * 16 + fr) * 16; }
    __device__ __forceinline__ void operator()(const f32x4 (&acc)[2][2][4][2], const Unit& u, int wr, int wc, int fr, int fq) const {
        const int row0 = u.pm * BM + wr * 64 + fr, col0 = u.pn * BM + wc * 32 + 8 * fq;
        const unsigned char* tg = gblob(u, 2, wr, wc, fr, fq);
#pragma unroll
        for (int ai = 0; ai < 2; ++ai) { u32x4 gr[4];
#pragma unroll
            for (int m = 0; m < 4; ++m) gr[m] = *(const u32x4*)(tg + (ai * 4 + m) * 1024);
#pragma unroll
            for (int m = 0; m < 4; ++m) { const size_t row = (size_t)(row0 + ai * HALF + m * 16);
#pragma unroll
                for (int bj = 0; bj < 2; ++bj) { const int col = col0 + bj * HALF;
                    float g[8]; unq(bj ? (u32x2){gr[m].z, gr[m].w} : (u32x2){gr[m].x, gr[m].y}, g);
                    const f32x4 v0 = acc[ai][bj][m][0] * (1.f / 255.f), v1 = acc[ai][bj][m][1] * (1.f / 255.f);
                    u32x4 w; w.x = pk2(v0[0] * g[0], v0[1] * g[1]); w.y = pk2(v0[2] * g[2], v0[3] * g[3]); w.z = pk2(v1[0] * g[4], v1[1] * g[5]); w.w = pk2(v1[2] * g[6], v1[3] * g[7]);
                    *(u32x4*)(merged + row * 2048 + col) = w; } } }
    }
};
template <int CTRL> __device__ __forceinline__ float dpp_rot(float v) { return __int_as_float(__builtin_amdgcn_mov_dpp(__float_as_int(v), CTRL, 0xf, 0xf, true)); }
struct EpiFfnAct {
    static constexpr bool APERM = true; static constexpr int PID = 3; static constexpr bool PERM = true, AFTER_DRAIN = false, KHOOK = false, KSTATE = true;
    bf16_t* act; const float* cwp; float* side; PG8_LAS float* ex;
    const float* rstd; PG8_LAS float* rl;
    PG8_LAS float* wl;
    __device__ __forceinline__ void kpre(const Unit& u, int wr, int wc, int fr, int fq) const {
        int fr_ = fr, fq_ = fq; asm volatile("" : "+v"(fr_), "+v"(fq_)); const unsigned lo = (unsigned)(fq_ * 16 + fr_) * 4u; const int wid = wr * 4 + wc;
        const char* b0 = (const char*)(rstd + u.pm * BM + wr * 64); const char* b1 = (const char*)(cwp + (u.pn * 4 + wc) * 128);
        __builtin_amdgcn_global_load_lds((const unsigned*)(b0 + lo), (PG8_LAS unsigned*)(rl + wid * 128), 4, 0, 0);
        __builtin_amdgcn_global_load_lds((const unsigned*)(b0 + HALF * 4 + lo), (PG8_LAS unsigned*)(rl + wid * 128 + 64), 4, 0, 0);
        __builtin_amdgcn_global_load_lds((const unsigned*)(b1 + lo), (PG8_LAS unsigned*)(wl + wid * 128), 4, 0, 0);
        __builtin_amdgcn_global_load_lds((const unsigned*)(b1 + 256 + lo), (PG8_LAS unsigned*)(wl + wid * 128 + 64), 4, 0, 0);
    }
    __device__ __forceinline__ void operator()(const f32x4 (&acc)[2][2][4][2], const Unit& u, int wr, int wc, int fr_in, int fq_in) const {
        int fr = fr_in, fq = fq_in; asm volatile("" : "+v"(fr), "+v"(fq));
        const int gc = u.pn * 128 + wc * 32 + 8 * fq, lc = wc * 32 + 8 * fq;
        const int row0 = u.pm * BM + wr * 64 + 4 * fr;
        f32x4 rs[2];
#pragma unroll
        for (int ai = 0; ai < 2; ++ai) rs[ai] = *(const PG8_LAS f32x4*)(rl + (wr * 4 + wc) * 128 + ai * 64 + 4 * fr);
        f32x4 w0[2], w1[2], w2[2], bb[2];
        {   const PG8_LAS float* wp = wl + (wr * 4 + wc) * 128 + 8 * fq;
#pragma unroll
            for (int n = 0; n < 2; ++n) { w0[n] = *(const PG8_LAS f32x4*)(wp + 4 * n); w1[n] = *(const PG8_LAS f32x4*)(wp + 32 + 4 * n); w2[n] = *(const PG8_LAS f32x4*)(wp + 64 + 4 * n); bb[n] = *(const PG8_LAS f32x4*)(wp + 96 + 4 * n); } }
#pragma unroll
        for (int ai = 0; ai < 2; ++ai) { const int b = 2 * ai + wr;
            if (fr == 0)  { *(PG8_LAS f32x4*)(ex + (b * 2 + 0) * 128 + lc) = acc[ai][0][0][0] * rs[ai][0]; *(PG8_LAS f32x4*)(ex + (b * 2 + 0) * 128 + lc + 4) = acc[ai][0][0][1] * rs[ai][0]; }
            if (fr == 15) { *(PG8_LAS f32x4*)(ex + (b * 2 + 1) * 128 + lc) = acc[ai][0][3][0] * rs[ai][3]; *(PG8_LAS f32x4*)(ex + (b * 2 + 1) * 128 + lc + 4) = acc[ai][0][3][1] * rs[ai][3]; } }
        asm volatile("s_waitcnt lgkmcnt(0)" ::: "memory"); __builtin_amdgcn_s_barrier(); asm volatile("" ::: "memory");
        const bool f0 = fr == 0, f15 = fr == 15;
#pragma unroll
        for (int ai = 0; ai < 2; ++ai) { const int b = 2 * ai + wr;
            f32x4 hu[2], hd[2];
#pragma unroll
            for (int n = 0; n < 2; ++n) { hu[n] = b > 0 ? *(const PG8_LAS f32x4*)(ex + ((b - 1) * 2 + 1) * 128 + lc + 4 * n) : (f32x4){0.f, 0.f, 0.f, 0.f};
                                          hd[n] = b < 3 ? *(const PG8_LAS f32x4*)(ex + ((b + 1) * 2 + 0) * 128 + lc + 4 * n) : (f32x4){0.f, 0.f, 0.f, 0.f}; }
            f32x4 o[4][2];
            const bool sidew = ai == 0 ? (wr == 0 && f0) : (wr == 1 && f15);
#pragma unroll
            for (int n = 0; n < 2; ++n) { f32x4 sedge;
#pragma unroll
                for (int e = 0; e < 4; ++e) { float g[4];
#pragma unroll
                    for (int m = 0; m < 4; ++m) g[m] = acc[ai][0][m][n][e] * rs[ai][m];
                    float up = dpp_rot<0x121>(g[3]); up = f0 ? hu[n][e] : up;
                    float dn = dpp_rot<0x12f>(g[0]); dn = f15 ? hd[n][e] : dn;
#pragma unroll
                    for (int m = 0; m < 4; ++m) { const float gu = m == 0 ? up : g[m > 0 ? m - 1 : 0], gd = m == 3 ? dn : g[m < 3 ? m + 1 : 3];
                        const float s = bb[n][e] + w0[n][e] * gu + w1[n][e] * g[m] + w2[n][e] * gd;
                        o[m][n][e] = siluf_(s) * (acc[ai][1][m][n][e] * rs[ai][m]);
                        if ((ai == 0 && m == 0) || (ai == 1 && m == 3)) sedge[e] = s; } }
                if (sidew) { const int m = ai == 0 ? 0 : 3;
                    const f32x4 gg = acc[ai][0][m][n] * rs[ai][m], vg = acc[ai][1][m][n] * rs[ai][m];
                    f32x4* sp = (f32x4*)(side + (((size_t)u.pm * 2 + ai) * 5632 + gc + 4 * n) * 3);
                    sp[0] = (f32x4){sedge[0], vg[0], gg[0], sedge[1]}; sp[1] = (f32x4){vg[1], gg[1], sedge[2], vg[2]}; sp[2] = (f32x4){gg[2], sedge[3], vg[3], gg[3]}; } }
#pragma unroll
            for (int m = 0; m < 4; ++m) { u32x4 w; w.x = pk2(o[m][0][0], o[m][0][1]); w.y = pk2(o[m][0][2], o[m][0][3]); w.z = pk2(o[m][1][0], o[m][1][1]); w.w = pk2(o[m][1][2], o[m][1][3]);
                *(u32x4*)(act + (size_t)(row0 + ai * HALF + m) * 5632 + gc) = w; } }
    }
};
struct EpiResid {
    static constexpr bool APERM = false; static constexpr int PID = 4; static constexpr bool PERM = true, AFTER_DRAIN = false, KHOOK = false, KSTATE = false;
    bf16_t* xw; float* fout; int out_f32; float* ssq; float* rstd; unsigned* cnt; PG8_LAS float* part;
    __device__ __forceinline__ void operator()(const f32x4 (&acc)[2][2][4][2], const Unit& u, int wr, int wc, int fr, int fq) const {
        const int row0 = u.pm * BM + wr * 64 + fr, col0 = u.pn * BM + wc * 32 + 8 * fq;
#pragma unroll
        for (int ai = 0; ai < 2; ++ai) { u32x4 xr[4][2];
#pragma unroll
            for (int m = 0; m < 4; ++m)
#pragma unroll
                for (int bj = 0; bj < 2; ++bj) xr[m][bj] = *(const u32x4*)(xw + (size_t)(row0 + ai * HALF + m * 16) * 2048 + col0 + bj * HALF);
#pragma unroll
            for (int m = 0; m < 4; ++m) { const size_t off = (size_t)(row0 + ai * HALF + m * 16) * 2048 + col0; float sq = 0.f;
#pragma unroll
                for (int bj = 0; bj < 2; ++bj) { float t[8]; unpack8(xr[m][bj], t);
                    const f32x4 v0 = (f32x4){t[0], t[1], t[2], t[3]} + acc[ai][bj][m][0], v1 = (f32x4){t[4], t[5], t[6], t[7]} + acc[ai][bj][m][1];
                    sq += ((v0[0] * v0[0] + v0[1] * v0[1]) + (v0[2] * v0[2] + v0[3] * v0[3])) + ((v1[0] * v1[0] + v1[1] * v1[1]) + (v1[2] * v1[2] + v1[3] * v1[3]));
                    if (out_f32) { *(f32x4*)(fout + off + bj * HALF) = v0; *(f32x4*)(fout + off + bj * HALF + 4) = v1; }
                    else { u32x4 w; w.x = pk2(v0[0], v0[1]); w.y = pk2(v0[2], v0[3]); w.z = pk2(v1[0], v1[1]); w.w = pk2(v1[2], v1[3]); *(u32x4*)(xw + off + bj * HALF) = w; } }
                if (!out_f32) { sq += xor_lane<16>(sq);
                    { auto rr = __builtin_amdgcn_permlane32_swap(__float_as_uint(sq), __float_as_uint(sq), false, false); sq = __uint_as_float(rr[0]) + __uint_as_float(rr[1]); }
                    if (fq == 0) part[(ai * HALF + wr * 64 + m * 16 + fr) * 4 + wc] = sq; } } }
        if (out_f32) return;
        asm volatile("s_waitcnt lgkmcnt(0)" ::: "memory"); __builtin_amdgcn_s_barrier(); asm volatile("" ::: "memory");
        if (wr == 0) {
            const int lane = fq * 16 + fr, t = wc * 64 + lane;
            const f32x4 q = *(const PG8_LAS f32x4*)(part + t * 4);
            __hip_atomic_store(ssq + (size_t)(u.pm * BM + t) * 8 + u.pn, (q.x + q.y) + (q.z + q.w), __ATOMIC_RELAXED, __HIP_MEMORY_SCOPE_AGENT);
            asm volatile("s_waitcnt vmcnt(0)" ::: "memory");
            unsigned old = 0u; if (lane == 0) old = __hip_atomic_fetch_add(cnt + u.pm * 16, 1u, __ATOMIC_RELAXED, __HIP_MEMORY_SCOPE_AGENT);
            if ((unsigned)__builtin_amdgcn_readfirstlane(old) == 31u) {
                __builtin_amdgcn_fence(__ATOMIC_ACQUIRE, "agent");
#pragma unroll
                for (int k = 0; k < 4; ++k) { const int r = u.pm * BM + lane + 64 * k; float tot = 0.f;
#pragma unroll
                    for (int j = 0; j < 8; ++j) tot += __hip_atomic_load(ssq + (size_t)r * 8 + j, __ATOMIC_RELAXED, __HIP_MEMORY_SCOPE_AGENT);
                    rstd[r] = 1.f / sqrtf(tot * (1.f / 2048.f) + 1e-6f); } }
        }
    }
};

template <class Epi, class Sched, bool ALIGN_EPI = false, bool SP2 = false>
__device__ __forceinline__ void gemm_phase(PG8_LAS unsigned char* lds, const Gemm g, const Sched& S, const Epi& E, int wave_) {
    const int tid_ = tid_of(wave_);
    const int tid = tid_, wid = __builtin_amdgcn_readfirstlane(tid >> 6), lane = tid & 63, wr = wid >> 2, wc = wid & 3, fr = lane & 15, fq = lane >> 4;
    const int K = g.K, nt = K / BK;
    unsigned voffA[2], voffB[2];
#define PG8_VOFF(t_) do { _Pragma("unroll") for (int i = 0; i < 2; ++i) { int R, C; stage_rc((t_) * 16 + i * 8192, R, C); const int Rb = Epi::PERM ? ((R & ~31) + perm32(R & 31)) : R; \
        const int Ra = Epi::APERM ? ((R & ~63) + ((R & 15) * 4 + ((R >> 4) & 3))) : R; voffA[i] = (unsigned)(Ra * g.lda + C) * 2u; voffB[i] = (unsigned)(Rb * g.ldb + C) * 2u; } } while (0)
    PG8_VOFF(tid);
    const size_t kstep = (size_t)(BK * 2);
    const size_t hstepA = (size_t)HALF * g.lda * 2, hstepB = (size_t)HALF * g.ldb * 2;
    const size_t tstepA = 2 * hstepA, tstepB = 2 * hstepB;
    const unsigned ldsw = (unsigned)wid * 1024u;
    int aoff = lds_byte(wr * 64 + fr, fq * 8), boff = lds_byte(wc * 32 + fr, fq * 8);
#define PG8_SA(b, h) (((b) * 2 + (h)) * HTB)
#define PG8_SB(b, h) ((4 + (b) * 2 + (h)) * HTB)
#define PG8_STAGE(bufoff, gbase, voff) do { _Pragma("unroll") for (int _i = 0; _i < 2; ++_i) \
        __builtin_amdgcn_global_load_lds((const unsigned*)((const char*)(gbase) + (voff)[_i]), (PG8_LAS unsigned*)(lds + (bufoff) + ldsw + _i * 8192), 16, 0, 0); } while (0)
#define PG8_LDA(dst, b, h) do { _Pragma("unroll") for (int m = 0; m < 4; ++m) _Pragma("unroll") for (int k = 0; k < 2; ++k) dst[m][k] = *(const PG8_LAS bf16x8*)(lds + PG8_SA(b, h) + aoff + m * 2048 + k * 1024); } while (0)
#define PG8_LDB(dst, b, h) do { _Pragma("unroll") for (int n = 0; n < 2; ++n) _Pragma("unroll") for (int k = 0; k < 2; ++k) dst[n][k] = *(const PG8_LAS bf16x8*)(lds + PG8_SB(b, h) + boff + n * 2048 + k * 1024); } while (0)
#define PG8_MMA(ai, bj, At, Bt) do { __builtin_amdgcn_s_setprio(1); _Pragma("unroll") for (int m = 0; m < 4; ++m) _Pragma("unroll") for (int n = 0; n < 2; ++n) _Pragma("unroll") for (int k = 0; k < 2; ++k) \
        acc[ai][bj][m][n] = __builtin_amdgcn_mfma_f32_16x16x32_bf16(Bt[n][k], At[m][k], acc[ai][bj][m][n], 0, 0, 0); __builtin_amdgcn_s_setprio(0); } while (0)
#define PG8_WAIT_V(n) asm volatile("s_waitcnt vmcnt(" #n ")" ::: "memory")
#define PG8_WAIT_L(n) asm volatile("s_waitcnt lgkmcnt(" #n ")" ::: "memory")
#define PG8_BAR __builtin_amdgcn_s_barrier()
#define PG8_SCHED __builtin_amdgcn_sched_barrier(0)
    Unit cur, nxt; int ui = 0;
    if (!S.next(0, cur)) return;
    f32x4 acc[2][2][4][2];
#pragma unroll
    for (int a = 0; a < 2; ++a)
#pragma unroll
        for (int b = 0; b < 2; ++b)
#pragma unroll
            for (int m = 0; m < 4; ++m)
#pragma unroll
                for (int n = 0; n < 2; ++n) acc[a][b][m][n] = (f32x4){0.f, 0.f, 0.f, 0.f};
    bf16x8 At[4][2], B0[2][2], B1[2][2];
    const char* cA = (const char*)g.A + (size_t)cur.pm * tstepA; const char* cB = (const char*)g.Bt + (size_t)cur.pn * tstepB;
    S.a_ready(cur);
    if constexpr (SP2) {
        PG8_STAGE(PG8_SB(0, 0), cB, voffB); PG8_STAGE(PG8_SB(0, 1), cB + hstepB, voffB); PG8_STAGE(PG8_SA(0, 0), cA, voffA); PG8_STAGE(PG8_SA(0, 1), cA + hstepA, voffA);
        if (wr == 1) PG8_BAR;
        PG8_WAIT_V(2); PG8_BAR;
        PG8_STAGE(PG8_SB(1, 0), cB + kstep, voffB); PG8_STAGE(PG8_SA(1, 0), cA + kstep, voffA); PG8_STAGE(PG8_SB(1, 1), cB + hstepB + kstep, voffB);
        PG8_WAIT_V(6); PG8_BAR;
    } else {
        PG8_STAGE(PG8_SB(0, 0), cB, voffB); PG8_STAGE(PG8_SA(0, 0), cA, voffA); PG8_STAGE(PG8_SB(0, 1), cB + hstepB, voffB); PG8_STAGE(PG8_SA(0, 1), cA + hstepA, voffA);
        if (wr == 1) PG8_BAR;
        PG8_WAIT_V(4); PG8_BAR;
        PG8_STAGE(PG8_SB(1, 0), cB + kstep, voffB); PG8_STAGE(PG8_SA(1, 0), cA + kstep, voffA); PG8_STAGE(PG8_SB(1, 1), cB + hstepB + kstep, voffB);
        PG8_WAIT_V(6); PG8_BAR;
    }
    for (;;) {
        const bool has_next = S.next(ui + 1, nxt);
        const char* nA = has_next ? (const char*)g.A + (size_t)nxt.pm * tstepA : cA; const char* nB = has_next ? (const char*)g.Bt + (size_t)nxt.pn * tstepB : cB;
        for (int t = 0; t < nt; t += 2) {
            if constexpr (Epi::KHOOK) { const int l_ = tid_of(wave_) & 63; E.khook(acc, cur, t, wr, wc, l_ & 15, l_ >> 4); }
            const bool last = (t == nt - 2);
            if constexpr (Epi::KSTATE) { if (last) { const int l_ = tid_of(wave_) & 63; E.kpre(cur, wr, wc, l_ & 15, l_ >> 4); } }
            const char* a1 = cA + (size_t)(t + 1) * kstep;
            const char* a2 = last ? nA : cA + (size_t)(t + 2) * kstep; const char* b2 = last ? nB : cB + (size_t)(t + 2) * kstep;
            const char* a3 = a2 + kstep; const char* b3 = b2 + kstep;
            if (last && has_next) S.a_ready(nxt);
            if constexpr (SP2) {
            PG8_LDB(B0, 0, 0); PG8_LDB(B1, 0, 1); PG8_SCHED; PG8_LDA(At, 0, 0); PG8_STAGE(PG8_SA(1, 1), a1 + hstepA, voffA);
            PG8_WAIT_V(8); PG8_WAIT_L(0); PG8_BAR; PG8_MMA(0, 0, At, B0); PG8_MMA(0, 1, At, B1); PG8_BAR; PG8_SCHED;
            PG8_LDA(At, 0, 1); PG8_STAGE(PG8_SB(0, 0), b2, voffB); PG8_STAGE(PG8_SB(0, 1), b2 + hstepB, voffB); PG8_STAGE(PG8_SA(0, 0), a2, voffA);
            PG8_WAIT_V(8); PG8_WAIT_L(0); PG8_BAR; PG8_MMA(1, 0, At, B0); PG8_MMA(1, 1, At, B1); PG8_BAR; PG8_SCHED;
            PG8_LDB(B0, 1, 0); PG8_LDB(B1, 1, 1); PG8_SCHED; PG8_LDA(At, 1, 0); PG8_STAGE(PG8_SA(0, 1), a2 + hstepA, voffA);
            PG8_WAIT_V(8); PG8_WAIT_L(0); PG8_BAR; PG8_MMA(0, 0, At, B0); PG8_MMA(0, 1, At, B1); PG8_BAR; PG8_SCHED;
            PG8_LDA(At, 1, 1); PG8_STAGE(PG8_SB(1, 0), b3, voffB); PG8_STAGE(PG8_SB(1, 1), b3 + hstepB, voffB); PG8_STAGE(PG8_SA(1, 0), a3, voffA);
            PG8_WAIT_V(8); PG8_WAIT_L(0); PG8_BAR; PG8_MMA(1, 0, At, B0); PG8_MMA(1, 1, At, B1); PG8_BAR; PG8_SCHED;
            } else {
            PG8_LDB(B0, 0, 0); PG8_SCHED; PG8_LDA(At, 0, 0); PG8_STAGE(PG8_SA(1, 1), a1 + hstepA, voffA);
            PG8_WAIT_L(8); PG8_BAR; PG8_WAIT_L(0); PG8_MMA(0, 0, At, B0); PG8_BAR; PG8_SCHED;
            PG8_LDB(B1, 0, 1); PG8_STAGE(PG8_SB(0, 0), b2, voffB);
            PG8_BAR; PG8_WAIT_L(0); PG8_MMA(0, 1, At, B1); PG8_BAR;
            PG8_LDA(At, 0, 1); PG8_STAGE(PG8_SA(0, 0), a2, voffA);
            PG8_BAR; PG8_WAIT_L(0); PG8_MMA(1, 0, At, B0); PG8_BAR; PG8_SCHED;
            PG8_STAGE(PG8_SB(0, 1), b2 + hstepB, voffB);
            PG8_WAIT_V(6); PG8_BAR; PG8_MMA(1, 1, At, B1); PG8_BAR;
            PG8_LDB(B0, 1, 0); PG8_SCHED; PG8_LDA(At, 1, 0); PG8_STAGE(PG8_SA(0, 1), a2 + hstepA, voffA);
            PG8_WAIT_L(8); PG8_BAR; PG8_WAIT_L(0); PG8_MMA(0, 0, At, B0); PG8_BAR; PG8_SCHED;
            PG8_LDB(B1, 1, 1); PG8_STAGE(PG8_SB(1, 0), b3, voffB);
            PG8_BAR; PG8_WAIT_L(0); PG8_MMA(0, 1, At, B1); PG8_BAR;
            PG8_LDA(At, 1, 1); PG8_STAGE(PG8_SA(1, 0), a3, voffA);
            PG8_BAR; PG8_WAIT_L(0); PG8_MMA(1, 0, At, B0); PG8_BAR; PG8_SCHED;
            PG8_STAGE(PG8_SB(1, 1), b3 + hstepB, voffB);
            PG8_WAIT_V(6); PG8_BAR; PG8_MMA(1, 1, At, B1); PG8_BAR;
            }
        }
#if PROBE_G
        unsigned long long gt0_ = 0, gacc_ = 0; if constexpr ((PROBE_G >> Epi::PID) & 1) gt0_ = __builtin_amdgcn_s_memrealtime();
#define PG_SEG(k) if constexpr ((PROBE_G >> Epi::PID) & 1) { const unsigned long long tt_ = __builtin_amdgcn_s_memrealtime(); if (PROBE_GS == 0 || PROBE_GS == (k)) gacc_ += tt_ - gt0_; gt0_ = tt_; }
#else
#define PG_SEG(k)
#endif
        if constexpr (ALIGN_EPI) { if (wr == 0) PG8_BAR; }
        PG_SEG(1);
        if constexpr (!Epi::AFTER_DRAIN) { const int l_ = tid_of(wave_) & 63; E(acc, cur, wr, wc, l_ & 15, l_ >> 4); S.done(cur); }
        PG_SEG(2);
        if (!has_next) break;
#pragma unroll
        for (int a = 0; a < 2; ++a)
#pragma unroll
            for (int b = 0; b < 2; ++b)
#pragma unroll
                for (int m = 0; m < 4; ++m)
#pragma unroll
                    for (int n = 0; n < 2; ++n) acc[a][b][m][n] = (f32x4){0.f, 0.f, 0.f, 0.f};
        cur = nxt; cA = nA; cB = nB; ++ui;
        { const int t2_ = tid_of(wave_); PG8_VOFF(t2_); const int l2_ = t2_ & 63; aoff = lds_byte(wr * 64 + (l2_ & 15), (l2_ >> 4) * 8); boff = lds_byte(wc * 32 + (l2_ & 15), (l2_ >> 4) * 8); }
        if constexpr (ALIGN_EPI) { if (wr == 1) PG8_BAR; }
        PG_SEG(3);
#if PROBE_G
        if constexpr ((PROBE_G >> Epi::PID) & 1) { const unsigned long long t1_ = __builtin_amdgcn_s_memrealtime(), d_ = gacc_ * 2; while (__builtin_amdgcn_s_memrealtime() - t1_ < d_) __builtin_amdgcn_s_sleep(4); }
#endif
#undef PG_SEG
    }
    PG8_WAIT_V(0);
    if constexpr (!ALIGN_EPI) { if (wr == 0) PG8_BAR; }
    PG8_BAR;
    if constexpr (Epi::AFTER_DRAIN) { E.fused(acc, cur, wr, wc, fr, fq, lds, wid, lane); S.done(cur); }
#undef PG8_VOFF
#undef PG8_SA
#undef PG8_SB
#undef PG8_STAGE
#undef PG8_LDA
#undef PG8_LDB
#undef PG8_MMA
#undef PG8_WAIT_V
#undef PG8_WAIT_L
#undef PG8_BAR
#undef PG8_SCHED
}
}
namespace att {
constexpr int D = 128, NW = 8, QBLK = 32, KVBLK = 64;
constexpr float SCALE = 0.088388347648318440f;
constexpr float THR = 8.f;
constexpr size_t SHM_V = KVBLK * D * 2, SHM_K = KVBLK * D * 2, SHM_ATTN = 2 * SHM_V + 2 * SHM_K + NW * 64 * 4;
constexpr size_t SHM_RPB = SHM_ATTN;
#define KSWZ(row, colB) ((row) * 256 + ((colB) ^ (((row) & 7) << 4)))
#define SBAR() __builtin_amdgcn_sched_barrier(0)
DI int crow(int r, int hi) { return (r & 3) + 8 * (r >> 2) + 4 * hi; }
DI unsigned cvtpk(float lo, float hi) { unsigned r; asm volatile("v_cvt_pk_bf16_f32 %0, %1, %2" : "=v"(r) : "v"(lo), "v"(hi)); return r; }

struct NaCtx { int jlo; int dr0; int cq; int cs; const float* rpb; };

template <bool NA> DI void mask_bias(f32x16& p0, f32x16& p1, int j, const NaCtx& c, int hi) {
  if constexpr (NA) {
    const bool tv = (unsigned)(j - c.jlo) < 8u;
    int ri = c.dr0 + j + 7; ri = ri < 0 ? 0 : (ri > 14 ? 14 : ri);
    int boff = ri * 32 + 15 - c.cq + 4 * hi, t = 4 * hi - c.cs;
    asm volatile("" : "+v"(boff), "+v"(t));
    const float* bp = c.rpb + boff;
#pragma unroll
    for (int q4 = 0; q4 < 4; ++q4) {
#pragma unroll
      for (int rr = 0; rr < 4; ++rr) { const int r = 4 * q4 + rr;
        const int k0 = (r & 3) + 8 * (r >> 2);
        const bool ok0 = tv && ((unsigned)(t + k0) < 16u), ok1 = tv && ((unsigned)(t + k0 + 32) < 16u);
        const float b0 = bp[k0], b1 = bp[k0 + 32];
        p0[r] = ok0 ? p0[r] + b0 : -INFINITY; p1[r] = ok1 ? p1[r] + b1 : -INFINITY; }
      __builtin_amdgcn_sched_barrier(0);
    }
  }
}
DI void partialSM(f32x16& p0, f32x16& p1, float& m_reg, float& mn, float& alpha) {
  constexpr float C = SCALE * 1.4426950408889634f;
  float pmax = p0[0];
#pragma unroll
  for (int r = 1; r < 16; ++r) pmax = fmaxf(pmax, p0[r]);
#pragma unroll
  for (int r = 0; r < 16; ++r) pmax = fmaxf(pmax, p1[r]);
  { auto rr = __builtin_amdgcn_permlane32_swap(__float_as_uint(pmax), __float_as_uint(pmax), false, false);
    pmax = fmaxf(__uint_as_float(rr[0]), __uint_as_float(rr[1])); }
  if (__builtin_expect(__all(pmax - m_reg <= THR / SCALE), 1)) { mn = m_reg; alpha = 1.f; }
  else { mn = fmaxf(m_reg, pmax); alpha = __builtin_amdgcn_exp2f((m_reg - mn) * C); m_reg = mn; }
  float mnC = -mn * C;
#pragma unroll
  for (int r = 0; r < 16; ++r) p0[r] = fmaf(p0[r], C, mnC);
#pragma unroll
  for (int r = 0; r < 16; ++r) p1[r] = fmaf(p1[r], C, mnC);
#pragma unroll
  for (int r = 0; r < 16; ++r) p0[r] = __builtin_amdgcn_exp2f(p0[r]);
}
DI void finishSM(f32x16& p0, f32x16& p1, float alpha, float& l_reg, bf16x8& pa0, bf16x8& pa1, bf16x8& pa2, bf16x8& pa3) {
#pragma unroll
  for (int r = 0; r < 16; ++r) p1[r] = __builtin_amdgcn_exp2f(p1[r]);
  float ps = 0;
#pragma unroll
  for (int r = 0; r < 16; ++r) ps += p0[r];
#pragma unroll
  for (int r = 0; r < 16; ++r) ps += p1[r];
  { auto rr = __builtin_amdgcn_permlane32_swap(__float_as_uint(ps), __float_as_uint(ps), false, false);
    ps = __uint_as_float(rr[0]) + __uint_as_float(rr[1]); }
  l_reg = l_reg * alpha + ps;
#define PK4(P, BASE, OUT) do { unsigned a0 = cvtpk(P[BASE + 0], P[BASE + 1]), a1 = cvtpk(P[BASE + 2], P[BASE + 3]);   \
    unsigned b0 = cvtpk(P[BASE + 4], P[BASE + 5]), b1 = cvtpk(P[BASE + 6], P[BASE + 7]);                              \
    auto r0 = __builtin_amdgcn_permlane32_swap(a0, b0, false, false); auto r1 = __builtin_amdgcn_permlane32_swap(a1, b1, false, false); \
    v4u w = {r0[0], r1[0], r0[1], r1[1]}; OUT = *reinterpret_cast<bf16x8*>(&w); } while (0)
  PK4(p0, 0, pa0); PK4(p0, 8, pa1); PK4(p1, 0, pa2); PK4(p1, 8, pa3);
#undef PK4
}
DI void qkt(f32x16& p0, f32x16& p1, const bf16* Ks, const bf16x8* qr, int r32, int hi) {
  p0 = f32x16{}; p1 = f32x16{};
#pragma unroll
  for (int d0 = 0; d0 < 8; ++d0) { int cb = (d0 * 16 + hi * 8) * 2;
    bf16x8 b0 = *reinterpret_cast<const bf16x8*>((const char*)Ks + KSWZ(r32, cb));
    bf16x8 b1 = *reinterpret_cast<const bf16x8*>((const char*)Ks + KSWZ(32 + r32, cb));
    p0 = __builtin_amdgcn_mfma_f32_32x32x16_bf16(b0, qr[d0], p0, 0, 0, 0);
    p1 = __builtin_amdgcn_mfma_f32_32x32x16_bf16(b1, qr[d0], p1, 0, 0, 0); }
}
DI int v_st(int k, int c) { const int kk = (k & ~0xC) | ((k & 4) << 1) | ((k & 8) >> 1); return ((kk >> 3) * 4 + (c >> 5)) * 512 + ((kk & 7) * 32 + (c & 31)) * 2; }
DI int v_rd_base(int lane) { return ((lane & 3) << 3) | (((lane >> 2) & 3) << 6) | (((lane >> 4) & 1) << 5) | (((lane >> 5) & 1) << 8); }
constexpr int v_rd_off(int d0, int ks, int half) { return d0 * 512 + ks * 4096 + half * 2048; }
template <int OFF> DI s16x4 tr_read(int vb) { s16x4 r; asm volatile("ds_read_b64_tr_b16 %0, %1 offset:%2" : "=&v"(r) : "v"(vb), "i"(OFF) : "memory"); return r; }
template <int D0> DI void pv_one(f32x16& od, int vb, bf16x8 pa0, bf16x8 pa1, bf16x8 pa2, bf16x8 pa3) {
  const s16x4 l0 = tr_read<v_rd_off(D0, 0, 0)>(vb), h0 = tr_read<v_rd_off(D0, 0, 1)>(vb), l1 = tr_read<v_rd_off(D0, 1, 0)>(vb), h1 = tr_read<v_rd_off(D0, 1, 1)>(vb);
  const s16x4 l2 = tr_read<v_rd_off(D0, 2, 0)>(vb), h2 = tr_read<v_rd_off(D0, 2, 1)>(vb), l3 = tr_read<v_rd_off(D0, 3, 0)>(vb), h3 = tr_read<v_rd_off(D0, 3, 1)>(vb);
  asm volatile("s_waitcnt lgkmcnt(0)" ::: "memory"); SBAR();
#define PK(L, H) (bf16x8){L[0], L[1], L[2], L[3], H[0], H[1], H[2], H[3]}
  od = __builtin_amdgcn_mfma_f32_32x32x16_bf16(pa0, PK(l0, h0), od, 0, 0, 0);
  od = __builtin_amdgcn_mfma_f32_32x32x16_bf16(pa1, PK(l1, h1), od, 0, 0, 0);
  od = __builtin_amdgcn_mfma_f32_32x32x16_bf16(pa2, PK(l2, h2), od, 0, 0, 0);
  od = __builtin_amdgcn_mfma_f32_32x32x16_bf16(pa3, PK(l3, h3), od, 0, 0, 0);
#undef PK
}
DI void pv_d0(f32x16* o, int vb, bf16x8 pa0, bf16x8 pa1, bf16x8 pa2, bf16x8 pa3) {
  pv_one<0>(o[0], vb, pa0, pa1, pa2, pa3); pv_one<1>(o[1], vb, pa0, pa1, pa2, pa3); pv_one<2>(o[2], vb, pa0, pa1, pa2, pa3); pv_one<3>(o[3], vb, pa0, pa1, pa2, pa3);
}
template <int LDQ, int LDK, int LDO, bool NA, int SDEPTH>
DI void attn_body(const bf16* __restrict__ Qb, const bf16* __restrict__ Kh, const bf16* __restrict__ Vh, bf16* __restrict__ Ob, int NT, char* lds, const NaCtx& nc, int wave_, const float* __restrict__ nqw, int t0) {
  const int tid_ = tid_of(wave_);
  const int tid = tid_, wid = tid >> 6, lane = tid & 63, r32 = lane & 31, hi = lane >> 5;
  bf16* V_lds = (bf16*)lds; bf16* K_lds = (bf16*)(lds + 2 * SHM_V);
  float* ws = (float*)(lds + 2 * SHM_V + 2 * SHM_K) + wid * 64; float* li_l = ws; float* al_l = ws + 32;
  float m_reg = -1e30f, l_reg = 0; f32x16 o[4] = {}; bf16x8 qr[8];
  const bf16* Qw = Qb + (long)(wid * QBLK + r32) * LDQ + hi * 8;
#pragma unroll
  for (int d0 = 0; d0 < 8; ++d0) qr[d0] = *reinterpret_cast<const bf16x8*>(Qw + d0 * 16);
  {
      float y[8][8]; float ss = 0.f;
#pragma unroll
      for (int d0 = 0; d0 < 8; ++d0) { unpack8(__builtin_bit_cast(v4u, qr[d0]), y[d0]);
#pragma unroll
          for (int e = 0; e < 8; ++e) ss += y[d0][e] * y[d0][e]; }
      { auto rr = __builtin_amdgcn_permlane32_swap(__float_as_uint(ss), __float_as_uint(ss), false, false); ss = __uint_as_float(rr[0]) + __uint_as_float(rr[1]); }
      const float rstd = 1.f / sqrtf(ss * (1.f / 128.f) + EPSN);
#pragma unroll
      for (int d0 = 0; d0 < 8; ++d0) { const f32x4 w0 = *(const f32x4*)(nqw + d0 * 16 + hi * 8), w1 = *(const f32x4*)(nqw + d0 * 16 + hi * 8 + 4);
#pragma unroll
          for (int e = 0; e < 4; ++e) { y[d0][e] = y[d0][e] * rstd * w0[e]; y[d0][4 + e] = y[d0][4 + e] * rstd * w1[e]; } }
      if constexpr (!NA) {
          const int t = t0 + wid * QBLK + r32;
#pragma unroll
          for (int ax = 0; ax < 2; ++ax) { const float pos = (float)(ax ? (t & 63) : (t >> 6));
#pragma unroll
              for (int dl = 0; dl < 2; ++dl)
#pragma unroll
                  for (int e = 0; e < 8; ++e) { const int f = dl * 16 + hi * 8 + e;
                      float rev = pos * exp2f(-(float)f * (13.287712379549449f / 32.f)) * 0.15915494309189535f; rev -= floorf(rev);
                      const float sn = __builtin_amdgcn_sinf(rev), cs = __builtin_amdgcn_cosf(rev);
                      const float va = y[ax * 4 + dl][e], vb = y[ax * 4 + 2 + dl][e];
                      y[ax * 4 + dl][e] = va * cs - vb * sn; y[ax * 4 + 2 + dl][e] = va * sn + vb * cs; } } }
#pragma unroll
      for (int d0 = 0; d0 < 8; ++d0) qr[d0] = __builtin_bit_cast(bf16x8, pack8(y[d0]));
  }
  const int sr = tid >> 4, sc = (tid & 15) * 8, vst0 = v_st(sr, sc), vst1 = v_st(32 + sr, sc);
  const int vb0 = (int)(uintptr_t)V_lds + v_rd_base(lane);
  struct { bf16x8 vs0, vs1, ks0, ks1; } sr_[SDEPTH];
#define SLOAD(i, k0) do { sr_[i].vs0 = *reinterpret_cast<const bf16x8*>(&Vh[(long)((k0) + sr) * LDK + sc]); sr_[i].vs1 = *reinterpret_cast<const bf16x8*>(&Vh[(long)((k0) + 32 + sr) * LDK + sc]); \
    sr_[i].ks0 = *reinterpret_cast<const bf16x8*>(&Kh[(long)((k0) + sr) * LDK + sc]); sr_[i].ks1 = *reinterpret_cast<const bf16x8*>(&Kh[(long)((k0) + 32 + sr) * LDK + sc]); } while (0)
#define SWRITE(b, i) do { *(bf16x8*)((char*)V_lds + (b) * SHM_V + vst0) = sr_[i].vs0;          \
    *(bf16x8*)((char*)V_lds + (b) * SHM_V + vst1) = sr_[i].vs1; int kc = sc * 2;               \
    *(bf16x8*)((char*)K_lds + (b) * SHM_K + KSWZ(sr, kc)) = sr_[i].ks0;                       \
    *(bf16x8*)((char*)K_lds + (b) * SHM_K + KSWZ(32 + sr, kc)) = sr_[i].ks1; } while (0)
#define SWAIT() do { if constexpr (SDEPTH == 2) asm volatile("s_waitcnt vmcnt(4)" ::: "memory"); else asm volatile("s_waitcnt vmcnt(0)" ::: "memory"); } while (0)
#define RESC(a) do { if (__any((a) < 1.f)) { if (hi == 0) al_l[r32] = (a); asm volatile("s_waitcnt lgkmcnt(0)" ::: "memory"); \
    _Pragma("unroll") for (int d = 0; d < 4; ++d) _Pragma("unroll") for (int r = 0; r < 16; ++r) o[d][r] *= al_l[crow(r, hi)]; } } while (0)
  f32x16 pA0, pA1, pB0, pB1; float mnA, mnB, alA, alB; bf16x8 pa0, pa1, pa2, pa3;
  constexpr int SE = 0, SO = SDEPTH - 1;
  SLOAD(SE, 0); asm volatile("s_waitcnt vmcnt(0)" ::: "memory"); SWRITE(0, SE); __syncthreads();
#define ACT(jj) (!NA || (unsigned)((jj) - nc.jlo) < 8u)
  if (ACT(0)) { qkt(pA0, pA1, K_lds, qr, r32, hi); mask_bias<NA>(pA0, pA1, 0, nc, hi); partialSM(pA0, pA1, m_reg, mnA, alA); } else { alA = 1.f; }
  SLOAD(SO, KVBLK); if constexpr (SDEPTH == 2) { if (2 < NT) SLOAD(SE, 2 * KVBLK); }
  SWAIT(); SWRITE(1, SO); __syncthreads();
  if (wave_ >= 4) __builtin_amdgcn_s_setprio(1);
  for (int j = 1; j + 1 < NT; j += 2) {
    SBAR(); if (ACT(j)) { qkt(pB0, pB1, (bf16*)((char*)K_lds + SHM_K), qr, r32, hi); mask_bias<NA>(pB0, pB1, j, nc, hi); }
    if (ACT(j - 1)) finishSM(pA0, pA1, alA, l_reg, pa0, pa1, pa2, pa3); SBAR();
    SLOAD(SO, (j + SDEPTH) * KVBLK); SBAR();
    if (ACT(j - 1)) pv_d0(o, vb0, pa0, pa1, pa2, pa3);
    if (ACT(j)) partialSM(pB0, pB1, m_reg, mnB, alB); else alB = 1.f;
    __syncthreads(); SWAIT(); SWRITE(0, SE);
    RESC(alB); __syncthreads();
    SBAR(); if (ACT(j + 1)) { qkt(pA0, pA1, K_lds, qr, r32, hi); mask_bias<NA>(pA0, pA1, j + 1, nc, hi); }
    if (ACT(j)) finishSM(pB0, pB1, alB, l_reg, pa0, pa1, pa2, pa3); SBAR();
    if (SDEPTH == 1 || j + 3 < NT) SLOAD(SE, (j + 1 + SDEPTH) * KVBLK); SBAR();
    if (ACT(j)) pv_d0(o, vb0 + (int)SHM_V, pa0, pa1, pa2, pa3);
    if (ACT(j + 1)) partialSM(pA0, pA1, m_reg, mnA, alA); else alA = 1.f;
    __syncthreads(); SWAIT(); SWRITE(1, SO);
    RESC(alA); __syncthreads();
  }
  SBAR(); if (ACT(NT - 1)) { qkt(pB0, pB1, (bf16*)((char*)K_lds + SHM_K), qr, r32, hi); mask_bias<NA>(pB0, pB1, NT - 1, nc, hi); }
  if (ACT(NT - 2)) finishSM(pA0, pA1, alA, l_reg, pa0, pa1, pa2, pa3); SBAR();
  if (ACT(NT - 2)) pv_d0(o, vb0, pa0, pa1, pa2, pa3);
  if (ACT(NT - 1)) partialSM(pB0, pB1, m_reg, mnB, alB); else alB = 1.f;
  __syncthreads(); RESC(alB);
  if (ACT(NT - 1)) { finishSM(pB0, pB1, alB, l_reg, pa0, pa1, pa2, pa3); SBAR();
    pv_d0(o, vb0 + (int)SHM_V, pa0, pa1, pa2, pa3); }
#undef ACT
  __builtin_amdgcn_s_setprio(0);
  if (hi == 0) li_l[r32] = l_reg; asm volatile("s_waitcnt lgkmcnt(0)" ::: "memory");
  float rli[16];
#pragma unroll
  for (int r = 0; r < 16; ++r) rli[r] = __builtin_amdgcn_rcpf(li_l[crow(r, hi)]);
  bf16* Ow = Ob + (long)(wid * QBLK) * LDO;
#pragma unroll
  for (int r = 0; r < 16; ++r) { int orow = crow(r, hi);
#pragma unroll
    for (int d0 = 0; d0 < 4; ++d0) Ow[(long)orow * LDO + d0 * 32 + r32] = f2bf(o[d0][r] * rli[r]); }
  __syncthreads();
#undef SLOAD
#undef SWRITE
#undef SWAIT
#undef RESC
}
#undef KSWZ
#undef SBAR
}
#define XB_TMO      128
#define XB_XCNT(j)  (256  + 64 * (j))
#define XB_XSUB(j)  (1280 + 64 * (j))
#define XB_XGEN(j)  (2304 + 64 * (j))
#define XB_TOP      3328
#define XB_TOPGEN   3392
#define XCD_BAR_WORDS 3456
#define XB_SPIN_CAP (1u << 18)

__device__ __forceinline__ unsigned xb_ld(unsigned* p)              { return __hip_atomic_load(p, __ATOMIC_RELAXED, __HIP_MEMORY_SCOPE_AGENT); }
__device__ __forceinline__ unsigned xb_add(unsigned* p, unsigned v) { return __hip_atomic_fetch_add(p, v, __ATOMIC_RELAXED, __HIP_MEMORY_SCOPE_AGENT); }
__device__ __forceinline__ unsigned xb_xcc_id() { return (unsigned)__builtin_amdgcn_s_getreg((3 << 11) | 20) & 0xFu; }
#define XB_SPIN(cond, bar) do { unsigned _sp = 0; while (cond) { __builtin_amdgcn_s_sleep(1); \
    if ((++_sp & 255u) == 0u) { if (xb_ld(&(bar)[XB_TMO])) break; if (_sp > XB_SPIN_CAP) { atomicAdd(&(bar)[XB_TMO], 1u); break; } } } } while (0)

struct XcdBarrier {
    unsigned* bar; unsigned x; int wave;
    volatile LAS unsigned* st;
};

__device__ __forceinline__ XcdBarrier xcd_barrier_post(unsigned* bar, volatile LAS unsigned* st, int wave) {
    XcdBarrier b; b.bar = bar; b.x = xb_xcc_id(); b.st = st; b.wave = wave;
    if (wave == 0 && lane_id() == 0) (void)xb_add(&bar[XB_XCNT(b.x)], 1u);
    return b;
}
__device__ __forceinline__ void xcd_barrier_complete(unsigned* bar, unsigned x, unsigned& nloc, unsigned& nx) {
    const unsigned G = gridDim.x * gridDim.y * gridDim.z;
    unsigned sum, cnt, mine, sp = 0u;
    for (;;) {
        sum = 0u; cnt = 0u; mine = 0u;
#pragma unroll
        for (unsigned j = 0; j < 16; ++j) { const unsigned c = xb_ld(&bar[XB_XCNT(j)]); sum += c; cnt += (c > 0u) ? 1u : 0u; mine = (j == x) ? c : mine; }
        if (sum == G) break;
        __builtin_amdgcn_s_sleep(1);
        if ((++sp & 255u) == 0u) { if (xb_ld(&bar[XB_TMO])) break; if (sp > XB_SPIN_CAP) { atomicAdd(&bar[XB_TMO], 1u); break; } }
    }
    nloc = mine > 0u ? mine : 1u; nx = cnt > 0u ? cnt : 1u;
}

__device__ __forceinline__ void xcd_barrier(const XcdBarrier& b) {
    asm volatile("s_waitcnt vmcnt(0)" ::: "memory");
    __syncthreads();
    if (b.wave == 0 && tid_of(0) == 0) {
        unsigned* bar = b.bar;
        __builtin_amdgcn_s_waitcnt(0);
        unsigned nloc = b.st[0], nx = b.st[1];
        if (nloc == 0u) { xcd_barrier_complete(bar, b.x, nloc, nx); b.st[0] = nloc; b.st[1] = nx; }
        const unsigned old = xb_add(&bar[XB_XSUB(b.x)], 1u);
        const unsigned gen = old / nloc;
        if (old + 1u == (gen + 1u) * nloc) {
            __builtin_amdgcn_fence(__ATOMIC_RELEASE, "agent");
            asm volatile("s_waitcnt vmcnt(0)" ::: "memory");
            const unsigned og = xb_add(&bar[XB_TOP], 1u);
            const unsigned tg = og / nx;
            if (og + 1u == (tg + 1u) * nx) xb_add(&bar[XB_TOPGEN], 1u);
            else XB_SPIN(xb_ld(&bar[XB_TOPGEN]) == tg, bar);
            __builtin_amdgcn_fence(__ATOMIC_ACQUIRE, "agent");
            xb_add(&bar[XB_XGEN(b.x)], 1u);
            asm volatile("s_waitcnt vmcnt(0)" ::: "memory");
        } else {
            XB_SPIN(xb_ld(&bar[XB_XGEN(b.x)]) == gen, bar);
            __builtin_amdgcn_fence(__ATOMIC_ACQUIRE, "agent");
            asm volatile("s_waitcnt vmcnt(0)" ::: "memory");
        }
    }
    __syncthreads();
}
struct Ctx { int tid, lane, wave, G, blk; int gw, ngw; };

DI void tr_item(const float* __restrict__ W, int ldw, int K, bf16* __restrict__ WT, int k0, int n0, int drow0, const float* __restrict__ nw, LAS float* scr, int lane) {
    float tv[32];
#pragma unroll
    for (int i = 0; i < 32; ++i) tv[i] = W[(size_t)(k0 + 2 * i + (lane >> 5)) * ldw + n0 + (lane & 31)];
    if (nw) {
#pragma unroll
        for (int i = 0; i < 32; ++i) tv[i] *= nw[k0 + 2 * i + (lane >> 5)]; }
#pragma unroll
    for (int i = 0; i < 32; ++i) scr[(2 * i + (lane >> 5)) * 33 + (lane & 31)] = tv[i];
    LDS_WAIT(); asm volatile("" ::: "memory");
    const int c = lane & 7;
#pragma unroll
    for (int j = 0; j < 4; ++j) { const int n = (lane >> 3) + 8 * j; const LAS float* s = scr + (8 * c) * 33 + n;
        v4u o; o.x = pk2(s[0 * 33], s[1 * 33]); o.y = pk2(s[2 * 33], s[3 * 33]); o.z = pk2(s[4 * 33], s[5 * 33]); o.w = pk2(s[6 * 33], s[7 * 33]);
        *(v4u*)(WT + (size_t)(drow0 + n) * K + k0 + 8 * c) = o; }
    LDS_WAIT(); asm volatile("" ::: "memory");
}
struct WPtrs { const float *w_in, *w_br, *w_out, *w_up, *w_dn, *n1, *n2, *nssd; bf16 *t_in, *t_br, *t_out, *t_up, *t_dn; const float *cw, *cb; float* t_cw; };
DI void convert_weights(const Ctx& F, const WPtrs& P, LAS unsigned char* lds) {
    LAS float* scr = (LAS float*)(lds + F.wave * 8704);
    constexpr int I_IN = 32 * (NIN / 32), I_BR = 32 * 64, I_OUT = 32 * 64, I_UP = 32 * (NUP / 32), I_DN = (DFF / 64) * 64;
    constexpr int NITEMS = I_IN + I_BR + I_OUT + I_UP + I_DN;
    for (int it = F.gw; it < NITEMS; it += F.ngw) {
        int r = it;
        if (r < I_IN) { const int nblk = NIN / 32, kb = r / nblk, nb = r % nblk, n0 = nb * 32; tr_item(P.w_in, NIN, DM, P.t_in, kb * 64, n0, n0 < GATE_SRC0 ? n0 : n0 + (GATE_DST0 - GATE_SRC0), P.n1, scr, F.lane); continue; } r -= I_IN;
        if (r < I_BR) { const int kb = r / 64, nb = r % 64; tr_item(P.w_br, DM, DM, P.t_br, kb * 64, nb * 32, nb * 32, (kb >= 8 && kb < 24) ? P.nssd - 512 : nullptr, scr, F.lane); continue; } r -= I_BR;
        if (r < I_OUT) { const int kb = r / 64, nb = r % 64; tr_item(P.w_out, DM, DM, P.t_out, kb * 64, nb * 32, nb * 32, nullptr, scr, F.lane); continue; } r -= I_OUT;
        if (r < I_UP) { const int nblk = NUP / 32, kb = r / nblk, nb = r % nblk, n0 = nb * 32, isv = n0 >= DFF, nn = n0 - isv * DFF;
            tr_item(P.w_up, NUP, DM, P.t_up, kb * 64, n0, 256 * (nn >> 7) + 128 * isv + (nn & 127), P.n2, scr, F.lane); continue; } r -= I_UP;
        { const int kb = r / 64, nb = r % 64; tr_item(P.w_dn, DM, DFF, P.t_dn, kb * 64, nb * 32, nb * 32, nullptr, scr, F.lane); }
    }
    for (int i = F.gw * 64 + F.lane; i < 4 * DFF; i += F.ngw * 64) { const int blk = i >> 7, arr = (i >> 5) & 3, c = blk * 32 + (i & 31); P.t_cw[i] = arr < 3 ? P.cw[arr * DFF + c] : P.cb[c]; }
}
DI void xw_init(const Ctx& F, const float* __restrict__ xp, const float* __restrict__ xs, bf16* __restrict__ xw, float* __restrict__ rstd) {
    for (int m0 = 2 * F.gw; m0 < MTOT; m0 += 2 * F.ngw) {
        float s[2];
#pragma unroll
        for (int q = 0; q < 2; ++q) { const int m = m0 + q; const f32x4* xr = (const f32x4*)(m < LP ? xp + (size_t)m * DM : xs + (size_t)(m - LP) * DM) + F.lane;
            v2u* o8 = (v2u*)(xw + (size_t)m * DM) + F.lane; s[q] = 0.f;
#pragma unroll
            for (int j = 0; j < 8; ++j) { const f32x4 v = xr[64 * j]; s[q] += (v.x * v.x + v.y * v.y) + (v.z * v.z + v.w * v.w); v2u o; o.x = pk2(v.x, v.y); o.y = pk2(v.z, v.w); o8[64 * j] = o; } }
#pragma unroll
        for (int q = 0; q < 2; ++q) { const float t = wave_sum(s[q]); if (F.lane == 0) rstd[m0 + q] = 1.f / sqrtf(t * (1.f / DM) + EPSN); }
    }
}
struct PrepPtrs { bf16 *qna, *kna, *gq, *gk; const float *nq_na, *nk_na, *nq_g, *nk_g; };
DI void prep_qk(const Ctx& F, const PrepPtrs& P, int grp) {
    const int sub = F.lane >> 4, j = F.lane & 15;
    const int a = j >> 3, b = (j >> 2) & 1, f0 = (j & 3) * 8;
    float wk_na[8], wk_g[8], invf[8];
#pragma unroll
    for (int e = 0; e < 8; ++e) { wk_na[e] = P.nk_na[j * 8 + e]; wk_g[e] = P.nk_g[j * 8 + e];
        invf[e] = exp2f(-(float)(f0 + e) * (13.287712379549449f / 32.f)); }
    for (int tok = F.gw * 4 + sub; tok < MG; tok += F.ngw * 4) {
        const int t = tok - seq_start(grp, tok); const float pos = (float)(a ? (t & 63) : (t >> 6));
        float cs[8], sn[8];
#pragma unroll
        for (int e = 0; e < 8; ++e) { float rev = pos * invf[e] * 0.15915494309189535f; rev -= floorf(rev); sn[e] = __builtin_amdgcn_sinf(rev); cs[e] = __builtin_amdgcn_cosf(rev); }
        v4u raw[6];
#pragma unroll
        for (int v = 0; v < 6; ++v) { const bf16* p = v < 4 ? P.kna + (size_t)tok * 512 + v * 128 : P.gk + (size_t)tok * 256 + (v - 4) * 128;
            raw[v] = *(const v4u*)(p + j * 8); }
#pragma unroll
        for (int v = 0; v < 6; ++v) {
            bf16* p; const float* w; bool rope;
            if (v < 4) { p = P.kna + (size_t)tok * 512 + v * 128;       w = wk_na; rope = false; }
            else       { p = P.gk + (size_t)tok * 256 + (v - 4) * 128;  w = wk_g;  rope = true; }
            p += j * 8;
            float x[8]; unpack8(raw[v], x);
            float ss = 0.f;
#pragma unroll
            for (int e = 0; e < 8; ++e) ss += x[e] * x[e];
            ss += xor_lane<1>(ss); ss += xor_lane<2>(ss); ss += xor_lane<4>(ss); ss += xor_lane<8>(ss);
            const float rstd = 1.f / sqrtf(ss * (1.f / 128.f) + EPSN);
            float y[8];
#pragma unroll
            for (int e = 0; e < 8; ++e) y[e] = x[e] * rstd * w[e];
            if (rope) {
#pragma unroll
                for (int e = 0; e < 8; ++e) { const float pr = xor_lane<4>(y[e]); y[e] = b ? (pr * sn[e] + y[e] * cs[e]) : (y[e] * cs[e] - pr * sn[e]); }
            }
            *(v4u*)p = pack8(y);
        }
    }
}
DI void prep_xbc(const Ctx& F, const bf16* __restrict__ src, bf16* __restrict__ dst, const float* __restrict__ cw, const float* __restrict__ cb, int grp) {
    constexpr int NIT = (MG / 16) * 3;
    for (int it = F.gw; it < NIT; it += F.ngw) {
        const int tb = it / 3, cs = it % 3, c0 = cs * 512 + F.lane * 8, tok0 = tb * 16, slo = seq_start(grp, tok0), shi = slo + seq_len(grp, tok0);
        float w[5][8], bias[8];
#pragma unroll
        for (int i = 0; i < 5; ++i) { const f32x4 a = *(const f32x4*)(cw + i * 1536 + c0), bq = *(const f32x4*)(cw + i * 1536 + c0 + 4);
            w[i][0] = a.x; w[i][1] = a.y; w[i][2] = a.z; w[i][3] = a.w; w[i][4] = bq.x; w[i][5] = bq.y; w[i][6] = bq.z; w[i][7] = bq.w; }
        { const f32x4 a = *(const f32x4*)(cb + c0), bq = *(const f32x4*)(cb + c0 + 4); bias[0] = a.x; bias[1] = a.y; bias[2] = a.z; bias[3] = a.w; bias[4] = bq.x; bias[5] = bq.y; bias[6] = bq.z; bias[7] = bq.w; }
        v4u rw[20];
#pragma unroll
        for (int k = 0; k < 20; ++k) { const int t_ = tok0 - 2 + k; rw[k] = (t_ >= slo && t_ < shi) ? *(const v4u*)(src + (size_t)t_ * 1536 + c0) : (v4u){0u, 0u, 0u, 0u}; }
        float r[5][8];
        unpack8(rw[0], r[0]); unpack8(rw[1], r[1]); unpack8(rw[2], r[2]); unpack8(rw[3], r[3]);
#pragma unroll
        for (int k = 0; k < 16; ++k) {
            unpack8(rw[k + 4], r[4]);
            float y[8];
#pragma unroll
            for (int e = 0; e < 8; ++e) { float s = bias[e] + r[0][e] * w[0][e] + r[1][e] * w[1][e] + r[2][e] * w[2][e] + r[3][e] * w[3][e] + r[4][e] * w[4][e]; y[e] = siluf_(s); }
            *(v4u*)(dst + (size_t)(tok0 + k) * 1536 + c0) = pack8(y);
#pragma unroll
            for (int e = 0; e < 8; ++e) { r[0][e] = r[1][e]; r[1][e] = r[2][e]; r[2][e] = r[3][e]; r[3][e] = r[4][e]; }
        }
    }
}
DI void ffn_fix(const Ctx& F, const float* __restrict__ side, bf16* __restrict__ act, const float* __restrict__ cw) {
    constexpr int NB = MTOT / 256 - 1, NIT = NB * DFF;
    for (int it = F.blk * 512 + F.tid; it < NIT; it += F.G * 512) {
        const int pmb = it / DFF + 1, c = it % DFF;
        if (pmb * 256 >= LP && ((pmb * 256) & (LS - 1)) == 0) continue;
        const float* sb = side + (((size_t)(pmb - 1) * 2 + 1) * DFF + c) * 3; const float* st = side + (((size_t)pmb * 2 + 0) * DFF + c) * 3;
        const float s_bot = sb[0], v_bot = sb[1], a_bot = sb[2], s_top = st[0], v_top = st[1], a_top = st[2];
        act[(size_t)(pmb * 256 - 1) * DFF + c] = f2bf(siluf_(s_bot + cw[2 * DFF + c] * a_top) * v_bot);
        act[(size_t)(pmb * 256) * DFF + c] = f2bf(siluf_(s_top + cw[c] * a_bot) * v_top);
    }
}
namespace ssd {
constexpr int IMG = 32768;
DI unsigned off_b(unsigned row, unsigned ch) { return 256u * row + 16u * (ch ^ (((row & 3) << 2) | ((row >> 2) & 3))); }
DI bf16x8 row_read(const LAS unsigned char* img, unsigned lane, unsigned rowbase, unsigned s) {
    return *(const LAS bf16x8*)(img + off_b(rowbase + (lane & 31), 2 * s + (lane >> 5)));
}
DI s16x4 tr_read4(const LAS unsigned char* img, unsigned lane, unsigned r0, unsigned c) {
    const unsigned blk = (lane >> 4) & 1, q = (lane & 15) >> 2, p = lane & 3;
    const LAS unsigned char* a = img + off_b(r0 + q, 4 * c + 2 * blk + (p >> 1)) + 8 * (p & 1);
    return __builtin_bit_cast(s16x4, __builtin_amdgcn_ds_read_tr16_b64_v4i16((LAS s16x4*)a));
}
DI bf16x8 cat8(s16x4 lo, s16x4 hi) { return (bf16x8){lo[0], lo[1], lo[2], lo[3], hi[0], hi[1], hi[2], hi[3]}; }
DI int crow(int r, int hi) { return (r & 3) + 8 * (r >> 2) + 4 * hi; }
DI void stage_img(LAS unsigned char* img, const bf16* __restrict__ src, int ld, int tid) {
#pragma unroll
    for (int i = 0; i < 4; ++i) { const int id = tid + 512 * i, row = id >> 4, ch = id & 15;
        const v4u v = *(const v4u*)(src + (size_t)row * ld + ch * 8);
        *(LAS v4u*)(img + off_b(row, ch)) = v; }
}
DI void stage_ld(v4u (&v)[4], const bf16* __restrict__ src, int ld, int tid) {
#pragma unroll
    for (int i = 0; i < 4; ++i) { const int id = tid + 512 * i, row = id >> 4, ch = id & 15; v[i] = *(const v4u*)(src + (size_t)row * ld + ch * 8); }
}
DI void stage_st(LAS unsigned char* img, const v4u (&v)[4], int tid) {
#pragma unroll
    for (int i = 0; i < 4; ++i) { const int id = tid + 512 * i, row = id >> 4, ch = id & 15; *(LAS v4u*)(img + off_b(row, ch)) = v[i]; }
}
DI float softplusf_(float x) { return x > 20.f ? x : log1pf(__expf(x)); }
DI void dt_cum(const float* __restrict__ DT, int rowbase, int h, int dir, float bias, float a, int lane, float& dt0, float& dt1, float& c0, float& c1, float& tot) {
    const float r0 = DT[(size_t)(rowbase + 2 * lane) * 32 + dir * 16 + h], r1 = DT[(size_t)(rowbase + 2 * lane + 1) * 32 + dir * 16 + h];
    dt0 = softplusf_(r0 + bias); dt1 = softplusf_(r1 + bias);
    const float d0 = dt0 * a, d1 = dt1 * a;
    const float sc = wave_scan_incl(d0 + d1);
    tot = __int_as_float(__builtin_amdgcn_readlane(__float_as_int(sc), 63));
    if (dir == 0) { c1 = sc; c0 = sc - d1; }
    else { c1 = tot - sc + d1; c0 = tot - sc + d1 + d0; }
}
struct Ptrs {
    const bf16* xbca;
    const float* dt;
    const bf16* z;
    bf16* states;
    float* dec;
    bf16* o;
    float* rss;
    const float *dt_bias, *a_log, *dskip;
};
constexpr int L_B = 0, L_C = IMG, L_X0 = 2 * IMG, L_X1 = 3 * IMG, L_ARR = 4 * IMG, L_SSQ = 4 * IMG + 8192;

DI void s1_unit(const Ptrs& P, LAS unsigned char* lds, int c, int g, int tid) {
    const int lane = tid & 63, w = __builtin_amdgcn_readfirstlane(tid >> 6), hl = w >> 1, nh = w & 1, hh = lane >> 5, r = lane & 31;
    const int rowbase = c * 128;
    __syncthreads();
    v4u xa[4], xb[4];
    stage_ld(xa, P.xbca + (size_t)rowbase * 1536 + 8 * g * 64, 1536, tid); stage_ld(xb, P.xbca + (size_t)rowbase * 1536 + 8 * g * 64 + 128, 1536, tid);
    stage_img(lds + L_B, P.xbca + (size_t)rowbase * 1536 + 1024 + g * 128, 1536, tid);
#pragma unroll 1
    for (int quad = 0; quad < 2; ++quad) {
        const int hq = 8 * g + 4 * quad;
        if (quad) __syncthreads();
        stage_st(lds + L_X0, xa, tid); stage_st(lds + L_X1, xb, tid);
        if (quad == 0) { stage_ld(xa, P.xbca + (size_t)rowbase * 1536 + (hq + 4) * 64, 1536, tid); stage_ld(xb, P.xbca + (size_t)rowbase * 1536 + (hq + 4) * 64 + 128, 1536, tid); }
        {
            const int h = hq + hl, dir = nh; float dt0, dt1, c0, c1, tot;
            dt_cum(P.dt, rowbase, h, dir, P.dt_bias[dir * 16 + h], -__expf(P.a_log[dir * 16 + h]), lane, dt0, dt1, c0, c1, tot);
            LAS float* wg = (LAS float*)(lds + L_ARR) + (hl * 2 + dir) * 128;
            wg[2 * lane] = dt0 * __expf(tot - c0); wg[2 * lane + 1] = dt1 * __expf(tot - c1);
            if (lane == 0) P.dec[(size_t)(c * 2 + dir) * 16 + h] = __expf(tot);
        }
        __syncthreads();
        const LAS unsigned char* ximg = lds + (hl >> 1 ? L_X1 : L_X0);
        const int h = hq + hl;
#pragma unroll 1
        for (int dir = 0; dir < 2; ++dir) {
            const LAS float* wg = (const LAS float*)(lds + L_ARR) + (hl * 2 + dir) * 128;
            f32x16 acc[2][2];
#pragma unroll
            for (int i = 0; i < 2; ++i)
#pragma unroll
                for (int k = 0; k < 2; ++k) acc[i][k] = f32x16{};
#pragma unroll 2
            for (int ks = 0; ks < 8; ++ks) {
                bf16x8 af[2], bfr[2];
#pragma unroll
                for (int nb = 0; nb < 2; ++nb) af[nb] = cat8(tr_read4(lds + L_B, lane, 16 * ks + 8 * hh, 2 * nh + nb), tr_read4(lds + L_B, lane, 16 * ks + 8 * hh + 4, 2 * nh + nb));
                const f32x4 w0 = *(const LAS f32x4*)(wg + 16 * ks + 8 * hh), w1 = *(const LAS f32x4*)(wg + 16 * ks + 8 * hh + 4);
#pragma unroll
                for (int pb = 0; pb < 2; ++pb) {
                    const s16x4 lo = tr_read4(ximg, lane, 16 * ks + 8 * hh, 2 * (hl & 1) + pb), hi4 = tr_read4(ximg, lane, 16 * ks + 8 * hh + 4, 2 * (hl & 1) + pb);
                    v4u pk; pk.x = pk2(bf2f((unsigned short)lo[0]) * w0.x, bf2f((unsigned short)lo[1]) * w0.y); pk.y = pk2(bf2f((unsigned short)lo[2]) * w0.z, bf2f((unsigned short)lo[3]) * w0.w);
                    pk.z = pk2(bf2f((unsigned short)hi4[0]) * w1.x, bf2f((unsigned short)hi4[1]) * w1.y); pk.w = pk2(bf2f((unsigned short)hi4[2]) * w1.z, bf2f((unsigned short)hi4[3]) * w1.w);
                    bfr[pb] = __builtin_bit_cast(bf16x8, pk);
                }
#pragma unroll
                for (int nb = 0; nb < 2; ++nb)
#pragma unroll
                    for (int pb = 0; pb < 2; ++pb) acc[nb][pb] = __builtin_amdgcn_mfma_f32_32x32x16_bf16(af[nb], bfr[pb], acc[nb][pb], 0, 0, 0);
            }
            bf16* sp = P.states + ((size_t)(c * 2 + dir) * 16 + h) * 8192;
#pragma unroll
            for (int nb = 0; nb < 2; ++nb)
#pragma unroll
                for (int pb = 0; pb < 2; ++pb)
#pragma unroll
                    for (int i4 = 0; i4 < 4; ++i4) {
                        v2u o; o.x = pk2(acc[nb][pb][4 * i4], acc[nb][pb][4 * i4 + 1]); o.y = pk2(acc[nb][pb][4 * i4 + 2], acc[nb][pb][4 * i4 + 3]);
                        *(v2u*)(sp + ((((4 * nh + 2 * nb + (i4 >> 1)) * 2 + pb) * 64 + r + 32 * (i4 & 1)) * 8 + 4 * hh)) = o; }
        }
    }
}
template <int BATCH>
DI void scan_states(const Ctx& F, bf16* __restrict__ states, const float* __restrict__ dec, int grp) {
    const int nseq = grp == 0 ? 5 : 12, ntask = nseq * 65536, nthr = F.G * 512;
    for (int task = F.blk * 512 + F.tid; task < ntask; task += nthr) {
        const int n4 = task & 31, p = (task >> 5) & 63, h = (task >> 11) & 15, dir = (task >> 15) & 1, s = task >> 16;
        const int ncs = (grp == 0 && s == 0) ? LP / 128 : LS / 128, cbase = grp == 0 ? (s == 0 ? 0 : LP / 128 + (s - 1) * (LS / 128)) : s * (LS / 128);
        float run[4] = {0.f, 0.f, 0.f, 0.f};
#pragma unroll 1
        for (int k0 = 0; k0 < ncs; k0 += BATCH) {
            v2u v[BATCH]; float dc[BATCH];
#pragma unroll
            for (int k = 0; k < BATCH; ++k) { const int cc = cbase + (dir ? ncs - 1 - (k0 + k) : (k0 + k));
                v[k] = *(const v2u*)(states + (((size_t)(cc * 2 + dir) * 16 + h) * 64 + p) * 128 + n4 * 4); dc[k] = dec[(size_t)(cc * 2 + dir) * 16 + h]; }
#pragma unroll
            for (int k = 0; k < BATCH; ++k) { const int cc = cbase + (dir ? ncs - 1 - (k0 + k) : (k0 + k));
                v2u o; o.x = pk2(run[0], run[1]); o.y = pk2(run[2], run[3]);
                *(v2u*)(states + (((size_t)(cc * 2 + dir) * 16 + h) * 64 + p) * 128 + n4 * 4) = o;
                run[0] = run[0] * dc[k] + bflo(v[k].x); run[1] = run[1] * dc[k] + bfhi(v[k].x); run[2] = run[2] * dc[k] + bflo(v[k].y); run[3] = run[3] * dc[k] + bfhi(v[k].y); }
        }
    }
}
#ifndef PROBE_S3
#define PROBE_S3 0
#endif
#define S3_T0() unsigned long long st0_ = 0; if (PROBE_S3) st0_ = __builtin_amdgcn_s_memrealtime()
#define S3_T1(id) do { if (PROBE_S3 == (id)) { const unsigned long long t1_ = __builtin_amdgcn_s_memrealtime(), d_ = (t1_ - st0_) * 2; while (__builtin_amdgcn_s_memrealtime() - t1_ < d_) __builtin_amdgcn_s_sleep(8); } if (PROBE_S3) st0_ = __builtin_amdgcn_s_memrealtime(); } while (0)
template <int QUAD>
DI void s3_pass(const Ptrs& P, LAS unsigned char* lds, int c, int g, int tid) {
    const int lane_o = tid & 63, w = __builtin_amdgcn_readfirstlane(tid >> 6), hl = w >> 1, lh = w & 1;
    const int rowbase = c * 128, hq = 8 * g + 4 * QUAD, h = hq + hl;
    S3_T0();
    if (QUAD) __syncthreads();
    stage_img(lds + L_X0, P.xbca + (size_t)rowbase * 1536 + hq * 64, 1536, tid);
    stage_img(lds + L_X1, P.xbca + (size_t)rowbase * 1536 + hq * 64 + 128, 1536, tid);
    LAS float* arr = (LAS float*)(lds + L_ARR);
    {   const int dir = lh, lane = lane_o; float dt0, dt1, c0, c1, tot;
        dt_cum(P.dt, rowbase, h, dir, P.dt_bias[dir * 16 + h], -__expf(P.a_log[dir * 16 + h]), lane, dt0, dt1, c0, c1, tot);
        LAS float* a = arr + hl * 512;
        a[dir * 128 + 2 * lane] = dt0; a[dir * 128 + 2 * lane + 1] = dt1; a[(2 + dir) * 128 + 2 * lane] = c0; a[(2 + dir) * 128 + 2 * lane + 1] = c1; }
    __syncthreads();
    S3_T1(2);
    const LAS float* aD0 = arr + hl * 512, *aD1 = aD0 + 128, *aCF = aD0 + 256, *aCR = aD0 + 384;
    const LAS unsigned char* ximg = lds + (hl >> 1 ? L_X1 : L_X0);
    const bf16* pf = P.states + ((size_t)(c * 2 + 0) * 16 + h) * 8192, *pb_ = P.states + ((size_t)(c * 2 + 1) * 16 + h) * 8192;
    const float dsk = P.dskip[h];
    LAS float* ssq = (LAS float*)(lds + L_SSQ);
#pragma unroll 1
    for (int lb = 0; lb < 2; ++lb) {
        f32x16 acc[2];
        acc[0] = f32x16{}; acc[1] = f32x16{};
        int ln_ = lane_o; asm volatile("" : "+v"(ln_)); const int lane = ln_, hh = lane >> 5, r = lane & 31;
        const int l0 = 64 * lh + 32 * lb, l = l0 + r; const float cf_l = aCF[l], cr_l = aCR[l];
#pragma unroll 1
        for (int sb = 0; sb < 4; ++sb) {
            const int s0 = 32 * sb;
            f32x16 X = f32x16{};
            {   bf16x8 bq[8];
#pragma unroll
                for (int ks = 0; ks < 8; ++ks) bq[ks] = row_read(lds + L_B, lane, s0, ks);
                __builtin_amdgcn_sched_barrier(0);
#pragma unroll
                for (int ks = 0; ks < 8; ++ks) X = __builtin_amdgcn_mfma_f32_32x32x16_bf16(bq[ks], row_read(lds + L_C, lane, l0, ks), X, 0, 0, 0); }
            {   const bool needf = s0 <= l0 + 31, needb = s0 + 31 >= l0; const int sb4 = s0 + 4 * hh;
                f32x4 fac[4];
#pragma unroll
                for (int q = 0; q < 4; ++q) fac[q] = (f32x4){0.f, 0.f, 0.f, 0.f};
                if (needf) { f32x4 cs[4], ds[4];
#pragma unroll
                    for (int q = 0; q < 4; ++q) { cs[q] = *(const LAS f32x4*)(aCF + sb4 + 8 * q); ds[q] = *(const LAS f32x4*)(aD0 + sb4 + 8 * q); }
#pragma unroll
                    for (int q = 0; q < 4; ++q)
#pragma unroll
                        for (int e = 0; e < 4; ++e) { const float t = __expf(fminf(cf_l - cs[q][e], 0.f)) * ds[q][e]; fac[q][e] += (sb4 + 8 * q + e <= l) ? t : 0.f; } }
                if (needb) { f32x4 cs[4], ds[4];
#pragma unroll
                    for (int q = 0; q < 4; ++q) { cs[q] = *(const LAS f32x4*)(aCR + sb4 + 8 * q); ds[q] = *(const LAS f32x4*)(aD1 + sb4 + 8 * q); }
#pragma unroll
                    for (int q = 0; q < 4; ++q)
#pragma unroll
                        for (int e = 0; e < 4; ++e) { const float t = __expf(fminf(cr_l - cs[q][e], 0.f)) * ds[q][e]; fac[q][e] += (sb4 + 8 * q + e >= l) ? t : 0.f; } }
#pragma unroll
                for (int q = 0; q < 4; ++q)
#pragma unroll
                    for (int e = 0; e < 4; ++e) X[4 * q + e] *= fac[q][e];
            }
            {   bf16x8 xf[2][2];
#pragma unroll
                for (int sp = 0; sp < 2; ++sp)
#pragma unroll
                    for (int pb = 0; pb < 2; ++pb) xf[sp][pb] = cat8(tr_read4(ximg, lane, s0 + 16 * sp + 4 * hh, 2 * (hl & 1) + pb), tr_read4(ximg, lane, s0 + 16 * sp + 8 + 4 * hh, 2 * (hl & 1) + pb));
                __builtin_amdgcn_sched_barrier(0);
#pragma unroll
                for (int sp = 0; sp < 2; ++sp) {
                    v4u pk; pk.x = pk2(X[8 * sp], X[8 * sp + 1]); pk.y = pk2(X[8 * sp + 2], X[8 * sp + 3]); pk.z = pk2(X[8 * sp + 4], X[8 * sp + 5]); pk.w = pk2(X[8 * sp + 6], X[8 * sp + 7]);
                    const bf16x8 af = __builtin_bit_cast(bf16x8, pk);
#pragma unroll
                    for (int pb = 0; pb < 2; ++pb) acc[pb] = __builtin_amdgcn_mfma_f32_32x32x16_bf16(af, xf[sp][pb], acc[pb], 0, 0, 0);
                } }
        }
        S3_T1(3);
        {
            const float ef = __expf(cf_l), eb = __expf(cr_l);
            int r2 = r; asm volatile("" : "+v"(r2));
            bf16x8 sF[4][2], sB[4][2];
#define S3_LD(ks_, sl_) do { _Pragma("unroll") for (int pb = 0; pb < 2; ++pb) { sF[sl_][pb] = *(const bf16x8*)(pf + (((ks_) * 2 + pb) * 64 + r2 + 32 * hh) * 8); sB[sl_][pb] = *(const bf16x8*)(pb_ + (((ks_) * 2 + pb) * 64 + r2 + 32 * hh) * 8); } } while (0)
            S3_LD(0, 0); S3_LD(1, 1); S3_LD(2, 2); S3_LD(3, 3);
#pragma unroll
            for (int ks = 0; ks < 8; ++ks) {
                const bf16x8 cfr = row_read(lds + L_C, lane, l0, ks);
                float x[8]; unpack8(__builtin_bit_cast(v4u, cfr), x);
                float xf[8], xb[8];
#pragma unroll
                for (int e = 0; e < 8; ++e) { xf[e] = x[e] * ef; xb[e] = x[e] * eb; }
                const bf16x8 aF = __builtin_bit_cast(bf16x8, pack8(xf)), aB = __builtin_bit_cast(bf16x8, pack8(xb));
#pragma unroll
                for (int pb = 0; pb < 2; ++pb) { acc[pb] = __builtin_amdgcn_mfma_f32_32x32x16_bf16(aF, sF[ks & 3][pb], acc[pb], 0, 0, 0);
                    acc[pb] = __builtin_amdgcn_mfma_f32_32x32x16_bf16(aB, sB[ks & 3][pb], acc[pb], 0, 0, 0); }
                if (ks + 4 < 8) S3_LD(ks + 4, ks & 3);
            }
#undef S3_LD
        }
        S3_T1(4);
        {
            unsigned short zr[2][16]; int r3 = r; asm volatile("" : "+v"(r3));
#pragma unroll
            for (int i = 0; i < 16; ++i)
#pragma unroll
                for (int pb = 0; pb < 2; ++pb) zr[pb][i] = P.z[(size_t)(rowbase + l0 + crow(i, hh)) * 1024 + h * 64 + 32 * pb + r3];
            float sqv[16];
#pragma unroll
            for (int i = 0; i < 16; ++i) {
                const int li = l0 + crow(i, hh);
                float sq = 0.f;
#pragma unroll
                for (int pb = 0; pb < 2; ++pb) {
                    const int p = 32 * pb + r3, col = (hl & 1) * 64 + p;
                    const float xs = bf2f(*(const LAS unsigned short*)(ximg + off_b(li, col >> 3) + 2 * (col & 7)));
                    const float y = (acc[pb][i] + dsk * xs) * siluf_(bf2f(zr[pb][i]));
                    P.o[(size_t)(rowbase + li) * 2048 + 512 + h * 64 + p] = f2bf(y); sq += y * y;
                }
                sqv[i] = sq;
            }
            {   const bool c8 = (r3 & 8) != 0, c4 = (r3 & 4) != 0, c2 = (r3 & 2) != 0, c1 = (r3 & 1) != 0;
                float a8[8], a4[4], a2[2];
#pragma unroll
                for (int k = 0; k < 8; ++k) a8[k] = (c8 ? sqv[k + 8] : sqv[k]) + dppx<0x140>(c8 ? sqv[k] : sqv[k + 8]);
#pragma unroll
                for (int k = 0; k < 4; ++k) a4[k] = (c4 ? a8[k + 4] : a8[k]) + dppx<0x141>(c4 ? a8[k] : a8[k + 4]);
#pragma unroll
                for (int k = 0; k < 2; ++k) a2[k] = (c2 ? a4[k + 2] : a4[k]) + dppx<0x1b>(c2 ? a4[k] : a4[k + 2]);
                float tot = (c1 ? a2[1] : a2[0]) + dppx<0xb1>(c1 ? a2[0] : a2[1]);
                tot += xor_lane<16>(tot);
                if (r3 < 16) ssq[(QUAD * 4 + hl) * 128 + l0 + crow(r3, hh)] = tot;
            }
        }
        S3_T1(5);
    }
}
DI void s3_rstd(const Ptrs& P, LAS unsigned char* lds, int c, int g, int tid) {
    if (tid < 128) { const LAS float* ssq = (const LAS float*)(lds + L_SSQ);
        float tot = 0.f;
#pragma unroll
        for (int k = 0; k < 8; ++k) tot += ssq[k * 128 + tid];
        P.rss[(size_t)(c * 128 + tid) * 2 + g] = 1.f / sqrtf(tot * (1.f / 512.f) + EPSN); }
}
DI void s3_unit(const Ptrs& P, LAS unsigned char* lds, int c, int g, int tid) {
    const int rowbase = c * 128;
    S3_T0();
    __syncthreads();
    stage_img(lds + L_B, P.xbca + (size_t)rowbase * 1536 + 1024 + g * 128, 1536, tid);
    stage_img(lds + L_C, P.xbca + (size_t)rowbase * 1536 + 1280 + g * 128, 1536, tid);
    S3_T1(1);
    s3_pass<0>(P, lds, c, g, tid);
    s3_pass<1>(P, lds, c, g, tid);
    __syncthreads();
    if (PROBE_S3) st0_ = __builtin_amdgcn_s_memrealtime();
    s3_rstd(P, lds, c, g, tid);
    S3_T1(6);
}
}
constexpr size_t MiB = 1u << 20;
constexpr size_t WS_CTL = 0, CTL_ZERO_BYTES = 1 * MiB, WS_CW = 1 * MiB, CW_LAYER = 128 * 1024;
constexpr size_t WS_W = 2 * MiB, W_LAYER = 127 * MiB;
constexpr size_t W_TIN = 0, W_TBR = 45 * MiB, W_TOUT = 53 * MiB, W_TUP = 61 * MiB, W_TDN = 105 * MiB;
static_assert(W_TIN + (size_t)NINP * DM * 2 <= W_TBR && W_TUP + (size_t)NUP * DM * 2 <= W_TDN && W_TDN + (size_t)DM * DFF * 2 <= W_LAYER, "weights map");
constexpr size_t WS_R1 = 256 * MiB;
constexpr size_t R_QNA = 0, R_KNA = 24 * MiB, R_VNA = 48 * MiB, R_GQ = 72 * MiB, R_GK = 96 * MiB, R_GV = 108 * MiB, R_Z = 120 * MiB, R_XBC = 168 * MiB, R_DT = 240 * MiB, R_GATE = 243 * MiB;
constexpr size_t WS_XBCA = 643 * MiB, WS_ST = 715 * MiB, WS_O = 811 * MiB, WS_TMPF = 907 * MiB, WS_MRG = 907 * MiB, WS_DEC = 1003 * MiB, WS_SIDE = 1004 * MiB, WS_XW = 1030 * MiB, WS_STAT = 1222 * MiB, WS_END = 1226 * MiB;
constexpr size_t ST_SSQ = 0, ST_RSS = 1536 * 1024, ST_RSTD1 = 2 * MiB, ST_RSTD2 = 3 * MiB;
constexpr size_t WS_ACT = 256 * MiB;
static_assert(WS_W + 2 * W_LAYER <= WS_R1 && WS_R1 + R_GATE + (size_t)MG * 6144 <= WS_XBCA && R_DT + (size_t)MG * 32 * 4 <= R_GATE && WS_XBCA + (size_t)MG * 1536 * 2 <= WS_ST && WS_ST + (size_t)(MG / 128) * 2 * 16 * 8192 * 2 <= WS_O
              && WS_O + (size_t)MG * DM * 2 <= WS_TMPF && WS_TMPF + (size_t)MG * 1024 * 4 <= WS_DEC && WS_MRG + (size_t)MG * DM * 2 <= WS_DEC && WS_SIDE + (size_t)(MTOT / 256) * 6 * DFF * 4 <= WS_XW
              && WS_XW + (size_t)MTOT * DM * 2 <= WS_STAT && WS_ACT + (size_t)MTOT * DFF * 2 <= WS_DEC && ST_SSQ + (size_t)MTOT * 8 * 4 <= ST_RSS && ST_RSS + (size_t)MG * 8 <= ST_RSTD1 && WS_STAT + 4 * MiB <= WS_END, "activation map");
constexpr int CW_BAR = 4096;
constexpr int CW_CNT = 8192, CNT_USE = (MTOT / 256) * 16;
static_assert((CW_CNT + 2 * DEPTH * CNT_USE) * 4 <= (int)CTL_ZERO_BYTES, "counters inside the per-launch memset");

constexpr int LDS_BYTES = 147456, MISC_OFF = LDS_BYTES - 256, EX_OFF = 131072;

#ifndef PROBE_MASK
#define PROBE_MASK 0
#endif
#define PROBE_K 2
#define PROBE_T0() unsigned long long pt0_ = 0; if (PROBE_MASK) pt0_ = __builtin_amdgcn_s_memrealtime()
#define PROBE_T1(id) do { if ((PROBE_MASK >> (id)) & 1) { const unsigned long long t1_ = __builtin_amdgcn_s_memrealtime(), d_ = (t1_ - pt0_) * PROBE_K; \
    while (__builtin_amdgcn_s_memrealtime() - t1_ < d_) __builtin_amdgcn_s_sleep(32); GRID_BAR(); } if (PROBE_MASK) pt0_ = __builtin_amdgcn_s_memrealtime(); } while (0)
struct Args { const float* in[22]; float* out; unsigned char* ws; };

#define REFRESH() do { const int tv_ = tid_of(F.wave); F.tid = tv_; F.lane = tv_ & 63; } while (0)
#define GRID_BAR() do { XcdBarrier b_ = bar; asm volatile("" : "+s"(b_.bar)); b_.bar = (unsigned*)(GAS unsigned*)b_.bar; b_.x = xb_xcc_id(); xcd_barrier(b_); REFRESH(); } while (0)
#define W_PTRS(l)   \
    unsigned char* WL = ws + WS_W + (size_t)((l) & 1) * W_LAYER; \
    bf16* T_IN = (bf16*)(WL + W_TIN); bf16* T_BR = (bf16*)(WL + W_TBR); bf16* T_OUT = (bf16*)(WL + W_TOUT); bf16* T_UP = (bf16*)(WL + W_TUP); bf16* T_DN = (bf16*)(WL + W_TDN);
#define MK_WP(l) WPtrs WP{GIN(3) + (size_t)(l) * DM * NIN, GIN(15) + (size_t)(l) * DM * DM, GIN(16) + (size_t)(l) * DM * DM, GIN(18) + (size_t)(l) * DM * NUP, GIN(21) + (size_t)(l) * DFF * DM, \
    GIN(2) + (l) * DM, GIN(17) + (l) * DM, GIN(12) + (l) * 1024, T_IN, T_BR, T_OUT, T_UP, T_DN, GIN(19) + (size_t)(l) * 3 * DFF, GIN(20) + (size_t)(l) * DFF, (float*)(ws + WS_CW + (size_t)((l) & 1) * CW_LAYER)}
#define OPQ_PTRS() \
    unsigned char* R1 = ws + WS_R1; \
    bf16* QNA = (bf16*)(R1 + R_QNA); bf16* KNA = (bf16*)(R1 + R_KNA); bf16* VNA = (bf16*)(R1 + R_VNA); bf16* GQ = (bf16*)(R1 + R_GQ); bf16* GK = (bf16*)(R1 + R_GK); bf16* GV = (bf16*)(R1 + R_GV); \
    bf16* Z = (bf16*)(R1 + R_Z); bf16* XBC = (bf16*)(R1 + R_XBC); float* DT = (float*)(R1 + R_DT); unsigned char* GATE = (unsigned char*)(R1 + R_GATE); \
    bf16* XBCA = (bf16*)(ws + WS_XBCA); bf16* ST = (bf16*)(ws + WS_ST); bf16* O = (bf16*)(ws + WS_O); float* TMPF = (float*)(ws + WS_TMPF); bf16* MRG = (bf16*)(ws + WS_MRG); \
    float* DEC = (float*)(ws + WS_DEC); bf16* ACT = (bf16*)(ws + WS_ACT); float* SIDE = (float*)(ws + WS_SIDE); bf16* XWA = (bf16*)(ws + WS_XW); \
    float* SSQ = (float*)(ws + WS_STAT + ST_SSQ); float* RSS = (float*)(ws + WS_STAT + ST_RSS); float* RSTD1 = (float*)(ws + WS_STAT + ST_RSTD1); float* RSTD2 = (float*)(ws + WS_STAT + ST_RSTD2); unsigned* CNT = (unsigned*)(ws + WS_CTL) + CW_CNT;
#define NA_UNIT(u) do {   \
    const int b = (u) >> 2, h = (u) & 3, row0 = b * 256, L = seq_len(grp, row0), seq0 = seq_start(grp, row0), rows = L / 64, r0 = (row0 - seq0) >> 6; \
    int rs0 = r0 - 4; rs0 = rs0 < 0 ? 0 : (rs0 > rows - 8 ? rows - 8 : rs0); \
    const int NT = (r0 == 0 || r0 == rows - 4) ? 8 : 12; \
    __syncthreads(); \
    {   LAS float* rp = (LAS float*)(lds + att::SHM_RPB); const float* src = GIN(6) + ((size_t)layer * 4 + h) * 15 * 31; \
        for (int i = tid_of(F.wave); i < 15 * 31; i += 512) rp[(i / 31) * 32 + (i % 31)] = src[i] * (1.f / att::SCALE); } \
    const int r = r0 + (F.wave >> 1); int rs = r - 4; rs = rs < 0 ? 0 : (rs > rows - 8 ? rows - 8 : rs); \
    const int cq = 32 * (F.wave & 1) + (tid_of(F.wave) & 31); int cs = cq - 8; cs = cs < 0 ? 0 : (cs > 48 ? 48 : cs); \
    att::NaCtx nc{__builtin_amdgcn_readfirstlane(rs - rs0), __builtin_amdgcn_readfirstlane(rs0 - r), cq, cs, (const float*)(lds_raw + att::SHM_RPB)}; \
    att::attn_body<512, 512, 2048, true, 1>(QNA + (size_t)row0 * 512 + h * 128, KNA + (size_t)(seq0 + rs0 * 64) * 512 + h * 128, VNA + (size_t)(seq0 + rs0 * 64) * 512 + h * 128, \
                                         O + (size_t)row0 * 2048 + h * 128, NT, (char*)lds_raw, nc, F.wave, GIN(4) + layer * 128, 0); } while (0)
__global__ void __launch_bounds__(512, 2) fwd_kernel(Args args) {
    extern __shared__ __attribute__((aligned(16))) unsigned char lds_raw[];
    LAS unsigned char* lds = (LAS unsigned char*)lds_raw;
    Ctx F; F.tid = threadIdx.x; F.lane = F.tid & 63; F.wave = __builtin_amdgcn_readfirstlane(F.tid >> 6); F.G = gridDim.x; F.blk = blockIdx.x;
    F.gw = F.blk * 8 + F.wave; F.ngw = F.G * 8;
    typedef const __attribute__((address_space(4))) Args* KArgs;
    const KArgs kp0 = (KArgs)__builtin_amdgcn_kernarg_segment_ptr();
#define KP() ({ KArgs k_ = kp0; asm volatile("" : "+s"(k_)); k_; })
#define GIN(i) ((const float*)(const GAS float*)(KP()->in[i]))
#define GOUT() ((float*)(GAS float*)(KP()->out))
#define GWS() ((unsigned char*)(GAS unsigned char*)(KP()->ws))
    unsigned char* ws = GWS();
    if (F.tid < 64) ((LAS unsigned*)(lds + MISC_OFF))[F.tid] = 0u;
    __syncthreads();
    XcdBarrier bar = xcd_barrier_post((unsigned*)(ws + WS_CTL) + CW_BAR, (volatile LAS unsigned*)(lds + MISC_OFF), F.wave);

    {   REFRESH(); ws = GWS();
        { W_PTRS(0); MK_WP(0); convert_weights(F, WP, lds); }
        REFRESH();
        xw_init(F, GIN(0), GIN(1), (bf16*)(ws + WS_XW), (float*)(ws + WS_STAT + ST_RSTD1)); }
    GRID_BAR();
#pragma unroll 1
    for (int layer = 0; layer < DEPTH; ++layer) {
#pragma unroll 1
        for (int grp = 0; grp < NGRP; ++grp) {
            REFRESH();
            PROBE_T0();
            ws = GWS();
            OPQ_PTRS();
            W_PTRS(layer);
            bf16* XW = XWA + (size_t)grp * MG * DM;
            {   pg8::Gemm g{XW, T_IN, MG, NINP, DM, DM, DM}; pg8::StaticOrder S; S.init(MG, NINP, F.G, F.blk);
                pg8::EpiInProj E{R1, R_QNA, R_KNA, R_VNA, R_GQ, R_GK, R_GV, R_Z, R_XBC, R_DT, R_GATE, RSTD1 + (size_t)grp * MG, (LAS float*)(lds + EX_OFF + 4096)};
                pg8::gemm_phase<pg8::EpiInProj, pg8::StaticOrder, true, true>(lds, g, S, E, F.wave); }
            GRID_BAR();
            PROBE_T1(2);
            {   PrepPtrs PP{QNA, KNA, GQ, GK, GIN(4) + layer * 128, GIN(5) + layer * 128, GIN(13) + layer * 128, GIN(14) + layer * 128};
                prep_qk(F, PP, grp);
                REFRESH();
                prep_xbc(F, XBC, XBCA, GIN(7) + (size_t)layer * 5 * 1536, GIN(8) + (size_t)layer * 1536, grp); }
            GRID_BAR();
            PROBE_T1(3);
            ssd::Ptrs SP{XBCA, DT, Z, ST, DEC, O, RSS, GIN(9) + layer * 32, GIN(10) + layer * 32, GIN(11) + layer * 16};
            {
                constexpr int NU = (MG / 256) * 4;
                const bool rot = (F.G == 256);
                if (rot) { if (F.blk >= 128) NA_UNIT(F.blk - 128); }
                else for (int u = F.blk; u < NU; u += F.G) NA_UNIT(u);
                REFRESH();
                for (int u = F.blk; u < NU; u += F.G) {
                    int seq0, L, h, qb;
                    if (grp == 0 && u < 256) { seq0 = 0; L = LP; h = u >> 6; qb = u & 63; }
                    else { const int v = grp == 0 ? u - 256 : u; seq0 = (grp == 0 ? LP : 0) + (v >> 5) * LS; L = LS; h = (v >> 3) & 3; qb = v & 7; }
                    att::NaCtx nc{0, 0, 0, 0, nullptr};
                    att::attn_body<512, 256, 2048, false, 2>(GQ + (size_t)(seq0 + qb * 256) * 512 + h * 128, GK + (size_t)seq0 * 256 + (h >> 1) * 128, GV + (size_t)seq0 * 256 + (h >> 1) * 128,
                                                          O + (size_t)(seq0 + qb * 256) * 2048 + 1536 + h * 128, L / 64, (char*)lds_raw, nc, F.wave, GIN(13) + layer * 128, qb * 256);
                }
                REFRESH();
                for (int u0 = F.blk; u0 < (rot ? 512 : NU); u0 += F.G) { const int u = (rot && u0 >= 256) ? 256 + ((u0 + 128) & 255) : u0; if (u >= NU) continue; ssd::s1_unit(SP, lds, u >> 1, u & 1, F.tid); }
            }
            GRID_BAR();
            PROBE_T1(4);
            ssd::scan_states<16>(F, ST, DEC, grp);
            GRID_BAR();
            PROBE_T1(5);
            for (int u = F.blk; u < (MG / 128) * 2; u += F.G) ssd::s3_unit(SP, lds, u >> 1, u & 1, F.tid);
            if (F.G == 256 && F.blk >= 128) { REFRESH(); NA_UNIT(128 + 2 * (F.blk - 128)); REFRESH(); NA_UNIT(129 + 2 * (F.blk - 128)); }
            GRID_BAR();
            PROBE_T1(6);
            {   pg8::Gemm g{O, T_BR, MG, DM, DM, DM, DM}; pg8::StaticOrder S; S.init(MG, DM, F.G, F.blk);
                pg8::EpiMerge E{GATE, MRG, RSS};
                pg8::gemm_phase<pg8::EpiMerge, pg8::StaticOrder, true, true>(lds, g, S, E, F.wave); }
            GRID_BAR();
            PROBE_T1(7);
            {   pg8::Gemm g{MRG, T_OUT, MG, DM, DM, DM, DM}; pg8::StaticOrder S; S.init(MG, DM, F.G, F.blk);
                pg8::EpiResid E{XW, nullptr, 0, SSQ + (size_t)grp * MG * 8, RSTD2 + (size_t)grp * MG, CNT + (2 * layer + 0) * CNT_USE + grp * (MG / 256) * 16, (LAS float*)(lds + EX_OFF)};
                pg8::gemm_phase<pg8::EpiResid, pg8::StaticOrder, true, true>(lds, g, S, E, F.wave); }
            GRID_BAR();
            PROBE_T1(8);
        }
        {
            REFRESH();
            PROBE_T0();
            ws = GWS();
            OPQ_PTRS();
            W_PTRS(layer);
            {   pg8::Gemm g{XWA, T_UP, MTOT, NUP, DM, DM, DM}; pg8::StaticOrder S; S.init(MTOT, NUP, F.G, F.blk);
                pg8::EpiFfnAct E{ACT, (const float*)(ws + WS_CW + (size_t)(layer & 1) * CW_LAYER), SIDE, (LAS float*)(lds + EX_OFF), RSTD2, (LAS float*)(lds + EX_OFF + 4096), (LAS float*)(lds + EX_OFF + 8192)};
                pg8::gemm_phase<pg8::EpiFfnAct, pg8::StaticOrder, true, true>(lds, g, S, E, F.wave); }
            GRID_BAR();
            PROBE_T1(10);
            ffn_fix(F, SIDE, ACT, GIN(19) + (size_t)layer * 3 * DFF);
            if (layer + 1 < DEPTH) { REFRESH(); unsigned char* WLn = ws + WS_W + (size_t)((layer + 1) & 1) * W_LAYER;
                WPtrs WP{GIN(3) + (size_t)(layer + 1) * DM * NIN, GIN(15) + (size_t)(layer + 1) * DM * DM, GIN(16) + (size_t)(layer + 1) * DM * DM, GIN(18) + (size_t)(layer + 1) * DM * NUP, GIN(21) + (size_t)(layer + 1) * DFF * DM,
                         GIN(2) + (layer + 1) * DM, GIN(17) + (layer + 1) * DM, GIN(12) + (layer + 1) * 1024, (bf16*)(WLn + W_TIN), (bf16*)(WLn + W_TBR), (bf16*)(WLn + W_TOUT), (bf16*)(WLn + W_TUP), (bf16*)(WLn + W_TDN), GIN(19) + (size_t)(layer + 1) * 3 * DFF, GIN(20) + (size_t)(layer + 1) * DFF, (float*)(ws + WS_CW + (size_t)((layer + 1) & 1) * CW_LAYER)};
                convert_weights(F, WP, lds); }
            GRID_BAR();
            PROBE_T1(11);
            {   pg8::Gemm g{ACT, T_DN, MTOT, DM, DFF, DFF, DFF}; pg8::StaticOrder S; S.init(MTOT, DM, F.G, F.blk);
                pg8::EpiResid E{XWA, GOUT(), layer == DEPTH - 1, SSQ, RSTD1, CNT + (2 * layer + 1) * CNT_USE, (LAS float*)(lds + EX_OFF)};
                pg8::gemm_phase<pg8::EpiResid, pg8::StaticOrder, true, true>(lds, g, S, E, F.wave); }
            GRID_BAR();
            PROBE_T1(12);
        }
    }
}

extern "C" void kernel_launch(void* const* d_in, const int* in_sizes, int n_in, void* d_out, int out_size, void* d_ws, size_t ws_size, hipStream_t stream) {
    static int grid = 0;
    if (grid == 0) {
        if (n_in != 22 || out_size != MTOT * DM || ws_size < WS_END) { fprintf(stderr, "kernel_launch: unexpected shapes n_in %d out %d ws %zu (need %zu)\n", n_in, out_size, ws_size, (size_t)WS_END); grid = -1; return; }
        int dev = 0, cus = 0, per_cu = 0;
        if (hipGetDevice(&dev) != hipSuccess || hipDeviceGetAttribute(&cus, hipDeviceAttributeMultiprocessorCount, dev) != hipSuccess) { grid = -1; return; }
        if (hipFuncSetAttribute((const void*)fwd_kernel, hipFuncAttributeMaxDynamicSharedMemorySize, LDS_BYTES) != hipSuccess) { fprintf(stderr, "kernel_launch: hipFuncSetAttribute failed\n"); grid = -1; return; }
        if (hipOccupancyMaxActiveBlocksPerMultiprocessor(&per_cu, (const void*)fwd_kernel, 512, LDS_BYTES) != hipSuccess || per_cu < 1) { fprintf(stderr, "kernel_launch: occupancy query says %d blocks per CU\n", per_cu); (void)hipGetLastError(); grid = -1; return; }
        grid = cus;
    }
    if (grid < 0) return;
    if (hipMemsetAsync((char*)d_ws + WS_CTL, 0, CTL_ZERO_BYTES, stream) != hipSuccess) return;
    Args a{};
    for (int i = 0; i < 22; ++i) a.in[i] = (const float*)d_in[i];
    a.out = (float*)d_out; a.ws = (unsigned char*)d_ws;
    hipLaunchKernelGGL(fwd_kernel, dim3(grid), dim3(512), LDS_BYTES, stream, a);
    const hipError_t le = hipPeekAtLastError();
    if (le != hipSuccess) fprintf(stderr, "kernel_launch: launch failed: %s\n", hipGetErrorName(le));
}
```
